# Optimizing an MI355X kernel written in HIP

```python
import math
import jax, jax.numpy as jnp
from jax import lax
import numpy as np

D_MODEL = 1024
BATCH = 8
SEQ = 4096
DEPTH = 1

HG_HEADS = 8
HG_DK = 128
HG_DV = 128
HG_WIDTH = HG_HEADS * HG_DK
HG_CHUNK = 32
POOL_WINDOWS = (2, 4, 8, 16)
POOL_GROUPS = 4
POOL_GROUP = 128
POOL_WIDTH = POOL_GROUPS * POOL_GROUP
POOL_OUT_GROUP = D_MODEL // POOL_GROUPS
MAX_WIN = 16
IN_WIDTHS = (HG_WIDTH, HG_WIDTH, HG_WIDTH, HG_WIDTH, POOL_WIDTH, D_MODEL, D_MODEL)
IN_COLS = sum(IN_WIDTHS)
IN_SPLITS = tuple(int(s) for s in np.cumsum(IN_WIDTHS)[:-1])
PEER_HEADS = 8
PEER_NKEYS = 128
PEER_EXPERTS = PEER_NKEYS * PEER_NKEYS
PEER_QDIM = 256
PEER_HALF = PEER_QDIM // 2
PEER_TOPK = 16
PEER_TOKEN_BLOCK = 128
PLE_DIM = 256
ALPHA = (2.0 * DEPTH) ** 0.25
BETA = (8.0 * DEPTH) ** -0.25
LN_EPS = 1e-5
RMS_EPS = 1e-6

kernel_name = "hybrid_hgrn2_pool_peer_deepnorm_block"


def layer_norm(x, g, b):
    xf = x.astype(jnp.float32)
    mu = jnp.mean(xf, axis=-1, keepdims=True)
    var = jnp.mean(jnp.square(xf - mu), axis=-1, keepdims=True)
    return ((xf - mu) * lax.rsqrt(var + LN_EPS) * g + b).astype(x.dtype)


def hgrn2_mixer(q, f_logit, i, g, lb, norm_g):
    B, S, _ = q.shape
    f32 = jnp.float32
    nc = S // HG_CHUNK
    f = lb + (1.0 - lb) * jax.nn.sigmoid(f_logit.astype(f32))
    k = 1.0 - f
    logf = jnp.log(f)

    def heads(t, d):
        return t.reshape(B, nc, HG_CHUNK, HG_HEADS, d).transpose(0, 3, 1, 2, 4)

    qh = heads(jax.nn.silu(q.astype(f32)) * (HG_DK ** -0.5), HG_DK)
    kh = heads(k, HG_DK)
    vh = heads(i.astype(f32), HG_DV)
    bh = jnp.cumsum(heads(logf, HG_DK), axis=3)
    q_dec = qh * jnp.exp(bh)
    k_inv = kh * jnp.exp(-bh)
    causal = jnp.tril(jnp.ones((HG_CHUNK, HG_CHUNK), dtype=bool))
    scores = jnp.where(causal, jnp.einsum('bhncd,bhnsd->bhncs', q_dec, k_inv), 0.0)
    o_intra = jnp.einsum('bhncs,bhnse->bhnce', scores, vh)
    b_last = bh[:, :, :, -1:, :]
    k_end = kh * jnp.exp(b_last - bh)
    d_state = jnp.einsum('bhncd,bhnce->nbhde', k_end, vh)
    chunk_decay = jnp.exp(b_last[:, :, :, 0, :]).transpose(2, 0, 1, 3)

    def step(state, inp):
        dec, ds = inp
        return dec[..., None] * state + ds, state

    s0 = jnp.zeros((B, HG_HEADS, HG_DK, HG_DV), f32)
    _, s_in = lax.scan(step, s0, (chunk_decay, d_state))
    o_inter = jnp.einsum('bhncd,nbhde->bhnce', q_dec, s_in)
    o = (o_intra + o_inter).transpose(0, 2, 3, 1, 4).reshape(B, S, HG_HEADS, HG_DV)
    o = o * lax.rsqrt(jnp.mean(jnp.square(o), axis=-1, keepdims=True) + RMS_EPS) * norm_g
    o = o.reshape(B, S, HG_HEADS * HG_DV) * jax.nn.silu(g.astype(f32))
    return o.astype(q.dtype)


def pool_mixer(v, w_grp, scale):
    B, S, _ = v.shape
    vf = v.astype(jnp.float32)
    c = jnp.pad(jnp.cumsum(vf, axis=1), ((0, 0), (MAX_WIN, 0), (0, 0)))
    pos = jnp.arange(S)
    outs = []
    for gi, w in enumerate(POOL_WINDOWS):
        lo, hi = gi * POOL_GROUP, (gi + 1) * POOL_GROUP
        wsum = c[:, MAX_WIN:, lo:hi] - c[:, MAX_WIN - w:MAX_WIN - w + S, lo:hi]
        cnt = jnp.minimum(pos + 1, w).astype(jnp.float32)[None, :, None]
        outs.append(wsum / cnt - vf[:, :, lo:hi])
    pooled = jnp.stack(outs, axis=2).astype(v.dtype)
    y = jnp.einsum('bsgc,gco->bsgo', pooled, w_grp).reshape(B, S, D_MODEL)
    return y * scale


def peer_ffn(x, w_query, sub_keys, u_tab, v_tab):
    B, S, D = x.shape
    q = (x @ w_query).reshape(B, S, PEER_HEADS, 2, PEER_HALF)
    sc = jnp.einsum('bshpk,hpnk->bshpn', q, sub_keys).astype(jnp.float32)
    top_v, top_i = lax.top_k(sc, PEER_TOPK)
    cand = top_v[..., 0, :, None] + top_v[..., 1, None, :]
    cand = cand.reshape(B, S, PEER_HEADS, PEER_TOPK * PEER_TOPK)
    best_v, best_pos = lax.top_k(cand, PEER_TOPK)
    i1 = jnp.take_along_axis(top_i[..., 0, :], best_pos // PEER_TOPK, axis=-1)
    i2 = jnp.take_along_axis(top_i[..., 1, :], best_pos % PEER_TOPK, axis=-1)
    expert = i1 * PEER_NKEYS + i2
    gate = jax.nn.softmax(best_v, axis=-1).astype(x.dtype)
    nb = (B * S) // PEER_TOKEN_BLOCK
    hk = PEER_HEADS * PEER_TOPK
    xb = x.reshape(nb, PEER_TOKEN_BLOCK, D)
    eb = expert.reshape(nb, PEER_TOKEN_BLOCK, hk)
    gb = gate.reshape(nb, PEER_TOKEN_BLOCK, hk)

    def block(args):
        xt, et, gt = args
        u = u_tab[et]
        act = jax.nn.gelu(jnp.einsum('td,tkd->tk', xt, u), approximate=False) * gt
        return jnp.einsum('tk,tkd->td', act, v_tab[et])

    y = lax.map(block, (xb, eb, gb))
    return y.reshape(B, S, D)


def setup_inputs(seed: int = 0) -> dict:
    key = jax.random.key(seed)
    ks = jax.random.split(key, 24)
    nrm = jax.random.normal
    f32 = jnp.float32
    L = DEPTH
    return {
        "x": nrm(ks[0], (BATCH, SEQ, D_MODEL), f32),
        "p": nrm(ks[1], (DEPTH, BATCH, SEQ, PLE_DIM), f32),
        "ln0_g": 1.0 + 0.02 * nrm(ks[2], (D_MODEL,), f32),
        "ln0_b": 0.02 * nrm(ks[3], (D_MODEL,), f32),
        "w_in": nrm(ks[4], (L, D_MODEL, IN_COLS), f32) * D_MODEL ** -0.5,
        "hg_lb": 1.0 + 0.1 * nrm(ks[5], (DEPTH + 1, HG_WIDTH), f32),
        "hg_norm_g": 1.0 + 0.02 * nrm(ks[6], (L, HG_DV), f32),
        "w_hg_branch": nrm(ks[7], (L, HG_WIDTH, D_MODEL), f32) * (BETA * HG_WIDTH ** -0.5),
        "pool_w": nrm(ks[8], (L, POOL_GROUPS, POOL_GROUP, POOL_OUT_GROUP), f32) * (BETA * POOL_GROUP ** -0.5),
        "pool_scale": 1.0 + 0.1 * nrm(ks[9], (L, D_MODEL), f32),
        "w_out": nrm(ks[10], (L, D_MODEL, D_MODEL), f32) * (BETA * D_MODEL ** -0.5),
        "ln1_g": 1.0 + 0.02 * nrm(ks[11], (L, D_MODEL), f32),
        "ln1_b": 0.02 * nrm(ks[12], (L, D_MODEL), f32),
        "w_query": nrm(ks[13], (L, D_MODEL, PEER_HEADS * PEER_QDIM), f32) * D_MODEL ** -0.5,
        "sub_keys": nrm(ks[14], (L, PEER_HEADS, 2, PEER_NKEYS, PEER_HALF), f32) * PEER_HALF ** -0.5,
        "u_tab": nrm(ks[15], (L, PEER_EXPERTS, D_MODEL), f32) * D_MODEL ** -0.5,
        "v_tab": nrm(ks[16], (L, PEER_EXPERTS, D_MODEL), f32) * (BETA * PEER_HEADS ** -0.5),
        "w_ple_gate": nrm(ks[17], (L, D_MODEL, D_MODEL), f32) * D_MODEL ** -0.5,
        "w_ple_proj": nrm(ks[18], (L, PLE_DIM, D_MODEL), f32) * (BETA * PLE_DIM ** -0.5),
        "ln2_g": 1.0 + 0.02 * nrm(ks[19], (L, D_MODEL), f32),
        "ln2_b": 0.02 * nrm(ks[20], (L, D_MODEL), f32),
    }


def reference(x, p, ln0_g, ln0_b, w_in, hg_lb, hg_norm_g, w_hg_branch, pool_w, pool_scale,
              w_out, ln1_g, ln1_b, w_query, sub_keys, u_tab, v_tab, w_ple_gate, w_ple_proj,
              ln2_g, ln2_b):
    h = layer_norm(x, ln0_g, ln0_b)
    lb_all = jnp.cumsum(jax.nn.softmax(hg_lb.astype(jnp.float32), axis=0), axis=0)
    for l in range(DEPTH):
        proj = h @ w_in[l]
        q, f_logit, i_val, g_out, v_pool, gate_a, gate_b = jnp.split(proj, IN_SPLITS, axis=-1)
        y_a = hgrn2_mixer(q, f_logit, i_val, g_out, lb_all[l], hg_norm_g[l]) @ w_hg_branch[l]
        y_b = pool_mixer(v_pool, pool_w[l], pool_scale[l])
        mix = jax.nn.sigmoid(gate_a) * y_a + jax.nn.sigmoid(gate_b) * y_b
        h = layer_norm(ALPHA * h + mix @ w_out[l], ln1_g[l], ln1_b[l])
        ple = jax.nn.sigmoid(h @ w_ple_gate[l]) * (p[l] @ w_ple_proj[l])
        ffn = peer_ffn(h, w_query[l], sub_keys[l], u_tab[l], v_tab[l])
        h = layer_norm(ALPHA * h + ffn + ple, ln2_g[l], ln2_b[l])
    return h
```

```cpp
#include <hip/hip_runtime.h>
#include <cstdio>
#include <cstdint>

#ifndef MK_ONE_LAUNCH
#define MK_ONE_LAUNCH 0
#endif

#define LAS __attribute__((address_space(3)))
#define GAS __attribute__((address_space(1)))
typedef unsigned short bf16_t;
typedef short bf16x8 __attribute__((ext_vector_type(8)));
typedef float f32x4 __attribute__((ext_vector_type(4)));
typedef float f32x2 __attribute__((ext_vector_type(2)));
typedef unsigned u32x4 __attribute__((ext_vector_type(4)));
typedef unsigned u32x2 __attribute__((ext_vector_type(2)));

constexpr int BATCH = 8, SEQ = 4096, T = BATCH * SEQ, D = 1024;
constexpr int NPROJ = 6656;
constexpr int NEXP = 16384;
constexpr float ALPHA = 1.189207115002721f;
constexpr float LN_EPS = 1e-5f, RMS_EPS = 1e-6f;
constexpr int NWAVES = 8;

constexpr size_t MiB = 1u << 20;
constexpr size_t WS_CTL = 0, CTL_ZERO_BYTES = 1 * MiB;
constexpr size_t WS_OML = 1 * MiB;
constexpr size_t WS_ST0 = 1 * MiB + 65536;
constexpr size_t WS_WIN = 2 * MiB;
constexpr size_t WS_WA = 15 * MiB;
constexpr size_t WS_WOUT = 17 * MiB;
constexpr size_t WS_WPGQ = 19 * MiB;
constexpr size_t WS_WPP = 25 * MiB;
constexpr size_t WS_WPOOL = 25 * MiB + 512 * 1024;
constexpr size_t WS_SK = 26 * MiB;
constexpr size_t WS_PB = 27 * MiB;
constexpr size_t WS_UT = 43 * MiB;
constexpr size_t WS_VT = 75 * MiB;
constexpr size_t WS_XN = 108 * MiB;
constexpr size_t WS_QS = 172 * MiB, WS_KK = 236 * MiB, WS_VI = 300 * MiB, WS_SG = 364 * MiB;
constexpr size_t WS_VP = 428 * MiB, WS_PL = 460 * MiB;
constexpr size_t WS_END = 492 * MiB;
constexpr size_t WS_OG = WS_XN, WS_YB = WS_QS, WS_MIX = WS_KK, WS_PP = WS_VI, WS_H1B = WS_SG, WS_QRY = WS_QS;
constexpr size_t WS_IDX = WS_VP, WS_GATE = WS_VP + 16 * MiB;

constexpr int RING_BYTES = 131072;
constexpr int LDSCTL_OFF = RING_BYTES, MISC_OFF = LDSCTL_OFF + 320;
constexpr int LDS_BYTES = 147456;

__device__ __forceinline__ unsigned f2bf(float f) { unsigned u = __builtin_bit_cast(unsigned, f); return (u + 0x7fffu + ((u >> 16) & 1u)) >> 16; }
__device__ __forceinline__ unsigned pk2(float lo, float hi) { return f2bf(lo) | (f2bf(hi) << 16); }
__device__ __forceinline__ float bflo(unsigned w) { return __builtin_bit_cast(float, w << 16); }
__device__ __forceinline__ float bfhi(unsigned w) { return __builtin_bit_cast(float, w & 0xffff0000u); }
__device__ __forceinline__ unsigned cvt_pk_bf16(float lo, float hi) { unsigned r; asm volatile("v_cvt_pk_bf16_f32 %0, %1, %2" : "=v"(r) : "v"(lo), "v"(hi)); return r; }
__device__ __forceinline__ float sigmoidf_(float x) { return __builtin_amdgcn_rcpf(1.0f + __expf(-x)); }
__device__ __forceinline__ float wave_sum(float v) {
#pragma unroll
    for (int o = 1; o < 64; o <<= 1) v += __shfl_xor(v, o);
    return v;
}
#define LDS_WAIT() asm volatile("s_waitcnt lgkmcnt(0)" ::: "memory")
#define VM_WAIT() asm volatile("s_waitcnt vmcnt(0)" ::: "memory")

namespace pg8 {
constexpr int BM = 256, BK = 64, HALF = 128, HTB = HALF * BK * 2, STAGE_BYTES = 8 * HTB, NXCD = 8, WGM = 8;
__host__ __device__ __forceinline__ int lds_byte(int r, int c) { const int st = (r >> 4) * 2 + (c >> 5), rr = r & 15, cc = c & 31, ob = rr * 64 + cc * 2; return st * 1024 + (ob ^ (((ob >> 9) & 1) << 5)); }
__host__ __device__ __forceinline__ void stage_rc(int b, int& R, int& C) { const int st = b / 1024, sb = b % 1024, swz = sb ^ (((sb >> 9) & 1) << 5); R = (st >> 1) * 16 + swz / 64; C = (st & 1) * 32 + (swz % 64) / 2; }
__host__ __device__ __forceinline__ int perm32(int rho) { const int n = rho >> 4, i = rho & 15; return 8 * (i >> 2) + 4 * n + (i & 3); }

struct Unit { int pm, pn; };
struct Gemm { const bf16_t* A; const bf16_t* Bt; int M, N, K, lda, ldb, acol_shift, acol_mul; };

struct StaticOrder {
    int nM, nN, nwg, G, c;
    __host__ __device__ void init(int M, int N, int G_, int c_) { nM = M / BM; nN = N / BM; nwg = nM * nN; G = G_; c = c_; }
    __host__ __device__ bool next(int i, Unit& u) const {
        const long L = (long)i * G + c; if (L >= nwg) return false;
        int wgid = (int)L; { const int q = nwg / NXCD, r = nwg % NXCD, xcd = wgid % NXCD, off = wgid / NXCD; wgid = (xcd < r ? xcd * (q + 1) : r * (q + 1) + (xcd - r) * q) + off; }
        const int nig = WGM * nN, gid = wgid / nig, fm = gid * WGM, gsz = (nM - fm) < WGM ? (nM - fm) : WGM;
        u.pm = fm + ((wgid % nig) % gsz); u.pn = (wgid % nig) / gsz; return true;
    }
};


template <class Epi>
__device__ __forceinline__ void gemm_phase(LAS unsigned char* lds, const Gemm g, const StaticOrder& S, const Epi& E) {
    const int tid = threadIdx.x, wid = __builtin_amdgcn_readfirstlane(tid >> 6), lane = tid & 63, wr = wid >> 2, wc = wid & 3, fr = lane & 15, fq = lane >> 4;
    int K_ = g.K; asm volatile("" : "+s"(K_));
    const int K = K_, nt = K / BK;
    unsigned voffA[2], voffB[2];
#pragma unroll
    for (int i = 0; i < 2; ++i) { int R, C; stage_rc(tid * 16 + i * 8192, R, C); const int Rb = Epi::PERM ? ((R & ~31) + perm32(R & 31)) : R;
        voffA[i] = (unsigned)(R * g.lda + C) * 2u; voffB[i] = (unsigned)(Rb * g.ldb + C) * 2u; }
    const size_t kstep = (size_t)(BK * 2);
    const size_t hstepA = (size_t)HALF * g.lda * 2, hstepB = (size_t)HALF * g.ldb * 2;
    const size_t tstepA = 2 * hstepA, tstepB = 2 * hstepB;
    const unsigned ldsw = (unsigned)wid * 1024u;
    const int aoff = lds_byte(wr * 64 + fr, fq * 8), boff = lds_byte(wc * 32 + fr, fq * 8);
#define PG8_SA(b, h) (((b) * 2 + (h)) * HTB)
#define PG8_SB(b, h) ((4 + (b) * 2 + (h)) * HTB)
#define PG8_STAGE(bufoff, gbase, voff) do { _Pragma("unroll") for (int _i = 0; _i < 2; ++_i) \
        __builtin_amdgcn_global_load_lds((const unsigned*)((const char*)(gbase) + (voff)[_i]), (LAS unsigned*)(lds + (bufoff) + ldsw + _i * 8192), 16, 0, 0); } while (0)
#define PG8_LDA(dst, b, h) do { _Pragma("unroll") for (int m = 0; m < 4; ++m) _Pragma("unroll") for (int k = 0; k < 2; ++k) dst[m][k] = *(const LAS bf16x8*)(lds + PG8_SA(b, h) + aoff + m * 2048 + k * 1024); } while (0)
#define PG8_LDB(dst, b, h) do { _Pragma("unroll") for (int n = 0; n < 2; ++n) _Pragma("unroll") for (int k = 0; k < 2; ++k) dst[n][k] = *(const LAS bf16x8*)(lds + PG8_SB(b, h) + boff + n * 2048 + k * 1024); } while (0)
#define PG8_MMA(ai, bj, At, Bt) do { __builtin_amdgcn_s_setprio(1); _Pragma("unroll") for (int m = 0; m < 4; ++m) _Pragma("unroll") for (int n = 0; n < 2; ++n) _Pragma("unroll") for (int k = 0; k < 2; ++k) \
        acc[ai][bj][m][n] = __builtin_amdgcn_mfma_f32_16x16x32_bf16(Bt[n][k], At[m][k], acc[ai][bj][m][n], 0, 0, 0); __builtin_amdgcn_s_setprio(0); } while (0)
#define PG8_WAIT_V(n) asm volatile("s_waitcnt vmcnt(" #n ")" ::: "memory")
#define PG8_WAIT_L(n) asm volatile("s_waitcnt lgkmcnt(" #n ")" ::: "memory")
#define PG8_BAR __builtin_amdgcn_s_barrier()
#define PG8_SCHED __builtin_amdgcn_sched_barrier(0)
    Unit cur, nxt; int ui = 0;
    if (!S.next(0, cur)) return;
    f32x4 acc[2][2][4][2];
#pragma unroll
    for (int a = 0; a < 2; ++a)
#pragma unroll
        for (int b = 0; b < 2; ++b)
#pragma unroll
            for (int m = 0; m < 4; ++m)
#pragma unroll
                for (int n = 0; n < 2; ++n) acc[a][b][m][n] = (f32x4){0.f, 0.f, 0.f, 0.f};
    bf16x8 At[4][2], B0[2][2], B1[2][2];
    const char* cA = (const char*)g.A + (size_t)cur.pm * tstepA + (size_t)((cur.pn >> g.acol_shift) * g.acol_mul) * 2; const char* cB = (const char*)g.Bt + (size_t)cur.pn * tstepB;
    PG8_STAGE(PG8_SB(0, 0), cB, voffB); PG8_STAGE(PG8_SB(0, 1), cB + hstepB, voffB); PG8_STAGE(PG8_SA(0, 0), cA, voffA); PG8_STAGE(PG8_SA(0, 1), cA + hstepA, voffA);
    if (wr == 1) PG8_BAR;
    PG8_WAIT_V(2); PG8_BAR;
    PG8_STAGE(PG8_SB(1, 0), cB + kstep, voffB); PG8_STAGE(PG8_SA(1, 0), cA + kstep, voffA); PG8_STAGE(PG8_SB(1, 1), cB + hstepB + kstep, voffB);
    PG8_WAIT_V(6); PG8_BAR;
    for (;;) {
        const bool has_next = S.next(ui + 1, nxt);
        const char* nA = has_next ? (const char*)g.A + (size_t)nxt.pm * tstepA + (size_t)((nxt.pn >> g.acol_shift) * g.acol_mul) * 2 : cA;
        const char* nB = has_next ? (const char*)g.Bt + (size_t)nxt.pn * tstepB : cB;
        for (int t = 0; t < nt; t += 2) {
            const bool last = (t == nt - 2);
            const char* a1 = cA + (size_t)(t + 1) * kstep;
            const char* a2 = last ? nA : cA + (size_t)(t + 2) * kstep; const char* b2 = last ? nB : cB + (size_t)(t + 2) * kstep;
            const char* a3 = a2 + kstep; const char* b3 = b2 + kstep;
            PG8_LDB(B0, 0, 0); PG8_LDB(B1, 0, 1); PG8_SCHED; PG8_LDA(At, 0, 0); PG8_STAGE(PG8_SA(1, 1), a1 + hstepA, voffA);
            PG8_WAIT_V(8); PG8_WAIT_L(0); PG8_BAR; PG8_MMA(0, 0, At, B0); PG8_MMA(0, 1, At, B1); PG8_BAR; PG8_SCHED;
            PG8_LDA(At, 0, 1); PG8_STAGE(PG8_SB(0, 0), b2, voffB); PG8_STAGE(PG8_SB(0, 1), b2 + hstepB, voffB); PG8_STAGE(PG8_SA(0, 0), a2, voffA);
            PG8_WAIT_V(8); PG8_WAIT_L(0); PG8_BAR; PG8_MMA(1, 0, At, B0); PG8_MMA(1, 1, At, B1); PG8_BAR; PG8_SCHED;
            PG8_LDB(B0, 1, 0); PG8_LDB(B1, 1, 1); PG8_SCHED; PG8_LDA(At, 1, 0); PG8_STAGE(PG8_SA(0, 1), a2 + hstepA, voffA);
            PG8_WAIT_V(8); PG8_WAIT_L(0); PG8_BAR; PG8_MMA(0, 0, At, B0); PG8_MMA(0, 1, At, B1); PG8_BAR; PG8_SCHED;
            PG8_LDA(At, 1, 1); PG8_STAGE(PG8_SB(1, 0), b3, voffB); PG8_STAGE(PG8_SB(1, 1), b3 + hstepB, voffB); PG8_STAGE(PG8_SA(1, 0), a3, voffA);
            PG8_WAIT_V(8); PG8_WAIT_L(0); PG8_BAR; PG8_MMA(1, 0, At, B0); PG8_MMA(1, 1, At, B1); PG8_BAR; PG8_SCHED;
        }
        if (wr == 0) PG8_BAR;
        E(acc, cur, wr, wc, fr, fq);
        if (!has_next) break;
#pragma unroll
        for (int a = 0; a < 2; ++a)
#pragma unroll
            for (int b = 0; b < 2; ++b)
#pragma unroll
                for (int m = 0; m < 4; ++m)
#pragma unroll
                    for (int n = 0; n < 2; ++n) acc[a][b][m][n] = (f32x4){0.f, 0.f, 0.f, 0.f};
        cur = nxt; cA = nA; cB = nB; ++ui;
        if (wr == 1) PG8_BAR;
    }
    PG8_WAIT_V(0);
    PG8_BAR;
#undef PG8_SA
#undef PG8_SB
#undef PG8_STAGE
#undef PG8_LDA
#undef PG8_LDB
#undef PG8_MMA
#undef PG8_WAIT_V
#undef PG8_WAIT_L
#undef PG8_BAR
#undef PG8_SCHED
}

#define EPI_FENCE() asm volatile("" ::: "memory")
__device__ __forceinline__ u32x4 pack8(const f32x4& v0, const f32x4& v1) { u32x4 w; w.x = cvt_pk_bf16(v0[0], v0[1]); w.y = cvt_pk_bf16(v0[2], v0[3]); w.z = cvt_pk_bf16(v1[0], v1[1]); w.w = cvt_pk_bf16(v1[2], v1[3]); return w; }
__device__ __forceinline__ void unpack8(const u32x4& w, f32x4& v0, f32x4& v1) { v0 = (f32x4){bflo(w.x), bfhi(w.x), bflo(w.y), bfhi(w.y)}; v1 = (f32x4){bflo(w.z), bfhi(w.z), bflo(w.w), bfhi(w.w)}; }

struct EpiProj {
    static constexpr bool PERM = true;
    bf16_t *Qs, *Kk, *Vi, *SG, *VP, *GA, *GB; const float* oml;
    __device__ __forceinline__ void operator()(const f32x4 (&acc)[2][2][4][2], const Unit& u, int wr, int wc, int fr, int fq) const {
        const int pn = u.pn; bf16_t* base; int ldc = 1024, ct, mode;
        if (pn < 4) { base = Qs; ct = pn; mode = 0; } else if (pn < 8) { base = Kk; ct = pn - 4; mode = 1; } else if (pn < 12) { base = Vi; ct = pn - 8; mode = 2; }
        else if (pn < 16) { base = SG; ct = pn - 12; mode = 3; } else if (pn < 18) { base = VP; ct = pn - 16; mode = 2; ldc = 512; }
        else if (pn < 22) { base = GA; ct = pn - 18; mode = 4; } else { base = GB; ct = pn - 22; mode = 4; }
        const int row0 = u.pm * BM + wr * 64 + fr, col0 = ct * 256 + wc * 32 + 8 * fq;
        f32x4 om[2][2];
#pragma unroll
        for (int bj = 0; bj < 2; ++bj)
#pragma unroll
            for (int n = 0; n < 2; ++n) om[bj][n] = (mode == 1) ? *(const f32x4*)(oml + col0 + bj * HALF + 4 * n) : (f32x4){1.f, 1.f, 1.f, 1.f};
#pragma unroll
        for (int ai = 0; ai < 2; ++ai)
#pragma unroll
            for (int m = 0; m < 4; ++m) { bf16_t* rowp = base + (size_t)(row0 + ai * HALF + m * 16) * ldc + col0;
#pragma unroll
                for (int bj = 0; bj < 2; ++bj) { f32x4 v[2] = {acc[ai][bj][m][0], acc[ai][bj][m][1]};
#pragma unroll
                    for (int n = 0; n < 2; ++n)
#pragma unroll
                        for (int e = 0; e < 4; ++e) { const float x = v[n][e]; float y;
                            if (mode == 0) y = x * sigmoidf_(x) * 0.08838834764831845f;
                            else if (mode == 1) y = om[bj][n][e] * sigmoidf_(-x);
                            else if (mode == 2) y = x;
                            else if (mode == 3) y = x * sigmoidf_(x);
                            else y = sigmoidf_(x);
                            v[n][e] = y; }
                    *(u32x4*)(rowp + bj * HALF) = pack8(v[0], v[1]); } }
    }
};
struct EpiPlain {
    static constexpr bool PERM = true;
    bf16_t* O; int ldc;
    __device__ __forceinline__ void operator()(const f32x4 (&acc)[2][2][4][2], const Unit& u, int wr, int wc, int fr, int fq) const {
        const int row0 = u.pm * BM + wr * 64 + fr, col0 = u.pn * BM + wc * 32 + 8 * fq;
#pragma unroll
        for (int ai = 0; ai < 2; ++ai)
#pragma unroll
            for (int m = 0; m < 4; ++m) { bf16_t* rowp = O + (size_t)(row0 + ai * HALF + m * 16) * ldc + col0;
#pragma unroll
                for (int bj = 0; bj < 2; ++bj) *(u32x4*)(rowp + bj * HALF) = pack8(acc[ai][bj][m][0], acc[ai][bj][m][1]); }
    }
};
struct EpiYB {
    static constexpr bool PERM = true;
    bf16_t* YB; const bf16_t* GB; const float* scale;
    __device__ __forceinline__ void operator()(const f32x4 (&acc)[2][2][4][2], const Unit& u, int wr, int wc, int fr, int fq) const {
        const int row0 = u.pm * BM + wr * 64 + fr, col0 = u.pn * BM + wc * 32 + 8 * fq;
        f32x4 sc[2][2];
#pragma unroll
        for (int bj = 0; bj < 2; ++bj)
#pragma unroll
            for (int n = 0; n < 2; ++n) sc[bj][n] = *(const f32x4*)(scale + col0 + bj * HALF + 4 * n);
#pragma unroll
        for (int ai = 0; ai < 2; ++ai)
#pragma unroll
            for (int m = 0; m < 4; ++m) { const size_t off = (size_t)(row0 + ai * HALF + m * 16) * 1024 + col0;
#pragma unroll
                for (int bj = 0; bj < 2; ++bj) { const u32x4 gw = *(const u32x4*)(GB + off + bj * HALF); f32x4 g0, g1; unpack8(gw, g0, g1);
                    const f32x4 v0 = acc[ai][bj][m][0] * sc[bj][0] * g0, v1 = acc[ai][bj][m][1] * sc[bj][1] * g1;
                    *(u32x4*)(YB + off + bj * HALF) = pack8(v0, v1); }
                EPI_FENCE(); }
    }
};
struct EpiMix {
    static constexpr bool PERM = true;
    bf16_t* MIX; const bf16_t* GA; const bf16_t* YB;
    __device__ __forceinline__ void operator()(const f32x4 (&acc)[2][2][4][2], const Unit& u, int wr, int wc, int fr, int fq) const {
        const int row0 = u.pm * BM + wr * 64 + fr, col0 = u.pn * BM + wc * 32 + 8 * fq;
#pragma unroll
        for (int ai = 0; ai < 2; ++ai)
#pragma unroll
            for (int m = 0; m < 4; ++m) { const size_t off = (size_t)(row0 + ai * HALF + m * 16) * 1024 + col0;
#pragma unroll
                for (int bj = 0; bj < 2; ++bj) { const u32x4 gw = *(const u32x4*)(GA + off + bj * HALF), yw = *(const u32x4*)(YB + off + bj * HALF);
                    f32x4 g0, g1, y0, y1; unpack8(gw, g0, g1); unpack8(yw, y0, y1);
                    const f32x4 v0 = acc[ai][bj][m][0] * g0 + y0, v1 = acc[ai][bj][m][1] * g1 + y1;
                    *(u32x4*)(MIX + off + bj * HALF) = pack8(v0, v1); }
                EPI_FENCE(); }
    }
};
struct EpiR1 {
    static constexpr bool PERM = false;
    float* R1; const float* x; const float* st0; const float* g0; const float* b0;
    __device__ __forceinline__ void operator()(const f32x4 (&acc)[2][2][4][2], const Unit& u, int wr, int wc, int fr, int fq) const {
        const int row0 = u.pm * BM + wr * 64 + fr, col0 = u.pn * BM + wc * 32 + 4 * fq;
        f32x4 gg[2][2], bb[2][2];
#pragma unroll
        for (int bj = 0; bj < 2; ++bj)
#pragma unroll
            for (int n = 0; n < 2; ++n) { gg[bj][n] = *(const f32x4*)(g0 + col0 + bj * HALF + 16 * n); bb[bj][n] = *(const f32x4*)(b0 + col0 + bj * HALF + 16 * n); }
#pragma unroll
        for (int ai = 0; ai < 2; ++ai)
#pragma unroll
            for (int m = 0; m < 4; ++m) { const int r = row0 + ai * HALF + m * 16; const size_t off = (size_t)r * 1024 + col0; const f32x2 ms = *(const f32x2*)(st0 + 2 * (size_t)r);
#pragma unroll
                for (int bj = 0; bj < 2; ++bj)
#pragma unroll
                    for (int n = 0; n < 2; ++n) { const f32x4 xv = *(const f32x4*)(x + off + bj * HALF + 16 * n);
                        const f32x4 h = (xv - ms.x) * ms.y * gg[bj][n] + bb[bj][n];
                        *(f32x4*)(R1 + off + bj * HALF + 16 * n) = h * ALPHA + acc[ai][bj][m][n]; }
                EPI_FENCE(); }
    }
};
struct EpiPgq {
    static constexpr bool PERM = true;
    bf16_t* PP; bf16_t* QRY;
    __device__ __forceinline__ void operator()(const f32x4 (&acc)[2][2][4][2], const Unit& u, int wr, int wc, int fr, int fq) const {
        const int row0 = u.pm * BM + wr * 64 + fr;
        if (u.pn < 4) {
            const int col0 = u.pn * BM + wc * 32 + 8 * fq;
#pragma unroll
            for (int ai = 0; ai < 2; ++ai)
#pragma unroll
                for (int m = 0; m < 4; ++m) { const size_t off = (size_t)(row0 + ai * HALF + m * 16) * 1024 + col0;
#pragma unroll
                    for (int bj = 0; bj < 2; ++bj) { const u32x4 pw = *(const u32x4*)(PP + off + bj * HALF); f32x4 p0, p1; unpack8(pw, p0, p1); f32x4 v0, v1;
#pragma unroll
                        for (int e = 0; e < 4; ++e) { v0[e] = sigmoidf_(acc[ai][bj][m][0][e]) * p0[e]; v1[e] = sigmoidf_(acc[ai][bj][m][1][e]) * p1[e]; }
                        *(u32x4*)(PP + off + bj * HALF) = pack8(v0, v1); }
                    EPI_FENCE(); }
        } else {
            const int col0 = (u.pn - 4) * BM + wc * 32 + 8 * fq;
#pragma unroll
            for (int ai = 0; ai < 2; ++ai)
#pragma unroll
                for (int m = 0; m < 4; ++m) { bf16_t* rowp = QRY + (size_t)(row0 + ai * HALF + m * 16) * 2048 + col0;
#pragma unroll
                    for (int bj = 0; bj < 2; ++bj) *(u32x4*)(rowp + bj * HALF) = pack8(acc[ai][bj][m][0], acc[ai][bj][m][1]); }
        }
    }
};
}

typedef GAS unsigned gu32;
#define RLX_AGENT __ATOMIC_RELAXED, __HIP_MEMORY_SCOPE_AGENT
#define XB_TMO      128
#define XB_XCNT(j)  (256  + 64 * (j))
#define XB_XSUB(j)  (1280 + 64 * (j))
#define XB_XGEN(j)  (2304 + 64 * (j))
#define XB_TOP      3328
#define XB_TOPGEN   3392
#define XCD_BAR_WORDS 3456
#define XB_SPIN_CAP (1u << 22)
constexpr int CW_BAR = 4096;
__device__ __forceinline__ unsigned xb_ld(unsigned* p)              { return __hip_atomic_load(p, __ATOMIC_RELAXED, __HIP_MEMORY_SCOPE_AGENT); }
__device__ __forceinline__ unsigned xb_add(unsigned* p, unsigned v) { return __hip_atomic_fetch_add(p, v, __ATOMIC_RELAXED, __HIP_MEMORY_SCOPE_AGENT); }
__device__ __forceinline__ unsigned xb_xcc_id() { return (unsigned)__builtin_amdgcn_s_getreg((3 << 11) | 20) & 0xFu; }
#define XB_SPIN(cond, bar) do { unsigned _sp = 0; while (cond) { __builtin_amdgcn_s_sleep(1); \
    if ((++_sp & 255u) == 0u) { if (xb_ld(&(bar)[XB_TMO])) break; if (_sp > XB_SPIN_CAP) { atomicAdd(&(bar)[XB_TMO], 1u); break; } } } } while (0)
struct XcdBarrier { unsigned* bar; unsigned x; volatile LAS unsigned* st; };
__device__ __forceinline__ XcdBarrier xcd_barrier_post(unsigned* bar, volatile LAS unsigned* st) {
    XcdBarrier b; b.bar = bar; b.x = xb_xcc_id(); b.st = st;
    if (threadIdx.x == 0) (void)xb_add(&bar[XB_XCNT(b.x)], 1u);
    return b;
}
__device__ __forceinline__ void xcd_barrier_complete(unsigned* bar, unsigned x, unsigned& nloc, unsigned& nx) {
    const unsigned G = gridDim.x * gridDim.y * gridDim.z;
    unsigned sum, cnt, mine, sp = 0u;
    for (;;) {
        sum = 0u; cnt = 0u; mine = 0u;
#pragma unroll
        for (unsigned j = 0; j < 16; ++j) { const unsigned c = xb_ld(&bar[XB_XCNT(j)]); sum += c; cnt += (c > 0u) ? 1u : 0u; mine = (j == x) ? c : mine; }
        if (sum == G) break;
        __builtin_amdgcn_s_sleep(1);
        if ((++sp & 255u) == 0u) { if (xb_ld(&bar[XB_TMO])) break; if (sp > XB_SPIN_CAP) { atomicAdd(&bar[XB_TMO], 1u); break; } }
    }
    nloc = mine > 0u ? mine : 1u; nx = cnt > 0u ? cnt : 1u;
}
__device__ __forceinline__ void xcd_barrier(const XcdBarrier& b) {
    asm volatile("s_waitcnt vmcnt(0)" ::: "memory");
    __syncthreads();
    if (threadIdx.x == 0) {
        unsigned* bar = b.bar;
        __builtin_amdgcn_s_waitcnt(0);
        unsigned nloc = b.st[0], nx = b.st[1];
        if (nloc == 0u) { xcd_barrier_complete(bar, b.x, nloc, nx); b.st[0] = nloc; b.st[1] = nx; }
        const unsigned old = xb_add(&bar[XB_XSUB(b.x)], 1u);
        const unsigned gen = old / nloc;
        if (old + 1u == (gen + 1u) * nloc) {
            __builtin_amdgcn_fence(__ATOMIC_RELEASE, "agent");
            asm volatile("s_waitcnt vmcnt(0)" ::: "memory");
            const unsigned og = xb_add(&bar[XB_TOP], 1u);
            const unsigned tg = og / nx;
            if (og + 1u == (tg + 1u) * nx) xb_add(&bar[XB_TOPGEN], 1u);
            else XB_SPIN(xb_ld(&bar[XB_TOPGEN]) == tg, bar);
            __builtin_amdgcn_fence(__ATOMIC_ACQUIRE, "agent");
            xb_add(&bar[XB_XGEN(b.x)], 1u);
            asm volatile("s_waitcnt vmcnt(0)" ::: "memory");
        } else {
            XB_SPIN(xb_ld(&bar[XB_XGEN(b.x)]) == gen, bar);
            __builtin_amdgcn_fence(__ATOMIC_ACQUIRE, "agent");
            asm volatile("s_waitcnt vmcnt(0)" ::: "memory");
        }
    }
    __syncthreads();
}

struct Args { const float* in[21]; float* out; unsigned char* ws; int ph_lo, ph_hi; };
struct Frame {
    LAS unsigned char* lds; volatile LAS unsigned* MISC; gu32* ctl;
    int tid, lane, wave, vcu, G;
};

__device__ __forceinline__ void p0_transpose_item(const float* W, int K, int N, bf16_t* WT, int row_off, LAS float* scr, int item, int lane) {
    const int nblk = N / 32, kb = item / nblk, nb = item % nblk, k0 = 64 * kb, n0 = 32 * nb;
#pragma unroll 8
    for (int i = 0; i < 32; ++i) { const int kk = 2 * i + (lane >> 5); scr[kk * 33 + (lane & 31)] = W[(size_t)(k0 + kk) * N + n0 + (lane & 31)]; }
    LDS_WAIT(); asm volatile("" ::: "memory");
    const int c = lane & 7;
#pragma unroll
    for (int j = 0; j < 4; ++j) { const int n = (lane >> 3) + 8 * j; const LAS float* s = scr + (8 * c) * 33 + n;
        u32x4 o; o.x = pk2(s[0 * 33], s[1 * 33]); o.y = pk2(s[2 * 33], s[3 * 33]); o.z = pk2(s[4 * 33], s[5 * 33]); o.w = pk2(s[6 * 33], s[7 * 33]);
        *(GAS u32x4*)(WT + (size_t)(row_off + n0 + n) * K + k0 + 8 * c) = o; }
    LDS_WAIT(); asm volatile("" ::: "memory");
}
__device__ __forceinline__ void cvt_stream(const float* src, bf16_t* dst, size_t n4, size_t gtid, size_t nthr) {
    for (size_t i = gtid; i < n4; i += nthr) { const f32x4 v = ((const GAS f32x4*)src)[i]; u32x2 o; o.x = pk2(v[0], v[1]); o.y = pk2(v[2], v[3]); ((GAS u32x2*)dst)[i] = o; }
}

__device__ __forceinline__ void phase_prologue(Frame& F, const Args& a) {
    unsigned char* ws = a.ws;
    LAS float* scr = (LAS float*)(F.lds + F.wave * 16384);
    const int gw = F.vcu * NWAVES + F.wave, NGW = F.G * NWAVES;
    const size_t gtid = (size_t)gw * 64 + F.lane, nthr = (size_t)NGW * 64;
    constexpr int I_IN = 16 * (NPROJ / 32), I_SQ = 16 * 32, I_Q = 16 * 64, I_PP = 4 * 32;
    constexpr int NITEMS = I_IN + 3 * I_SQ + I_Q + I_PP;
    for (int it = gw; it < NITEMS; it += NGW) {
        int r = it;
        if (r < I_IN) { p0_transpose_item(a.in[4], 1024, NPROJ, (bf16_t*)(ws + WS_WIN), 0, scr, r, F.lane); continue; } r -= I_IN;
        if (r < I_SQ) { p0_transpose_item(a.in[7], 1024, 1024, (bf16_t*)(ws + WS_WA), 0, scr, r, F.lane); continue; } r -= I_SQ;
        if (r < I_SQ) { p0_transpose_item(a.in[10], 1024, 1024, (bf16_t*)(ws + WS_WOUT), 0, scr, r, F.lane); continue; } r -= I_SQ;
        if (r < I_SQ) { p0_transpose_item(a.in[17], 1024, 1024, (bf16_t*)(ws + WS_WPGQ), 0, scr, r, F.lane); continue; } r -= I_SQ;
        if (r < I_Q) { p0_transpose_item(a.in[13], 1024, 2048, (bf16_t*)(ws + WS_WPGQ), 1024, scr, r, F.lane); continue; } r -= I_Q;
        p0_transpose_item(a.in[18], 256, 1024, (bf16_t*)(ws + WS_WPP), 0, scr, r, F.lane);
    }
    { bf16_t* wp = (bf16_t*)(ws + WS_WPOOL); const float* pw = a.in[8];
      for (size_t i = gtid; i < 1024 * 256; i += nthr) { const int o = (int)(i >> 8), j = (int)(i & 255), g = o >> 8, gsrc = 2 * (g >> 1) + (j >> 7);
          const float v = (gsrc == g) ? pw[((size_t)g * 128 + (j & 127)) * 256 + (o & 255)] : 0.f; wp[i] = (bf16_t)f2bf(v); } }
    { float* oml = (float*)(ws + WS_OML); const float* lb = a.in[5]; for (size_t i = gtid; i < 1024; i += nthr) oml[i] = sigmoidf_(lb[1024 + i] - lb[i]); }
    cvt_stream(a.in[14], (bf16_t*)(ws + WS_SK), (size_t)16 * 128 * 128 / 4, gtid, nthr);
    cvt_stream(a.in[1], (bf16_t*)(ws + WS_PB), (size_t)T * 256 / 4, gtid, nthr);
    cvt_stream(a.in[15], (bf16_t*)(ws + WS_UT), (size_t)NEXP * 1024 / 4, gtid, nthr);
    cvt_stream(a.in[16], (bf16_t*)(ws + WS_VT), (size_t)NEXP * 1024 / 4, gtid, nthr);
    { const float* x = a.in[0]; const float* g0 = a.in[2]; const float* b0 = a.in[3]; bf16_t* XN = (bf16_t*)(ws + WS_XN); float* st = (float*)(ws + WS_ST0);
      for (int m = gw; m < T; m += NGW) {
          const GAS f32x4* xr = (const GAS f32x4*)(x + (size_t)m * D) + F.lane;
          f32x4 v[4]; float s = 0.f;
#pragma unroll
          for (int j = 0; j < 4; ++j) { v[j] = xr[64 * j]; s += (v[j][0] + v[j][1]) + (v[j][2] + v[j][3]); }
          const float mean = wave_sum(s) * (1.f / D); float s2 = 0.f;
#pragma unroll
          for (int j = 0; j < 4; ++j) { v[j] = v[j] - mean; s2 += (v[j][0] * v[j][0] + v[j][1] * v[j][1]) + (v[j][2] * v[j][2] + v[j][3] * v[j][3]); }
          const float rstd = 1.f / sqrtf(wave_sum(s2) * (1.f / D) + LN_EPS);
          if (F.lane == 0) { st[2 * (size_t)m] = mean; st[2 * (size_t)m + 1] = rstd; }
          GAS u32x2* o8 = (GAS u32x2*)(XN + (size_t)m * D) + F.lane;
#pragma unroll
          for (int j = 0; j < 4; ++j) { const f32x4 gg = ((const GAS f32x4*)g0)[64 * j + F.lane], bb = ((const GAS f32x4*)b0)[64 * j + F.lane];
              const f32x4 h = v[j] * rstd * gg + bb; u32x2 o; o.x = pk2(h[0], h[1]); o.y = pk2(h[2], h[3]); o8[64 * j] = o; }
      } }
}

__device__ __forceinline__ void hgrn_unit(Frame& F, const Args& a, int unit) {
    unsigned char* ws = a.ws;
    const bf16_t* Qs = (const bf16_t*)(ws + WS_QS); const bf16_t* Kk = (const bf16_t*)(ws + WS_KK); const bf16_t* Vi = (const bf16_t*)(ws + WS_VI); const bf16_t* SG = (const bf16_t*)(ws + WS_SG);
    bf16_t* OG = (bf16_t*)(ws + WS_OG); const float* ng = a.in[6];
    const int b = unit >> 3, h = unit & 7, tid = F.tid;
    LAS float* Lq = (LAS float*)F.lds; LAS float* Lk = Lq + 4096; LAS float* Lf = Lk + 4096; LAS float* Lv = Lf + 4096; LAS float* Lo = Lv + 4096;
    const int dv = tid & 127, g = tid >> 7;
    float S[32];
#pragma unroll
    for (int j = 0; j < 32; ++j) S[j] = 0.f;
    const int lr = tid >> 4, lc = (tid & 15) * 8;
    for (int n = 0; n < SEQ / 32; ++n) {
        const size_t t0 = (size_t)b * SEQ + (size_t)n * 32;
        const size_t goff = (t0 + lr) * 1024 + h * 128 + lc;
        const u32x4 rq = *(const GAS u32x4*)(Qs + goff), rk = *(const GAS u32x4*)(Kk + goff), rv = *(const GAS u32x4*)(Vi + goff);
        f32x4 q0, q1, k0, k1, v0, v1; pg8::unpack8(rq, q0, q1); pg8::unpack8(rk, k0, k1); pg8::unpack8(rv, v0, v1);
        const int lo = lr * 128 + lc;
        *(LAS f32x4*)(Lq + lo) = q0; *(LAS f32x4*)(Lq + lo + 4) = q1;
        *(LAS f32x4*)(Lk + lo) = k0; *(LAS f32x4*)(Lk + lo + 4) = k1;
        *(LAS f32x4*)(Lf + lo) = 1.0f - k0; *(LAS f32x4*)(Lf + lo + 4) = 1.0f - k1;
        *(LAS f32x4*)(Lv + lo) = v0; *(LAS f32x4*)(Lv + lo + 4) = v1;
        __syncthreads();
#pragma unroll 2
        for (int tok = 0; tok < 32; ++tok) {
            const float vv = Lv[tok * 128 + dv]; float o = 0.f;
#pragma unroll
            for (int j4 = 0; j4 < 8; ++j4) {
                const f32x4 ff = *(const LAS f32x4*)(Lf + tok * 128 + 32 * g + 4 * j4), kk = *(const LAS f32x4*)(Lk + tok * 128 + 32 * g + 4 * j4), qq = *(const LAS f32x4*)(Lq + tok * 128 + 32 * g + 4 * j4);
#pragma unroll
                for (int i = 0; i < 4; ++i) { S[4 * j4 + i] = ff[i] * S[4 * j4 + i] + kk[i] * vv; o += S[4 * j4 + i] * qq[i]; }
            }
            Lo[(tok * 4 + g) * 128 + dv] = o;
        }
        __syncthreads();
        { const int tok = tid >> 4, c8 = (tid & 15) * 8; float ov[8]; float ss = 0.f;
#pragma unroll
          for (int i = 0; i < 8; ++i) { ov[i] = (Lo[(tok * 4 + 0) * 128 + c8 + i] + Lo[(tok * 4 + 1) * 128 + c8 + i]) + (Lo[(tok * 4 + 2) * 128 + c8 + i] + Lo[(tok * 4 + 3) * 128 + c8 + i]); ss += ov[i] * ov[i]; }
          ss += __shfl_xor(ss, 1); ss += __shfl_xor(ss, 2); ss += __shfl_xor(ss, 4); ss += __shfl_xor(ss, 8);
          const float rstd = 1.0f / sqrtf(ss * (1.0f / 128.0f) + RMS_EPS);
          const size_t go = (t0 + tok) * 1024 + h * 128 + c8;
          const u32x4 sgw = *(const GAS u32x4*)(SG + go); f32x4 s0, s1; pg8::unpack8(sgw, s0, s1);
          const f32x4 n0 = *(const GAS f32x4*)(ng + c8), n1 = *(const GAS f32x4*)(ng + c8 + 4);
          f32x4 r0, r1;
#pragma unroll
          for (int i = 0; i < 4; ++i) { r0[i] = ov[i] * rstd * n0[i] * s0[i]; r1[i] = ov[4 + i] * rstd * n1[i] * s1[i]; }
          *(GAS u32x4*)(OG + go) = pg8::pack8(r0, r1); }
    }
    __syncthreads();
}
__device__ __forceinline__ void pool_prep(Frame& F, const Args& a, size_t gtid, size_t nthr) {
    const bf16_t* VP = (const bf16_t*)(a.ws + WS_VP); bf16_t* PL = (bf16_t*)(a.ws + WS_PL);
    for (size_t item = gtid; item < (size_t)T * 64; item += nthr) {
        const int t = (int)(item >> 6), c8 = (int)(item & 63) * 8, gi = c8 >> 7, w = 2 << gi, pos = t & (SEQ - 1), cnt = (pos + 1 < w) ? pos + 1 : w;
        f32x4 s0 = {0.f, 0.f, 0.f, 0.f}, s1 = {0.f, 0.f, 0.f, 0.f}, c0, c1;
        for (int j = 0; j < cnt; ++j) { const u32x4 r = *(const GAS u32x4*)(VP + (size_t)(t - j) * 512 + c8); f32x4 a0, a1; pg8::unpack8(r, a0, a1); s0 += a0; s1 += a1; if (j == 0) { c0 = a0; c1 = a1; } }
        const float inv = 1.0f / (float)cnt;
        *(GAS u32x4*)(PL + (size_t)t * 512 + c8) = pg8::pack8(s0 * inv - c0, s1 * inv - c1);
    }
}

__device__ __forceinline__ void phase_ln1(Frame& F, const Args& a) {
    float* R1 = a.out; bf16_t* H1b = (bf16_t*)(a.ws + WS_H1B); const float* g1 = a.in[11]; const float* b1 = a.in[12];
    const int gw = F.vcu * NWAVES + F.wave, NGW = F.G * NWAVES;
    for (int m = gw; m < T; m += NGW) {
        GAS f32x4* xr = (GAS f32x4*)(R1 + (size_t)m * D) + F.lane;
        f32x4 v[4]; float s = 0.f;
#pragma unroll
        for (int j = 0; j < 4; ++j) { v[j] = xr[64 * j]; s += (v[j][0] + v[j][1]) + (v[j][2] + v[j][3]); }
        const float mean = wave_sum(s) * (1.f / D); float s2 = 0.f;
#pragma unroll
        for (int j = 0; j < 4; ++j) { v[j] = v[j] - mean; s2 += (v[j][0] * v[j][0] + v[j][1] * v[j][1]) + (v[j][2] * v[j][2] + v[j][3] * v[j][3]); }
        const float rstd = 1.f / sqrtf(wave_sum(s2) * (1.f / D) + LN_EPS);
        GAS u32x2* o8 = (GAS u32x2*)(H1b + (size_t)m * D) + F.lane;
#pragma unroll
        for (int j = 0; j < 4; ++j) { const f32x4 gg = ((const GAS f32x4*)g1)[64 * j + F.lane], bb = ((const GAS f32x4*)b1)[64 * j + F.lane];
            const f32x4 h = v[j] * rstd * gg + bb; xr[64 * j] = h; u32x2 o; o.x = pk2(h[0], h[1]); o.y = pk2(h[2], h[3]); o8[64 * j] = o; }
    }
}

__device__ __forceinline__ unsigned ordf(float f) { const unsigned b = __builtin_bit_cast(unsigned, f); return (b & 0x80000000u) ? ~b : (b | 0x80000000u); }
__device__ __forceinline__ float unordf(unsigned o) { const unsigned b = (o & 0x80000000u) ? (o & 0x7fffffffu) : ~o; return __builtin_bit_cast(float, b); }
__device__ __forceinline__ unsigned long long wave_max_u64(unsigned long long k) {
#pragma unroll
    for (int o = 32; o; o >>= 1) { const unsigned long long t = __shfl_xor(k, o); k = t > k ? t : k; }
    return k;
}
__device__ __forceinline__ void phase_topk(Frame& F, const Args& a) {
    constexpr int SKROW = 272;
    const bf16_t* SK = (const bf16_t*)(a.ws + WS_SK); const bf16_t* QRY = (const bf16_t*)(a.ws + WS_QRY);
    int* IDX = (int*)(a.ws + WS_IDX); float* GATE = (float*)(a.ws + WS_GATE);
    LAS unsigned char* Lsk = F.lds;
    LAS float* Lq = (LAS float*)(F.lds + 256 * SKROW) + F.wave * 256;
    const int lane = F.lane, tid = F.tid;
    for (int tb = F.vcu * 128; tb < T; tb += F.G * 128) {
        for (int h = 0; h < 8; ++h) {
            __syncthreads();
            for (int c = tid; c < 256 * 16; c += 512) { const int row = c >> 4, ch = c & 15;
                const u32x4 v = *(const GAS u32x4*)(SK + ((size_t)h * 256 + row) * 128 + ch * 8); *(LAS u32x4*)(Lsk + row * SKROW + ch * 16) = v; }
            __syncthreads();
            for (int tt = 0; tt < 16; ++tt) {
                const int t = tb + F.wave * 16 + tt;
                { const u32x2 qw = *(const GAS u32x2*)(QRY + (size_t)t * 2048 + h * 256 + lane * 4);
                  *(LAS f32x4*)(Lq + lane * 4) = (f32x4){bflo(qw.x), bfhi(qw.x), bflo(qw.y), bfhi(qw.y)}; }
                LDS_WAIT(); asm volatile("" ::: "memory");
                float s[2][2];
#pragma unroll
                for (int p = 0; p < 2; ++p)
#pragma unroll
                    for (int nn = 0; nn < 2; ++nn) { const LAS unsigned char* rowp = Lsk + (p * 128 + nn * 64 + lane) * SKROW; float acc = 0.f;
#pragma unroll 4
                        for (int kc = 0; kc < 16; ++kc) { const u32x4 w = *(const LAS u32x4*)(rowp + kc * 16); const f32x4 qa = *(const LAS f32x4*)(Lq + p * 128 + kc * 8), qb = *(const LAS f32x4*)(Lq + p * 128 + kc * 8 + 4);
                            acc += bflo(w.x) * qa[0]; acc += bfhi(w.x) * qa[1]; acc += bflo(w.y) * qa[2]; acc += bfhi(w.y) * qa[3];
                            acc += bflo(w.z) * qb[0]; acc += bfhi(w.z) * qb[1]; acc += bflo(w.w) * qb[2]; acc += bfhi(w.w) * qb[3]; }
                        s[p][nn] = acc; }
                float tv[2]; int ti[2];
#pragma unroll
                for (int p = 0; p < 2; ++p) {
                    unsigned long long k0 = ((unsigned long long)ordf(s[p][0]) << 32) | (unsigned)(0xFFFFFFFFu - (unsigned)lane);
                    unsigned long long k1 = ((unsigned long long)ordf(s[p][1]) << 32) | (unsigned)(0xFFFFFFFFu - (unsigned)(lane + 64));
                    tv[p] = 0.f; ti[p] = 0;
                    for (int r = 0; r < 16; ++r) { const unsigned long long m = wave_max_u64(k0 > k1 ? k0 : k1);
                        if (k0 == m) k0 = 0ull; if (k1 == m) k1 = 0ull;
                        if (lane == r) { tv[p] = unordf((unsigned)(m >> 32)); ti[p] = (int)(0xFFFFFFFFu - (unsigned)m); } }
                }
                unsigned long long ck[4];
                { const float va = __shfl(tv[0], lane >> 2);
#pragma unroll
                  for (int j = 0; j < 4; ++j) { const int bidx = 4 * (lane & 3) + j; const float vb = __shfl(tv[1], bidx); const unsigned pos = (unsigned)((lane >> 2) * 16 + bidx);
                      ck[j] = ((unsigned long long)ordf(va + vb) << 32) | (unsigned)(0xFFFFFFFFu - pos); } }
                float bv = 0.f; int bpos = 0;
                for (int r = 0; r < 16; ++r) { unsigned long long mx = ck[0] > ck[1] ? ck[0] : ck[1]; const unsigned long long m2 = ck[2] > ck[3] ? ck[2] : ck[3]; mx = mx > m2 ? mx : m2;
                    const unsigned long long m = wave_max_u64(mx);
#pragma unroll
                    for (int j = 0; j < 4; ++j) if (ck[j] == m) ck[j] = 0ull;
                    if (lane == r) { bv = unordf((unsigned)(m >> 32)); bpos = (int)(0xFFFFFFFFu - (unsigned)m); } }
                const int i1 = __shfl(ti[0], (bpos >> 4) & 15), i2 = __shfl(ti[1], bpos & 15);
                const float vmax = __shfl(bv, 0);
                const float e = (lane < 16) ? __expf(bv - vmax) : 0.f;
                const float esum = wave_sum(e);
                if (lane < 16) { IDX[(size_t)t * 128 + h * 16 + lane] = i1 * 128 + i2; GATE[(size_t)t * 128 + h * 16 + lane] = e / esum; }
            }
        }
    }
    __syncthreads();
}

__device__ __forceinline__ void phase_gather(Frame& F, const Args& a) {
    const bf16_t* UT = (const bf16_t*)(a.ws + WS_UT); const bf16_t* VT = (const bf16_t*)(a.ws + WS_VT); const bf16_t* PLE = (const bf16_t*)(a.ws + WS_PP);
    const int* IDX = (const int*)(a.ws + WS_IDX); const float* GATE = (const float*)(a.ws + WS_GATE);
    float* H = a.out; const float* g2 = a.in[19]; const float* b2 = a.in[20];
    const int gw = F.vcu * NWAVES + F.wave, NGW = F.G * NWAVES, lane = F.lane;
    for (int t = gw; t < T; t += NGW) {
        GAS f32x4* hp = (GAS f32x4*)(H + (size_t)t * D) + lane * 4;
        f32x4 hv[4];
#pragma unroll
        for (int i = 0; i < 4; ++i) hv[i] = hp[i];
        const int id0 = IDX[(size_t)t * 128 + lane], id1 = IDX[(size_t)t * 128 + 64 + lane];
        const float gt0 = GATE[(size_t)t * 128 + lane], gt1 = GATE[(size_t)t * 128 + 64 + lane];
        f32x4 acc[4];
#pragma unroll
        for (int i = 0; i < 4; ++i) acc[i] = (f32x4){0.f, 0.f, 0.f, 0.f};
#pragma unroll 4
        for (int k = 0; k < 128; ++k) {
            const int e = __builtin_amdgcn_readlane(k < 64 ? id0 : id1, k & 63);
            const float gt = __builtin_bit_cast(float, __builtin_amdgcn_readlane(__builtin_bit_cast(int, k < 64 ? gt0 : gt1), k & 63));
            const GAS u32x4* up = (const GAS u32x4*)(UT + (size_t)e * D) + lane * 2;
            const GAS u32x4* vp = (const GAS u32x4*)(VT + (size_t)e * D) + lane * 2;
            const u32x4 ua = up[0], ub = up[1], va = vp[0], vb = vp[1];
            f32x4 u0, u1, u2, u3; pg8::unpack8(ua, u0, u1); pg8::unpack8(ub, u2, u3);
            const f32x4 pr = hv[0] * u0 + hv[1] * u1 + hv[2] * u2 + hv[3] * u3;
            const float s = wave_sum((pr[0] + pr[1]) + (pr[2] + pr[3]));
            const float act = 0.5f * s * (1.0f + erff(s * 0.70710678118654752f)) * gt;
            f32x4 v0, v1, v2, v3; pg8::unpack8(va, v0, v1); pg8::unpack8(vb, v2, v3);
            acc[0] += v0 * act; acc[1] += v1 * act; acc[2] += v2 * act; acc[3] += v3 * act;
        }
        const GAS u32x4* pp = (const GAS u32x4*)(PLE + (size_t)t * D) + lane * 2;
        const u32x4 pa = pp[0], pb = pp[1]; f32x4 p0, p1, p2, p3; pg8::unpack8(pa, p0, p1); pg8::unpack8(pb, p2, p3);
        f32x4 r[4]; r[0] = hv[0] * ALPHA + acc[0] + p0; r[1] = hv[1] * ALPHA + acc[1] + p1; r[2] = hv[2] * ALPHA + acc[2] + p2; r[3] = hv[3] * ALPHA + acc[3] + p3;
        float s = 0.f;
#pragma unroll
        for (int i = 0; i < 4; ++i) s += (r[i][0] + r[i][1]) + (r[i][2] + r[i][3]);
        const float mean = wave_sum(s) * (1.f / D); float s2 = 0.f;
#pragma unroll
        for (int i = 0; i < 4; ++i) { r[i] = r[i] - mean; s2 += (r[i][0] * r[i][0] + r[i][1] * r[i][1]) + (r[i][2] * r[i][2] + r[i][3] * r[i][3]); }
        const float rstd = 1.f / sqrtf(wave_sum(s2) * (1.f / D) + LN_EPS);
#pragma unroll
        for (int i = 0; i < 4; ++i) { const f32x4 gg = ((const GAS f32x4*)g2)[lane * 4 + i], bb = ((const GAS f32x4*)b2)[lane * 4 + i]; hp[i] = r[i] * rstd * gg + bb; }
    }
}

constexpr int NPHASE = 9;
__global__ void __launch_bounds__(NWAVES * 64, 2) mk_fwd(Args args) {
    extern __shared__ __attribute__((aligned(16))) unsigned char lds[];
    Frame F;
    F.lds = (LAS unsigned char*)lds;
    F.MISC = (volatile LAS unsigned*)(F.lds + MISC_OFF);
    F.tid = threadIdx.x; F.lane = F.tid & 63; F.wave = __builtin_amdgcn_readfirstlane(F.tid >> 6);
    F.G = gridDim.x; { const int bx = blockIdx.x; F.vcu = (F.G % 8 == 0) ? (bx % 8) * (F.G / 8) + bx / 8 : bx; }
    unsigned char* ws = args.ws;
    F.ctl = (gu32*)(ws + WS_CTL);
    for (int u = F.tid; u < (LDS_BYTES - LDSCTL_OFF) / 4; u += NWAVES * 64) ((LAS unsigned*)(F.lds + LDSCTL_OFF))[u] = 0u;
    __syncthreads();
    const int lo = args.ph_lo, hi = args.ph_hi;
    const bool one = (hi - lo) > 1;
    XcdBarrier bar; bar.bar = (unsigned*)(F.ctl + CW_BAR); bar.x = 0; bar.st = nullptr;
    if (one) bar = xcd_barrier_post((unsigned*)(F.ctl + CW_BAR), F.MISC + 8);
#ifndef PH_MASK
#define PH_MASK 0xFFFF
#endif
#define IN(k) (((PH_MASK >> (k)) & 1) && lo <= (k) && (k) < hi)
#define SEAM(k) do { if (IN(k) && IN((k) + 1)) xcd_barrier(bar); } while (0)
    bf16_t* const GA = (bf16_t*)args.out; bf16_t* const GB = (bf16_t*)args.out + (size_t)T * 1024;

    if (IN(0)) { phase_prologue(F, args); SEAM(0); }
    if (IN(1)) {
        pg8::Gemm g{(const bf16_t*)(ws + WS_XN), (const bf16_t*)(ws + WS_WIN), T, NPROJ, 1024, 1024, 1024, 0, 0};
        pg8::StaticOrder S; S.init(T, NPROJ, F.G, (int)blockIdx.x);
        pg8::EpiProj E{(bf16_t*)(ws + WS_QS), (bf16_t*)(ws + WS_KK), (bf16_t*)(ws + WS_VI), (bf16_t*)(ws + WS_SG), (bf16_t*)(ws + WS_VP), GA, GB, (const float*)(ws + WS_OML)};
        pg8::gemm_phase<pg8::EpiProj>(F.lds, g, S, E);
        SEAM(1);
    }
    if (IN(2)) {
        const int nh = F.G > 64 ? 64 : F.G;
        if ((int)blockIdx.x < nh) { for (int u = blockIdx.x; u < 64; u += nh) hgrn_unit(F, args, u); }
        if (F.G <= 64) pool_prep(F, args, (size_t)blockIdx.x * 512 + F.tid, (size_t)F.G * 512);
        else if ((int)blockIdx.x >= 64) pool_prep(F, args, (size_t)(blockIdx.x - 64) * 512 + F.tid, (size_t)(F.G - 64) * 512);
        SEAM(2);
    }
    if (IN(3)) {
        { pg8::Gemm g{(const bf16_t*)(ws + WS_PL), (const bf16_t*)(ws + WS_WPOOL), T, 1024, 256, 512, 256, 1, 256};
          pg8::StaticOrder S; S.init(T, 1024, F.G, (int)blockIdx.x);
          pg8::EpiYB E{(bf16_t*)(ws + WS_YB), GB, args.in[9]};
          pg8::gemm_phase<pg8::EpiYB>(F.lds, g, S, E); }
        { pg8::Gemm g{(const bf16_t*)(ws + WS_OG), (const bf16_t*)(ws + WS_WA), T, 1024, 1024, 1024, 1024, 0, 0};
          pg8::StaticOrder S; S.init(T, 1024, F.G, (int)blockIdx.x);
          pg8::EpiMix E{(bf16_t*)(ws + WS_MIX), GA, (const bf16_t*)(ws + WS_YB)};
          pg8::gemm_phase<pg8::EpiMix>(F.lds, g, S, E); }
        { pg8::Gemm g{(const bf16_t*)(ws + WS_PB), (const bf16_t*)(ws + WS_WPP), T, 1024, 256, 256, 256, 0, 0};
          pg8::StaticOrder S; S.init(T, 1024, F.G, (int)blockIdx.x);
          pg8::EpiPlain E{(bf16_t*)(ws + WS_PP), 1024};
          pg8::gemm_phase<pg8::EpiPlain>(F.lds, g, S, E); }
        SEAM(3);
    }
    if (IN(4)) {
        pg8::Gemm g{(const bf16_t*)(ws + WS_MIX), (const bf16_t*)(ws + WS_WOUT), T, 1024, 1024, 1024, 1024, 0, 0};
        pg8::StaticOrder S; S.init(T, 1024, F.G, (int)blockIdx.x);
        pg8::EpiR1 E{args.out, args.in[0], (const float*)(ws + WS_ST0), args.in[2], args.in[3]};
        pg8::gemm_phase<pg8::EpiR1>(F.lds, g, S, E);
        SEAM(4);
    }
    if (IN(5)) { phase_ln1(F, args); SEAM(5); }
    if (IN(6)) {
        pg8::Gemm g{(const bf16_t*)(ws + WS_H1B), (const bf16_t*)(ws + WS_WPGQ), T, 3072, 1024, 1024, 1024, 0, 0};
        pg8::StaticOrder S; S.init(T, 3072, F.G, (int)blockIdx.x);
        pg8::EpiPgq E{(bf16_t*)(ws + WS_PP), (bf16_t*)(ws + WS_QRY)};
        pg8::gemm_phase<pg8::EpiPgq>(F.lds, g, S, E);
        SEAM(6);
    }
    if (IN(7)) { phase_topk(F, args); SEAM(7); }
    if (IN(8)) { phase_gather(F, args); }
#undef IN
#undef SEAM
}

extern "C" void kernel_launch(void* const* d_in, const int* in_sizes, int n_in, void* d_out, int out_size, void* d_ws, size_t ws_size, hipStream_t stream) {
    static int grid = 0;
    if (grid == 0) {
        if (n_in != 21 || out_size != T * D || ws_size < WS_END) { fprintf(stderr, "kernel_launch: unexpected shapes (n_in %d, out %d, ws %zu)\n", n_in, out_size, ws_size); grid = -1; return; }
        int dev = 0, cus = 0, per_cu = 0;
        if (hipGetDevice(&dev) != hipSuccess || hipDeviceGetAttribute(&cus, hipDeviceAttributeMultiprocessorCount, dev) != hipSuccess) { grid = -1; return; }
        if (hipFuncSetAttribute((const void*)mk_fwd, hipFuncAttributeMaxDynamicSharedMemorySize, LDS_BYTES) != hipSuccess) { fprintf(stderr, "kernel_launch: hipFuncSetAttribute failed\n"); grid = -1; return; }
        if (hipOccupancyMaxActiveBlocksPerMultiprocessor(&per_cu, (const void*)mk_fwd, NWAVES * 64, LDS_BYTES) != hipSuccess || per_cu < 1)
            fprintf(stderr, "kernel_launch: occupancy query reports %d\n", per_cu);
        (void)hipGetLastError();
        grid = cus;
    }
    if (grid < 0) return;
    (void)hipMemsetAsync((char*)d_ws + WS_CTL, 0, CTL_ZERO_BYTES, stream);
    Args a{};
    for (int i = 0; i < 21; ++i) a.in[i] = (const float*)d_in[i];
    a.out = (float*)d_out; a.ws = (unsigned char*)d_ws;
#if MK_ONE_LAUNCH
    a.ph_lo = 0; a.ph_hi = NPHASE;
    hipLaunchKernelGGL(mk_fwd, dim3(grid), dim3(NWAVES * 64), LDS_BYTES, stream, a);
#else
    for (int p = 0; p < NPHASE; ++p) { a.ph_lo = p; a.ph_hi = p + 1; hipLaunchKernelGGL(mk_fwd, dim3(grid), dim3(NWAVES * 64), LDS_BYTES, stream, a); }
#endif
}
```

```cpp
#include <hip/hip_runtime.h>
#include <cstdio>
#include <cstdint>

#ifndef MK_ONE_LAUNCH
#define MK_ONE_LAUNCH 1
#endif

#define LAS __attribute__((address_space(3)))
#define GAS __attribute__((address_space(1)))
typedef unsigned short bf16_t;
typedef short bf16x8 __attribute__((ext_vector_type(8)));
typedef float f32x4 __attribute__((ext_vector_type(4)));
typedef float f32x2 __attribute__((ext_vector_type(2)));
typedef unsigned u32x4 __attribute__((ext_vector_type(4)));
typedef unsigned u32x2 __attribute__((ext_vector_type(2)));

constexpr int BATCH = 8, SEQ = 4096, T = BATCH * SEQ, D = 1024;
constexpr int NPROJ = 6656;
constexpr int NEXP = 16384;
constexpr float ALPHA = 1.189207115002721f;
constexpr float LN_EPS = 1e-5f, RMS_EPS = 1e-6f;
constexpr int NWAVES = 8;

constexpr size_t MiB = 1u << 20;
constexpr size_t WS_CTL = 0, CTL_ZERO_BYTES = 1 * MiB;
constexpr size_t WS_OML = 1 * MiB;
constexpr size_t WS_ST0 = 1 * MiB + 65536;
constexpr size_t WS_WIN = 2 * MiB;
constexpr size_t WS_WA = 15 * MiB;
constexpr size_t WS_WOUT = 17 * MiB;
constexpr size_t WS_WPGQ = 19 * MiB;
constexpr size_t WS_WPP = 25 * MiB;
constexpr size_t WS_WPOOL = 25 * MiB + 512 * 1024;
constexpr size_t WS_SK = 26 * MiB;
constexpr size_t WS_PB = 27 * MiB;
constexpr size_t WS_UT = 43 * MiB;
constexpr size_t WS_VT = 75 * MiB;
constexpr size_t WS_XN = 108 * MiB;
constexpr size_t WS_QS = 172 * MiB, WS_KK = 236 * MiB, WS_VI = 300 * MiB, WS_SG = 364 * MiB;
constexpr size_t WS_VP = 428 * MiB, WS_PL = 460 * MiB;
constexpr size_t WS_END = 492 * MiB;
constexpr size_t WS_OG = WS_XN, WS_YB = WS_QS, WS_MIX = WS_KK, WS_PP = WS_VI, WS_H1B = WS_SG, WS_QRY = WS_QS;
constexpr size_t WS_IDX = WS_VP, WS_GATE = WS_VP + 16 * MiB;

constexpr int RING_BYTES = 131072;
constexpr int LDSCTL_OFF = RING_BYTES, MISC_OFF = LDSCTL_OFF + 320;
constexpr int LDS_BYTES = 147456;

__device__ __forceinline__ unsigned f2bf(float f) { unsigned u = __builtin_bit_cast(unsigned, f); return (u + 0x7fffu + ((u >> 16) & 1u)) >> 16; }
__device__ __forceinline__ unsigned pk2(float lo, float hi) { return f2bf(lo) | (f2bf(hi) << 16); }
__device__ __forceinline__ float bflo(unsigned w) { return __builtin_bit_cast(float, w << 16); }
__device__ __forceinline__ float bfhi(unsigned w) { return __builtin_bit_cast(float, w & 0xffff0000u); }
__device__ __forceinline__ unsigned cvt_pk_bf16(float lo, float hi) { unsigned r; asm volatile("v_cvt_pk_bf16_f32 %0, %1, %2" : "=v"(r) : "v"(lo), "v"(hi)); return r; }
__device__ __forceinline__ float sigmoidf_(float x) { return __builtin_amdgcn_rcpf(1.0f + __expf(-x)); }
__device__ __forceinline__ float wave_sum(float v) {
#pragma unroll
    for (int o = 1; o < 64; o <<= 1) v += __shfl_xor(v, o);
    return v;
}
#define LDS_WAIT() asm volatile("s_waitcnt lgkmcnt(0)" ::: "memory")
#define VM_WAIT() asm volatile("s_waitcnt vmcnt(0)" ::: "memory")

namespace pg8 {
constexpr int BM = 256, BK = 64, HALF = 128, HTB = HALF * BK * 2, STAGE_BYTES = 8 * HTB, NXCD = 8, WGM = 8;
__host__ __device__ __forceinline__ int lds_byte(int r, int c) { const int st = (r >> 4) * 2 + (c >> 5), rr = r & 15, cc = c & 31, ob = rr * 64 + cc * 2; return st * 1024 + (ob ^ (((ob >> 9) & 1) << 5)); }
__host__ __device__ __forceinline__ void stage_rc(int b, int& R, int& C) { const int st = b / 1024, sb = b % 1024, swz = sb ^ (((sb >> 9) & 1) << 5); R = (st >> 1) * 16 + swz / 64; C = (st & 1) * 32 + (swz % 64) / 2; }
__host__ __device__ __forceinline__ int perm32(int rho) { const int n = rho >> 4, i = rho & 15; return 8 * (i >> 2) + 4 * n + (i & 3); }

struct Unit { int pm, pn; };
struct Gemm { const bf16_t* A; const bf16_t* Bt; int M, N, K, lda, ldb, acol_shift, acol_mul; };

struct StaticOrder {
    int nM, nN, nwg, G, c;
    __host__ __device__ void init(int M, int N, int G_, int c_) { nM = M / BM; nN = N / BM; nwg = nM * nN; G = G_; c = c_; }
    __host__ __device__ bool next(int i, Unit& u) const {
        const long L = (long)i * G + c; if (L >= nwg) return false;
        int wgid = (int)L; { const int q = nwg / NXCD, r = nwg % NXCD, xcd = wgid % NXCD, off = wgid / NXCD; wgid = (xcd < r ? xcd * (q + 1) : r * (q + 1) + (xcd - r) * q) + off; }
        const int nig = WGM * nN, gid = wgid / nig, fm = gid * WGM, gsz = (nM - fm) < WGM ? (nM - fm) : WGM;
        u.pm = fm + ((wgid % nig) % gsz); u.pn = (wgid % nig) / gsz; return true;
    }
};


template <class Epi>
__device__ __forceinline__ void gemm_phase(LAS unsigned char* lds, const Gemm g, const StaticOrder& S, const Epi& E) {
    const int tid = threadIdx.x, wid = __builtin_amdgcn_readfirstlane(tid >> 6), lane = tid & 63, wr = wid >> 2, wc = wid & 3, fr = lane & 15, fq = lane >> 4;
    int K_ = g.K; asm volatile("" : "+s"(K_));
    const int K = K_, nt = K / BK;
    unsigned voffA[2], voffB[2];
#pragma unroll
    for (int i = 0; i < 2; ++i) { int R, C; stage_rc(tid * 16 + i * 8192, R, C); const int Rb = Epi::PERM ? ((R & ~31) + perm32(R & 31)) : R;
        voffA[i] = (unsigned)(R * g.lda + C) * 2u; voffB[i] = (unsigned)(Rb * g.ldb + C) * 2u; }
    const size_t kstep = (size_t)(BK * 2);
    const size_t hstepA = (size_t)HALF * g.lda * 2, hstepB = (size_t)HALF * g.ldb * 2;
    const size_t tstepA = 2 * hstepA, tstepB = 2 * hstepB;
    const unsigned ldsw = (unsigned)wid * 1024u;
    const int aoff = lds_byte(wr * 64 + fr, fq * 8), boff = lds_byte(wc * 32 + fr, fq * 8);
#define PG8_SA(b, h) (((b) * 2 + (h)) * HTB)
#define PG8_SB(b, h) ((4 + (b) * 2 + (h)) * HTB)
#define PG8_STAGE(bufoff, gbase, voff) do { _Pragma("unroll") for (int _i = 0; _i < 2; ++_i) \
        __builtin_amdgcn_global_load_lds((const unsigned*)((const char*)(gbase) + (voff)[_i]), (LAS unsigned*)(lds + (bufoff) + ldsw + _i * 8192), 16, 0, 0); } while (0)
#define PG8_LDA(dst, b, h) do { _Pragma("unroll") for (int m = 0; m < 4; ++m) _Pragma("unroll") for (int k = 0; k < 2; ++k) dst[m][k] = *(const LAS bf16x8*)(lds + PG8_SA(b, h) + aoff + m * 2048 + k * 1024); } while (0)
#define PG8_LDB(dst, b, h) do { _Pragma("unroll") for (int n = 0; n < 2; ++n) _Pragma("unroll") for (int k = 0; k < 2; ++k) dst[n][k] = *(const LAS bf16x8*)(lds + PG8_SB(b, h) + boff + n * 2048 + k * 1024); } while (0)
#define PG8_MMA(ai, bj, At, Bt) do { __builtin_amdgcn_s_setprio(1); _Pragma("unroll") for (int m = 0; m < 4; ++m) _Pragma("unroll") for (int n = 0; n < 2; ++n) _Pragma("unroll") for (int k = 0; k < 2; ++k) \
        acc[ai][bj][m][n] = __builtin_amdgcn_mfma_f32_16x16x32_bf16(Bt[n][k], At[m][k], acc[ai][bj][m][n], 0, 0, 0); __builtin_amdgcn_s_setprio(0); } while (0)
#define PG8_WAIT_V(n) asm volatile("s_waitcnt vmcnt(" #n ")" ::: "memory")
#define PG8_WAIT_L(n) asm volatile("s_waitcnt lgkmcnt(" #n ")" ::: "memory")
#define PG8_BAR __builtin_amdgcn_s_barrier()
#define PG8_SCHED __builtin_amdgcn_sched_barrier(0)
    Unit cur, nxt; int ui = 0;
    if (!S.next(0, cur)) return;
    f32x4 acc[2][2][4][2];
#pragma unroll
    for (int a = 0; a < 2; ++a)
#pragma unroll
        for (int b = 0; b < 2; ++b)
#pragma unroll
            for (int m = 0; m < 4; ++m)
#pragma unroll
                for (int n = 0; n < 2; ++n) acc[a][b][m][n] = (f32x4){0.f, 0.f, 0.f, 0.f};
    bf16x8 At[4][2], B0[2][2], B1[2][2];
    const char* cA = (const char*)g.A + (size_t)cur.pm * tstepA + (size_t)((cur.pn >> g.acol_shift) * g.acol_mul) * 2; const char* cB = (const char*)g.Bt + (size_t)cur.pn * tstepB;
    PG8_STAGE(PG8_SB(0, 0), cB, voffB); PG8_STAGE(PG8_SB(0, 1), cB + hstepB, voffB); PG8_STAGE(PG8_SA(0, 0), cA, voffA); PG8_STAGE(PG8_SA(0, 1), cA + hstepA, voffA);
    if (wr == 1) PG8_BAR;
    PG8_WAIT_V(2); PG8_BAR;
    PG8_STAGE(PG8_SB(1, 0), cB + kstep, voffB); PG8_STAGE(PG8_SA(1, 0), cA + kstep, voffA); PG8_STAGE(PG8_SB(1, 1), cB + hstepB + kstep, voffB);
    PG8_WAIT_V(6); PG8_BAR;
    for (;;) {
        const bool has_next = S.next(ui + 1, nxt);
        const char* nA = has_next ? (const char*)g.A + (size_t)nxt.pm * tstepA + (size_t)((nxt.pn >> g.acol_shift) * g.acol_mul) * 2 : cA;
        const char* nB = has_next ? (const char*)g.Bt + (size_t)nxt.pn * tstepB : cB;
        for (int t = 0; t < nt; t += 2) {
            const bool last = (t == nt - 2);
            const char* a1 = cA + (size_t)(t + 1) * kstep;
            const char* a2 = last ? nA : cA + (size_t)(t + 2) * kstep; const char* b2 = last ? nB : cB + (size_t)(t + 2) * kstep;
            const char* a3 = a2 + kstep; const char* b3 = b2 + kstep;
            PG8_LDB(B0, 0, 0); PG8_LDB(B1, 0, 1); PG8_SCHED; PG8_LDA(At, 0, 0); PG8_STAGE(PG8_SA(1, 1), a1 + hstepA, voffA);
            PG8_WAIT_V(8); PG8_WAIT_L(0); PG8_BAR; PG8_MMA(0, 0, At, B0); PG8_MMA(0, 1, At, B1); PG8_BAR; PG8_SCHED;
            PG8_LDA(At, 0, 1); PG8_STAGE(PG8_SB(0, 0), b2, voffB); PG8_STAGE(PG8_SB(0, 1), b2 + hstepB, voffB); PG8_STAGE(PG8_SA(0, 0), a2, voffA);
            PG8_WAIT_V(8); PG8_WAIT_L(0); PG8_BAR; PG8_MMA(1, 0, At, B0); PG8_MMA(1, 1, At, B1); PG8_BAR; PG8_SCHED;
            PG8_LDB(B0, 1, 0); PG8_LDB(B1, 1, 1); PG8_SCHED; PG8_LDA(At, 1, 0); PG8_STAGE(PG8_SA(0, 1), a2 + hstepA, voffA);
            PG8_WAIT_V(8); PG8_WAIT_L(0); PG8_BAR; PG8_MMA(0, 0, At, B0); PG8_MMA(0, 1, At, B1); PG8_BAR; PG8_SCHED;
            PG8_LDA(At, 1, 1); PG8_STAGE(PG8_SB(1, 0), b3, voffB); PG8_STAGE(PG8_SB(1, 1), b3 + hstepB, voffB); PG8_STAGE(PG8_SA(1, 0), a3, voffA);
            PG8_WAIT_V(8); PG8_WAIT_L(0); PG8_BAR; PG8_MMA(1, 0, At, B0); PG8_MMA(1, 1, At, B1); PG8_BAR; PG8_SCHED;
        }
        if (wr == 0) PG8_BAR;
        E(acc, cur, wr, wc, fr, fq);
        if (!has_next) break;
#pragma unroll
        for (int a = 0; a < 2; ++a)
#pragma unroll
            for (int b = 0; b < 2; ++b)
#pragma unroll
                for (int m = 0; m < 4; ++m)
#pragma unroll
                    for (int n = 0; n < 2; ++n) acc[a][b][m][n] = (f32x4){0.f, 0.f, 0.f, 0.f};
        cur = nxt; cA = nA; cB = nB; ++ui;
        if (wr == 1) PG8_BAR;
    }
    PG8_WAIT_V(0);
    PG8_BAR;
#undef PG8_SA
#undef PG8_SB
#undef PG8_STAGE
#undef PG8_LDA
#undef PG8_LDB
#undef PG8_MMA
#undef PG8_WAIT_V
#undef PG8_WAIT_L
#undef PG8_BAR
#undef PG8_SCHED
}

#define EPI_FENCE() asm volatile("" ::: "memory")
__device__ __forceinline__ u32x4 pack8(const f32x4& v0, const f32x4& v1) { u32x4 w; w.x = cvt_pk_bf16(v0[0], v0[1]); w.y = cvt_pk_bf16(v0[2], v0[3]); w.z = cvt_pk_bf16(v1[0], v1[1]); w.w = cvt_pk_bf16(v1[2], v1[3]); return w; }
__device__ __forceinline__ void unpack8(const u32x4& w, f32x4& v0, f32x4& v1) { v0 = (f32x4){bflo(w.x), bfhi(w.x), bflo(w.y), bfhi(w.y)}; v1 = (f32x4){bflo(w.z), bfhi(w.z), bflo(w.w), bfhi(w.w)}; }

struct EpiProj {
    static constexpr bool PERM = true;
    bf16_t *Qs, *Kk, *Vi, *SG, *VP, *GA, *GB; const float* oml;
    __device__ __forceinline__ void operator()(const f32x4 (&acc)[2][2][4][2], const Unit& u, int wr, int wc, int fr, int fq) const {
        const int pn = u.pn; bf16_t* base; int ldc = 1024, ct, mode;
        if (pn < 4) { base = Qs; ct = pn; mode = 0; } else if (pn < 8) { base = Kk; ct = pn - 4; mode = 1; } else if (pn < 12) { base = Vi; ct = pn - 8; mode = 2; }
        else if (pn < 16) { base = SG; ct = pn - 12; mode = 3; } else if (pn < 18) { base = VP; ct = pn - 16; mode = 2; ldc = 512; }
        else if (pn < 22) { base = GA; ct = pn - 18; mode = 4; } else { base = GB; ct = pn - 22; mode = 4; }
        const int row0 = u.pm * BM + wr * 64 + fr, col0 = ct * 256 + wc * 32 + 8 * fq;
        f32x4 om[2][2];
#pragma unroll
        for (int bj = 0; bj < 2; ++bj)
#pragma unroll
            for (int n = 0; n < 2; ++n) om[bj][n] = (mode == 1) ? *(const f32x4*)(oml + col0 + bj * HALF + 4 * n) : (f32x4){1.f, 1.f, 1.f, 1.f};
#pragma unroll
        for (int ai = 0; ai < 2; ++ai)
#pragma unroll
            for (int m = 0; m < 4; ++m) { bf16_t* rowp = base + (size_t)(row0 + ai * HALF + m * 16) * ldc + col0;
#pragma unroll
                for (int bj = 0; bj < 2; ++bj) { f32x4 v[2] = {acc[ai][bj][m][0], acc[ai][bj][m][1]};
#pragma unroll
                    for (int n = 0; n < 2; ++n)
#pragma unroll
                        for (int e = 0; e < 4; ++e) { const float x = v[n][e]; float y;
                            if (mode == 0) y = x * sigmoidf_(x) * 0.08838834764831845f;
                            else if (mode == 1) y = om[bj][n][e] * sigmoidf_(-x);
                            else if (mode == 2) y = x;
                            else if (mode == 3) y = x * sigmoidf_(x);
                            else y = sigmoidf_(x);
                            v[n][e] = y; }
                    *(u32x4*)(rowp + bj * HALF) = pack8(v[0], v[1]); } }
    }
};
struct EpiPlain {
    static constexpr bool PERM = true;
    bf16_t* O; int ldc;
    __device__ __forceinline__ void operator()(const f32x4 (&acc)[2][2][4][2], const Unit& u, int wr, int wc, int fr, int fq) const {
        const int row0 = u.pm * BM + wr * 64 + fr, col0 = u.pn * BM + wc * 32 + 8 * fq;
#pragma unroll
        for (int ai = 0; ai < 2; ++ai)
#pragma unroll
            for (int m = 0; m < 4; ++m) { bf16_t* rowp = O + (size_t)(row0 + ai * HALF + m * 16) * ldc + col0;
#pragma unroll
                for (int bj = 0; bj < 2; ++bj) *(u32x4*)(rowp + bj * HALF) = pack8(acc[ai][bj][m][0], acc[ai][bj][m][1]); }
    }
};
struct EpiYB {
    static constexpr bool PERM = true;
    bf16_t* YB; const bf16_t* GB; const float* scale;
    __device__ __forceinline__ void operator()(const f32x4 (&acc)[2][2][4][2], const Unit& u, int wr, int wc, int fr, int fq) const {
        const int row0 = u.pm * BM + wr * 64 + fr, col0 = u.pn * BM + wc * 32 + 8 * fq;
        f32x4 sc[2][2];
#pragma unroll
        for (int bj = 0; bj < 2; ++bj)
#pragma unroll
            for (int n = 0; n < 2; ++n) sc[bj][n] = *(const f32x4*)(scale + col0 + bj * HALF + 4 * n);
#pragma unroll
        for (int ai = 0; ai < 2; ++ai)
#pragma unroll
            for (int m = 0; m < 4; ++m) { const size_t off = (size_t)(row0 + ai * HALF + m * 16) * 1024 + col0;
#pragma unroll
                for (int bj = 0; bj < 2; ++bj) { const u32x4 gw = *(const u32x4*)(GB + off + bj * HALF); f32x4 g0, g1; unpack8(gw, g0, g1);
                    const f32x4 v0 = acc[ai][bj][m][0] * sc[bj][0] * g0, v1 = acc[ai][bj][m][1] * sc[bj][1] * g1;
                    *(u32x4*)(YB + off + bj * HALF) = pack8(v0, v1); }
                EPI_FENCE(); }
    }
};
struct EpiMix {
    static constexpr bool PERM = true;
    bf16_t* MIX; const bf16_t* GA; const bf16_t* YB;
    __device__ __forceinline__ void operator()(const f32x4 (&acc)[2][2][4][2], const Unit& u, int wr, int wc, int fr, int fq) const {
        const int row0 = u.pm * BM + wr * 64 + fr, col0 = u.pn * BM + wc * 32 + 8 * fq;
#pragma unroll
        for (int ai = 0; ai < 2; ++ai)
#pragma unroll
            for (int m = 0; m < 4; ++m) { const size_t off = (size_t)(row0 + ai * HALF + m * 16) * 1024 + col0;
#pragma unroll
                for (int bj = 0; bj < 2; ++bj) { const u32x4 gw = *(const u32x4*)(GA + off + bj * HALF), yw = *(const u32x4*)(YB + off + bj * HALF);
                    f32x4 g0, g1, y0, y1; unpack8(gw, g0, g1); unpack8(yw, y0, y1);
                    const f32x4 v0 = acc[ai][bj][m][0] * g0 + y0, v1 = acc[ai][bj][m][1] * g1 + y1;
                    *(u32x4*)(MIX + off + bj * HALF) = pack8(v0, v1); }
                EPI_FENCE(); }
    }
};
struct EpiR1 {
    static constexpr bool PERM = false;
    float* R1; const float* x; const float* st0; const float* g0; const float* b0;
    __device__ __forceinline__ void operator()(const f32x4 (&acc)[2][2][4][2], const Unit& u, int wr, int wc, int fr, int fq) const {
        const int row0 = u.pm * BM + wr * 64 + fr, col0 = u.pn * BM + wc * 32 + 4 * fq;
        f32x4 gg[2][2], bb[2][2];
#pragma unroll
        for (int bj = 0; bj < 2; ++bj)
#pragma unroll
            for (int n = 0; n < 2; ++n) { gg[bj][n] = *(const f32x4*)(g0 + col0 + bj * HALF + 16 * n); bb[bj][n] = *(const f32x4*)(b0 + col0 + bj * HALF + 16 * n); }
#pragma unroll
        for (int ai = 0; ai < 2; ++ai)
#pragma unroll
            for (int m = 0; m < 4; ++m) { const int r = row0 + ai * HALF + m * 16; const size_t off = (size_t)r * 1024 + col0; const f32x2 ms = *(const f32x2*)(st0 + 2 * (size_t)r);
#pragma unroll
                for (int bj = 0; bj < 2; ++bj)
#pragma unroll
                    for (int n = 0; n < 2; ++n) { const f32x4 xv = *(const f32x4*)(x + off + bj * HALF + 16 * n);
                        const f32x4 h = (xv - ms.x) * ms.y * gg[bj][n] + bb[bj][n];
                        *(f32x4*)(R1 + off + bj * HALF + 16 * n) = h * ALPHA + acc[ai][bj][m][n]; }
                EPI_FENCE(); }
    }
};
struct EpiPgq {
    static constexpr bool PERM = true;
    bf16_t* PP; bf16_t* QRY;
    __device__ __forceinline__ void operator()(const f32x4 (&acc)[2][2][4][2], const Unit& u, int wr, int wc, int fr, int fq) const {
        const int row0 = u.pm * BM + wr * 64 + fr;
        if (u.pn < 4) {
            const int col0 = u.pn * BM + wc * 32 + 8 * fq;
#pragma unroll
            for (int ai = 0; ai < 2; ++ai)
#pragma unroll
                for (int m = 0; m < 4; ++m) { const size_t off = (size_t)(row0 + ai * HALF + m * 16) * 1024 + col0;
#pragma unroll
                    for (int bj = 0; bj < 2; ++bj) { const u32x4 pw = *(const u32x4*)(PP + off + bj * HALF); f32x4 p0, p1; unpack8(pw, p0, p1); f32x4 v0, v1;
#pragma unroll
                        for (int e = 0; e < 4; ++e) { v0[e] = sigmoidf_(acc[ai][bj][m][0][e]) * p0[e]; v1[e] = sigmoidf_(acc[ai][bj][m][1][e]) * p1[e]; }
                        *(u32x4*)(PP + off + bj * HALF) = pack8(v0, v1); }
                    EPI_FENCE(); }
        } else {
            const int col0 = (u.pn - 4) * BM + wc * 32 + 8 * fq;
#pragma unroll
            for (int ai = 0; ai < 2; ++ai)
#pragma unroll
                for (int m = 0; m < 4; ++m) { bf16_t* rowp = QRY + (size_t)(row0 + ai * HALF + m * 16) * 2048 + col0;
#pragma unroll
                    for (int bj = 0; bj < 2; ++bj) *(u32x4*)(rowp + bj * HALF) = pack8(acc[ai][bj][m][0], acc[ai][bj][m][1]); }
        }
    }
};
}

typedef GAS unsigned gu32;
#define RLX_AGENT __ATOMIC_RELAXED, __HIP_MEMORY_SCOPE_AGENT
#define XB_TMO      128
#define XB_XCNT(j)  (256  + 64 * (j))
#define XB_XSUB(j)  (1280 + 64 * (j))
#define XB_XGEN(j)  (2304 + 64 * (j))
#define XB_TOP      3328
#define XB_TOPGEN   3392
#define XCD_BAR_WORDS 3456
#define XB_SPIN_CAP (1u << 22)
constexpr int CW_BAR = 4096;
__device__ __forceinline__ unsigned xb_ld(unsigned* p)              { return __hip_atomic_load(p, __ATOMIC_RELAXED, __HIP_MEMORY_SCOPE_AGENT); }
__device__ __forceinline__ unsigned xb_add(unsigned* p, unsigned v) { return __hip_atomic_fetch_add(p, v, __ATOMIC_RELAXED, __HIP_MEMORY_SCOPE_AGENT); }
__device__ __forceinline__ unsigned xb_xcc_id() { return (unsigned)__builtin_amdgcn_s_getreg((3 << 11) | 20) & 0xFu; }
#define XB_SPIN(cond, bar) do { unsigned _sp = 0; while (cond) { __builtin_amdgcn_s_sleep(1); \
    if ((++_sp & 255u) == 0u) { if (xb_ld(&(bar)[XB_TMO])) break; if (_sp > XB_SPIN_CAP) { atomicAdd(&(bar)[XB_TMO], 1u); break; } } } } while (0)
struct XcdBarrier { unsigned* bar; unsigned x; volatile LAS unsigned* st; };
__device__ __forceinline__ XcdBarrier xcd_barrier_post(unsigned* bar, volatile LAS unsigned* st) {
    XcdBarrier b; b.bar = bar; b.x = xb_xcc_id(); b.st = st;
    if (threadIdx.x == 0) (void)xb_add(&bar[XB_XCNT(b.x)], 1u);
    return b;
}
__device__ __forceinline__ void xcd_barrier_complete(unsigned* bar, unsigned x, unsigned& nloc, unsigned& nx) {
    const unsigned G = gridDim.x * gridDim.y * gridDim.z;
    unsigned sum, cnt, mine, sp = 0u;
    for (;;) {
        sum = 0u; cnt = 0u; mine = 0u;
#pragma unroll
        for (unsigned j = 0; j < 16; ++j) { const unsigned c = xb_ld(&bar[XB_XCNT(j)]); sum += c; cnt += (c > 0u) ? 1u : 0u; mine = (j == x) ? c : mine; }
        if (sum == G) break;
        __builtin_amdgcn_s_sleep(1);
        if ((++sp & 255u) == 0u) { if (xb_ld(&bar[XB_TMO])) break; if (sp > XB_SPIN_CAP) { atomicAdd(&bar[XB_TMO], 1u); break; } }
    }
    nloc = mine > 0u ? mine : 1u; nx = cnt > 0u ? cnt : 1u;
}
__device__ __forceinline__ void xcd_barrier(const XcdBarrier& b) {
    asm volatile("s_waitcnt vmcnt(0)" ::: "memory");
    __syncthreads();
    if (threadIdx.x == 0) {
        unsigned* bar = b.bar;
        __builtin_amdgcn_s_waitcnt(0);
        unsigned nloc = b.st[0], nx = b.st[1];
        if (nloc == 0u) { xcd_barrier_complete(bar, b.x, nloc, nx); b.st[0] = nloc; b.st[1] = nx; }
        const unsigned old = xb_add(&bar[XB_XSUB(b.x)], 1u);
        const unsigned gen = old / nloc;
        if (old + 1u == (gen + 1u) * nloc) {
            __builtin_amdgcn_fence(__ATOMIC_RELEASE, "agent");
            asm volatile("s_waitcnt vmcnt(0)" ::: "memory");
            const unsigned og = xb_add(&bar[XB_TOP], 1u);
            const unsigned tg = og / nx;
            if (og + 1u == (tg + 1u) * nx) xb_add(&bar[XB_TOPGEN], 1u);
            else XB_SPIN(xb_ld(&bar[XB_TOPGEN]) == tg, bar);
            __builtin_amdgcn_fence(__ATOMIC_ACQUIRE, "agent");
            xb_add(&bar[XB_XGEN(b.x)], 1u);
            asm volatile("s_waitcnt vmcnt(0)" ::: "memory");
        } else {
            XB_SPIN(xb_ld(&bar[XB_XGEN(b.x)]) == gen, bar);
            __builtin_amdgcn_fence(__ATOMIC_ACQUIRE, "agent");
            asm volatile("s_waitcnt vmcnt(0)" ::: "memory");
        }
    }
    __syncthreads();
}

struct Args { const float* in[21]; float* out; unsigned char* ws; int ph_lo, ph_hi; };
struct Frame {
    LAS unsigned char* lds; volatile LAS unsigned* MISC; gu32* ctl;
    int tid, lane, wave, vcu, G;
};

__device__ __forceinline__ void p0_transpose_item(const float* W, int K, int N, bf16_t* WT, int row_off, LAS float* scr, int item, int lane) {
    const int nblk = N / 32, kb = item / nblk, nb = item % nblk, k0 = 64 * kb, n0 = 32 * nb;
#pragma unroll 8
    for (int i = 0; i < 32; ++i) { const int kk = 2 * i + (lane >> 5); scr[kk * 33 + (lane & 31)] = W[(size_t)(k0 + kk) * N + n0 + (lane & 31)]; }
    LDS_WAIT(); asm volatile("" ::: "memory");
    const int c = lane & 7;
#pragma unroll
    for (int j = 0; j < 4; ++j) { const int n = (lane >> 3) + 8 * j; const LAS float* s = scr + (8 * c) * 33 + n;
        u32x4 o; o.x = pk2(s[0 * 33], s[1 * 33]); o.y = pk2(s[2 * 33], s[3 * 33]); o.z = pk2(s[4 * 33], s[5 * 33]); o.w = pk2(s[6 * 33], s[7 * 33]);
        *(GAS u32x4*)(WT + (size_t)(row_off + n0 + n) * K + k0 + 8 * c) = o; }
    LDS_WAIT(); asm volatile("" ::: "memory");
}
__device__ __forceinline__ void cvt_stream(const float* src, bf16_t* dst, size_t n4, size_t gtid, size_t nthr) {
    for (size_t i = gtid; i < n4; i += nthr) { const f32x4 v = ((const GAS f32x4*)src)[i]; u32x2 o; o.x = pk2(v[0], v[1]); o.y = pk2(v[2], v[3]); ((GAS u32x2*)dst)[i] = o; }
}

__device__ __forceinline__ void phase_prologue(Frame& F, const Args& a) {
    unsigned char* ws = a.ws;
    LAS float* scr = (LAS float*)(F.lds + F.wave * 16384);
    const int gw = F.vcu * NWAVES + F.wave, NGW = F.G * NWAVES;
    const size_t gtid = (size_t)gw * 64 + F.lane, nthr = (size_t)NGW * 64;
    constexpr int I_IN = 16 * (NPROJ / 32), I_SQ = 16 * 32, I_Q = 16 * 64, I_PP = 4 * 32;
    constexpr int NITEMS = I_IN + 3 * I_SQ + I_Q + I_PP;
    for (int it = gw; it < NITEMS; it += NGW) {
        int r = it;
        if (r < I_IN) { p0_transpose_item(a.in[4], 1024, NPROJ, (bf16_t*)(ws + WS_WIN), 0, scr, r, F.lane); continue; } r -= I_IN;
        if (r < I_SQ) { p0_transpose_item(a.in[7], 1024, 1024, (bf16_t*)(ws + WS_WA), 0, scr, r, F.lane); continue; } r -= I_SQ;
        if (r < I_SQ) { p0_transpose_item(a.in[10], 1024, 1024, (bf16_t*)(ws + WS_WOUT), 0, scr, r, F.lane); continue; } r -= I_SQ;
        if (r < I_SQ) { p0_transpose_item(a.in[17], 1024, 1024, (bf16_t*)(ws + WS_WPGQ), 0, scr, r, F.lane); continue; } r -= I_SQ;
        if (r < I_Q) { p0_transpose_item(a.in[13], 1024, 2048, (bf16_t*)(ws + WS_WPGQ), 1024, scr, r, F.lane); continue; } r -= I_Q;
        p0_transpose_item(a.in[18], 256, 1024, (bf16_t*)(ws + WS_WPP), 0, scr, r, F.lane);
    }
    { bf16_t* wp = (bf16_t*)(ws + WS_WPOOL); const float* pw = a.in[8];
      for (size_t i = gtid; i < 1024 * 256; i += nthr) { const int o = (int)(i >> 8), j = (int)(i & 255), g = o >> 8, gsrc = 2 * (g >> 1) + (j >> 7);
          const float v = (gsrc == g) ? pw[((size_t)g * 128 + (j & 127)) * 256 + (o & 255)] : 0.f; wp[i] = (bf16_t)f2bf(v); } }
    { float* oml = (float*)(ws + WS_OML); const float* lb = a.in[5]; for (size_t i = gtid; i < 1024; i += nthr) oml[i] = sigmoidf_(lb[1024 + i] - lb[i]); }
    cvt_stream(a.in[14], (bf16_t*)(ws + WS_SK), (size_t)16 * 128 * 128 / 4, gtid, nthr);
    cvt_stream(a.in[1], (bf16_t*)(ws + WS_PB), (size_t)T * 256 / 4, gtid, nthr);
    cvt_stream(a.in[15], (bf16_t*)(ws + WS_UT), (size_t)NEXP * 1024 / 4, gtid, nthr);
    cvt_stream(a.in[16], (bf16_t*)(ws + WS_VT), (size_t)NEXP * 1024 / 4, gtid, nthr);
    { const float* x = a.in[0]; const float* g0 = a.in[2]; const float* b0 = a.in[3]; bf16_t* XN = (bf16_t*)(ws + WS_XN); float* st = (float*)(ws + WS_ST0);
      for (int m = gw; m < T; m += NGW) {
          const GAS f32x4* xr = (const GAS f32x4*)(x + (size_t)m * D) + F.lane;
          f32x4 v[4]; float s = 0.f;
#pragma unroll
          for (int j = 0; j < 4; ++j) { v[j] = xr[64 * j]; s += (v[j][0] + v[j][1]) + (v[j][2] + v[j][3]); }
          const float mean = wave_sum(s) * (1.f / D); float s2 = 0.f;
#pragma unroll
          for (int j = 0; j < 4; ++j) { v[j] = v[j] - mean; s2 += (v[j][0] * v[j][0] + v[j][1] * v[j][1]) + (v[j][2] * v[j][2] + v[j][3] * v[j][3]); }
          const float rstd = 1.f / sqrtf(wave_sum(s2) * (1.f / D) + LN_EPS);
          if (F.lane == 0) { st[2 * (size_t)m] = mean; st[2 * (size_t)m + 1] = rstd; }
          GAS u32x2* o8 = (GAS u32x2*)(XN + (size_t)m * D) + F.lane;
#pragma unroll
          for (int j = 0; j < 4; ++j) { const f32x4 gg = ((const GAS f32x4*)g0)[64 * j + F.lane], bb = ((const GAS f32x4*)b0)[64 * j + F.lane];
              const f32x4 h = v[j] * rstd * gg + bb; u32x2 o; o.x = pk2(h[0], h[1]); o.y = pk2(h[2], h[3]); o8[64 * j] = o; }
      } }
}

__device__ __forceinline__ void hgrn_unit(Frame& F, const Args& a, int unit) {
    unsigned char* ws = a.ws;
    const bf16_t* Qs = (const bf16_t*)(ws + WS_QS); const bf16_t* Kk = (const bf16_t*)(ws + WS_KK); const bf16_t* Vi = (const bf16_t*)(ws + WS_VI); const bf16_t* SG = (const bf16_t*)(ws + WS_SG);
    bf16_t* OG = (bf16_t*)(ws + WS_OG); const float* ng = a.in[6];
    const int b = unit >> 3, h = unit & 7, tid = F.tid;
    LAS float* Lq = (LAS float*)F.lds; LAS float* Lk = Lq + 4096; LAS float* Lf = Lk + 4096; LAS float* Lv = Lf + 4096; LAS float* Lo = Lv + 4096;
    const int dv = tid & 127, g = tid >> 7;
    float S[32];
#pragma unroll
    for (int j = 0; j < 32; ++j) S[j] = 0.f;
    const int lr = tid >> 4, lc = (tid & 15) * 8;
    for (int n = 0; n < SEQ / 32; ++n) {
        const size_t t0 = (size_t)b * SEQ + (size_t)n * 32;
        const size_t goff = (t0 + lr) * 1024 + h * 128 + lc;
        const u32x4 rq = *(const GAS u32x4*)(Qs + goff), rk = *(const GAS u32x4*)(Kk + goff), rv = *(const GAS u32x4*)(Vi + goff);
        f32x4 q0, q1, k0, k1, v0, v1; pg8::unpack8(rq, q0, q1); pg8::unpack8(rk, k0, k1); pg8::unpack8(rv, v0, v1);
        const int lo = lr * 128 + lc;
        *(LAS f32x4*)(Lq + lo) = q0; *(LAS f32x4*)(Lq + lo + 4) = q1;
        *(LAS f32x4*)(Lk + lo) = k0; *(LAS f32x4*)(Lk + lo + 4) = k1;
        *(LAS f32x4*)(Lf + lo) = 1.0f - k0; *(LAS f32x4*)(Lf + lo + 4) = 1.0f - k1;
        *(LAS f32x4*)(Lv + lo) = v0; *(LAS f32x4*)(Lv + lo + 4) = v1;
        __syncthreads();
#pragma unroll 2
        for (int tok = 0; tok < 32; ++tok) {
            const float vv = Lv[tok * 128 + dv]; float o = 0.f;
#pragma unroll
            for (int j4 = 0; j4 < 8; ++j4) {
                const f32x4 ff = *(const LAS f32x4*)(Lf + tok * 128 + 32 * g + 4 * j4), kk = *(const LAS f32x4*)(Lk + tok * 128 + 32 * g + 4 * j4), qq = *(const LAS f32x4*)(Lq + tok * 128 + 32 * g + 4 * j4);
#pragma unroll
                for (int i = 0; i < 4; ++i) { S[4 * j4 + i] = ff[i] * S[4 * j4 + i] + kk[i] * vv; o += S[4 * j4 + i] * qq[i]; }
            }
            Lo[(tok * 4 + g) * 128 + dv] = o;
        }
        __syncthreads();
        { const int tok = tid >> 4, c8 = (tid & 15) * 8; float ov[8]; float ss = 0.f;
#pragma unroll
          for (int i = 0; i < 8; ++i) { ov[i] = (Lo[(tok * 4 + 0) * 128 + c8 + i] + Lo[(tok * 4 + 1) * 128 + c8 + i]) + (Lo[(tok * 4 + 2) * 128 + c8 + i] + Lo[(tok * 4 + 3) * 128 + c8 + i]); ss += ov[i] * ov[i]; }
          ss += __shfl_xor(ss, 1); ss += __shfl_xor(ss, 2); ss += __shfl_xor(ss, 4); ss += __shfl_xor(ss, 8);
          const float rstd = 1.0f / sqrtf(ss * (1.0f / 128.0f) + RMS_EPS);
          const size_t go = (t0 + tok) * 1024 + h * 128 + c8;
          const u32x4 sgw = *(const GAS u32x4*)(SG + go); f32x4 s0, s1; pg8::unpack8(sgw, s0, s1);
          const f32x4 n0 = *(const GAS f32x4*)(ng + c8), n1 = *(const GAS f32x4*)(ng + c8 + 4);
          f32x4 r0, r1;
#pragma unroll
          for (int i = 0; i < 4; ++i) { r0[i] = ov[i] * rstd * n0[i] * s0[i]; r1[i] = ov[4 + i] * rstd * n1[i] * s1[i]; }
          *(GAS u32x4*)(OG + go) = pg8::pack8(r0, r1); }
    }
    __syncthreads();
}
__device__ __forceinline__ void pool_prep(Frame& F, const Args& a, size_t gtid, size_t nthr) {
    const bf16_t* VP = (const bf16_t*)(a.ws + WS_VP); bf16_t* PL = (bf16_t*)(a.ws + WS_PL);
    for (size_t item = gtid; item < (size_t)T * 64; item += nthr) {
        const int t = (int)(item >> 6), c8 = (int)(item & 63) * 8, gi = c8 >> 7, w = 2 << gi, pos = t & (SEQ - 1), cnt = (pos + 1 < w) ? pos + 1 : w;
        f32x4 s0 = {0.f, 0.f, 0.f, 0.f}, s1 = {0.f, 0.f, 0.f, 0.f}, c0, c1;
        for (int j = 0; j < cnt; ++j) { const u32x4 r = *(const GAS u32x4*)(VP + (size_t)(t - j) * 512 + c8); f32x4 a0, a1; pg8::unpack8(r, a0, a1); s0 += a0; s1 += a1; if (j == 0) { c0 = a0; c1 = a1; } }
        const float inv = 1.0f / (float)cnt;
        *(GAS u32x4*)(PL + (size_t)t * 512 + c8) = pg8::pack8(s0 * inv - c0, s1 * inv - c1);
    }
}

__device__ __forceinline__ void phase_ln1(Frame& F, const Args& a) {
    float* R1 = a.out; bf16_t* H1b = (bf16_t*)(a.ws + WS_H1B); const float* g1 = a.in[11]; const float* b1 = a.in[12];
    const int gw = F.vcu * NWAVES + F.wave, NGW = F.G * NWAVES;
    for (int m = gw; m < T; m += NGW) {
        GAS f32x4* xr = (GAS f32x4*)(R1 + (size_t)m * D) + F.lane;
        f32x4 v[4]; float s = 0.f;
#pragma unroll
        for (int j = 0; j < 4; ++j) { v[j] = xr[64 * j]; s += (v[j][0] + v[j][1]) + (v[j][2] + v[j][3]); }
        const float mean = wave_sum(s) * (1.f / D); float s2 = 0.f;
#pragma unroll
        for (int j = 0; j < 4; ++j) { v[j] = v[j] - mean; s2 += (v[j][0] * v[j][0] + v[j][1] * v[j][1]) + (v[j][2] * v[j][2] + v[j][3] * v[j][3]); }
        const float rstd = 1.f / sqrtf(wave_sum(s2) * (1.f / D) + LN_EPS);
        GAS u32x2* o8 = (GAS u32x2*)(H1b + (size_t)m * D) + F.lane;
#pragma unroll
        for (int j = 0; j < 4; ++j) { const f32x4 gg = ((const GAS f32x4*)g1)[64 * j + F.lane], bb = ((const GAS f32x4*)b1)[64 * j + F.lane];
            const f32x4 h = v[j] * rstd * gg + bb; xr[64 * j] = h; u32x2 o; o.x = pk2(h[0], h[1]); o.y = pk2(h[2], h[3]); o8[64 * j] = o; }
    }
}

__device__ __forceinline__ unsigned ordf(float f) { const unsigned b = __builtin_bit_cast(unsigned, f); return (b & 0x80000000u) ? ~b : (b | 0x80000000u); }
__device__ __forceinline__ float unordf(unsigned o) { const unsigned b = (o & 0x80000000u) ? (o & 0x7fffffffu) : ~o; return __builtin_bit_cast(float, b); }
__device__ __forceinline__ unsigned long long wave_max_u64(unsigned long long k) {
#pragma unroll
    for (int o = 32; o; o >>= 1) { const unsigned long long t = __shfl_xor(k, o); k = t > k ? t : k; }
    return k;
}
__device__ __forceinline__ void phase_topk(Frame& F, const Args& a) {
    constexpr int SKROW = 272;
    const bf16_t* SK = (const bf16_t*)(a.ws + WS_SK); const bf16_t* QRY = (const bf16_t*)(a.ws + WS_QRY);
    int* IDX = (int*)(a.ws + WS_IDX); float* GATE = (float*)(a.ws + WS_GATE);
    LAS unsigned char* Lsk = F.lds;
    LAS float* Lq = (LAS float*)(F.lds + 256 * SKROW) + F.wave * 256;
    const int lane = F.lane, tid = F.tid;
    for (int tb = F.vcu * 128; tb < T; tb += F.G * 128) {
        for (int h = 0; h < 8; ++h) {
            __syncthreads();
            for (int c = tid; c < 256 * 16; c += 512) { const int row = c >> 4, ch = c & 15;
                const u32x4 v = *(const GAS u32x4*)(SK + ((size_t)h * 256 + row) * 128 + ch * 8); *(LAS u32x4*)(Lsk + row * SKROW + ch * 16) = v; }
            __syncthreads();
            for (int tt = 0; tt < 16; ++tt) {
                const int t = tb + F.wave * 16 + tt;
                { const u32x2 qw = *(const GAS u32x2*)(QRY + (size_t)t * 2048 + h * 256 + lane * 4);
                  *(LAS f32x4*)(Lq + lane * 4) = (f32x4){bflo(qw.x), bfhi(qw.x), bflo(qw.y), bfhi(qw.y)}; }
                LDS_WAIT(); asm volatile("" ::: "memory");
                float s[2][2];
#pragma unroll
                for (int p = 0; p < 2; ++p)
#pragma unroll
                    for (int nn = 0; nn < 2; ++nn) { const LAS unsigned char* rowp = Lsk + (p * 128 + nn * 64 + lane) * SKROW; float acc = 0.f;
#pragma unroll 4
                        for (int kc = 0; kc < 16; ++kc) { const u32x4 w = *(const LAS u32x4*)(rowp + kc * 16); const f32x4 qa = *(const LAS f32x4*)(Lq + p * 128 + kc * 8), qb = *(const LAS f32x4*)(Lq + p * 128 + kc * 8 + 4);
                            acc += bflo(w.x) * qa[0]; acc += bfhi(w.x) * qa[1]; acc += bflo(w.y) * qa[2]; acc += bfhi(w.y) * qa[3];
                            acc += bflo(w.z) * qb[0]; acc += bfhi(w.z) * qb[1]; acc += bflo(w.w) * qb[2]; acc += bfhi(w.w) * qb[3]; }
                        s[p][nn] = acc; }
                float tv[2]; int ti[2];
#pragma unroll
                for (int p = 0; p < 2; ++p) {
                    unsigned long long k0 = ((unsigned long long)ordf(s[p][0]) << 32) | (unsigned)(0xFFFFFFFFu - (unsigned)lane);
                    unsigned long long k1 = ((unsigned long long)ordf(s[p][1]) << 32) | (unsigned)(0xFFFFFFFFu - (unsigned)(lane + 64));
                    tv[p] = 0.f; ti[p] = 0;
                    for (int r = 0; r < 16; ++r) { const unsigned long long m = wave_max_u64(k0 > k1 ? k0 : k1);
                        if (k0 == m) k0 = 0ull; if (k1 == m) k1 = 0ull;
                        if (lane == r) { tv[p] = unordf((unsigned)(m >> 32)); ti[p] = (int)(0xFFFFFFFFu - (unsigned)m); } }
                }
                unsigned long long ck[4];
                { const float va = __shfl(tv[0], lane >> 2);
#pragma unroll
                  for (int j = 0; j < 4; ++j) { const int bidx = 4 * (lane & 3) + j; const float vb = __shfl(tv[1], bidx); const unsigned pos = (unsigned)((lane >> 2) * 16 + bidx);
                      ck[j] = ((unsigned long long)ordf(va + vb) << 32) | (unsigned)(0xFFFFFFFFu - pos); } }
                float bv = 0.f; int bpos = 0;
                for (int r = 0; r < 16; ++r) { unsigned long long mx = ck[0] > ck[1] ? ck[0] : ck[1]; const unsigned long long m2 = ck[2] > ck[3] ? ck[2] : ck[3]; mx = mx > m2 ? mx : m2;
                    const unsigned long long m = wave_max_u64(mx);
#pragma unroll
                    for (int j = 0; j < 4; ++j) if (ck[j] == m) ck[j] = 0ull;
                    if (lane == r) { bv = unordf((unsigned)(m >> 32)); bpos = (int)(0xFFFFFFFFu - (unsigned)m); } }
                const int i1 = __shfl(ti[0], (bpos >> 4) & 15), i2 = __shfl(ti[1], bpos & 15);
                const float vmax = __shfl(bv, 0);
                const float e = (lane < 16) ? __expf(bv - vmax) : 0.f;
                const float esum = wave_sum(e);
                if (lane < 16) { IDX[(size_t)t * 128 + h * 16 + lane] = i1 * 128 + i2; GATE[(size_t)t * 128 + h * 16 + lane] = e / esum; }
            }
        }
    }
    __syncthreads();
}

__device__ __forceinline__ void phase_gather(Frame& F, const Args& a) {
    const bf16_t* UT = (const bf16_t*)(a.ws + WS_UT); const bf16_t* VT = (const bf16_t*)(a.ws + WS_VT); const bf16_t* PLE = (const bf16_t*)(a.ws + WS_PP);
    const int* IDX = (const int*)(a.ws + WS_IDX); const float* GATE = (const float*)(a.ws + WS_GATE);
    float* H = a.out; const float* g2 = a.in[19]; const float* b2 = a.in[20];
    const int gw = F.vcu * NWAVES + F.wave, NGW = F.G * NWAVES, lane = F.lane;
    for (int t = gw; t < T; t += NGW) {
        GAS f32x4* hp = (GAS f32x4*)(H + (size_t)t * D) + lane * 4;
        f32x4 hv[4];
#pragma unroll
        for (int i = 0; i < 4; ++i) hv[i] = hp[i];
        const int id0 = IDX[(size_t)t * 128 + lane], id1 = IDX[(size_t)t * 128 + 64 + lane];
        const float gt0 = GATE[(size_t)t * 128 + lane], gt1 = GATE[(size_t)t * 128 + 64 + lane];
        f32x4 acc[4];
#pragma unroll
        for (int i = 0; i < 4; ++i) acc[i] = (f32x4){0.f, 0.f, 0.f, 0.f};
#pragma unroll 4
        for (int k = 0; k < 128; ++k) {
            const int e = __builtin_amdgcn_readlane(k < 64 ? id0 : id1, k & 63);
            const float gt = __builtin_bit_cast(float, __builtin_amdgcn_readlane(__builtin_bit_cast(int, k < 64 ? gt0 : gt1), k & 63));
            const GAS u32x4* up = (const GAS u32x4*)(UT + (size_t)e * D) + lane * 2;
            const GAS u32x4* vp = (const GAS u32x4*)(VT + (size_t)e * D) + lane * 2;
            const u32x4 ua = up[0], ub = up[1], va = vp[0], vb = vp[1];
            f32x4 u0, u1, u2, u3; pg8::unpack8(ua, u0, u1); pg8::unpack8(ub, u2, u3);
            const f32x4 pr = hv[0] * u0 + hv[1] * u1 + hv[2] * u2 + hv[3] * u3;
            const float s = wave_sum((pr[0] + pr[1]) + (pr[2] + pr[3]));
            const float act = 0.5f * s * (1.0f + erff(s * 0.70710678118654752f)) * gt;
            f32x4 v0, v1, v2, v3; pg8::unpack8(va, v0, v1); pg8::unpack8(vb, v2, v3);
            acc[0] += v0 * act; acc[1] += v1 * act; acc[2] += v2 * act; acc[3] += v3 * act;
        }
        const GAS u32x4* pp = (const GAS u32x4*)(PLE + (size_t)t * D) + lane * 2;
        const u32x4 pa = pp[0], pb = pp[1]; f32x4 p0, p1, p2, p3; pg8::unpack8(pa, p0, p1); pg8::unpack8(pb, p2, p3);
        f32x4 r[4]; r[0] = hv[0] * ALPHA + acc[0] + p0; r[1] = hv[1] * ALPHA + acc[1] + p1; r[2] = hv[2] * ALPHA + acc[2] + p2; r[3] = hv[3] * ALPHA + acc[3] + p3;
        float s = 0.f;
#pragma unroll
        for (int i = 0; i < 4; ++i) s += (r[i][0] + r[i][1]) + (r[i][2] + r[i][3]);
        const float mean = wave_sum(s) * (1.f / D); float s2 = 0.f;
#pragma unroll
        for (int i = 0; i < 4; ++i) { r[i] = r[i] - mean; s2 += (r[i][0] * r[i][0] + r[i][1] * r[i][1]) + (r[i][2] * r[i][2] + r[i][3] * r[i][3]); }
        const float rstd = 1.f / sqrtf(wave_sum(s2) * (1.f / D) + LN_EPS);
#pragma unroll
        for (int i = 0; i < 4; ++i) { const f32x4 gg = ((const GAS f32x4*)g2)[lane * 4 + i], bb = ((const GAS f32x4*)b2)[lane * 4 + i]; hp[i] = r[i] * rstd * gg + bb; }
    }
}

constexpr int NPHASE = 9;
__global__ void __launch_bounds__(NWAVES * 64, 2) mk_fwd(Args args) {
    extern __shared__ __attribute__((aligned(16))) unsigned char lds[];
    Frame F;
    F.lds = (LAS unsigned char*)lds;
    F.MISC = (volatile LAS unsigned*)(F.lds + MISC_OFF);
    F.tid = threadIdx.x; F.lane = F.tid & 63; F.wave = __builtin_amdgcn_readfirstlane(F.tid >> 6);
    F.G = gridDim.x; { const int bx = blockIdx.x; F.vcu = (F.G % 8 == 0) ? (bx % 8) * (F.G / 8) + bx / 8 : bx; }
    unsigned char* ws = args.ws;
    F.ctl = (gu32*)(ws + WS_CTL);
    for (int u = F.tid; u < (LDS_BYTES - LDSCTL_OFF) / 4; u += NWAVES * 64) ((LAS unsigned*)(F.lds + LDSCTL_OFF))[u] = 0u;
    __syncthreads();
    const int lo = args.ph_lo, hi = args.ph_hi;
    const bool one = (hi - lo) > 1;
    XcdBarrier bar; bar.bar = (unsigned*)(F.ctl + CW_BAR); bar.x = 0; bar.st = nullptr;
    if (one) bar = xcd_barrier_post((unsigned*)(F.ctl + CW_BAR), F.MISC + 8);
#ifndef PH_MASK
#define PH_MASK 0xFFFF
#endif
#define IN(k) (((PH_MASK >> (k)) & 1) && lo <= (k) && (k) < hi)
#define SEAM(k) do { if (IN(k) && IN((k) + 1)) xcd_barrier(bar); } while (0)
    bf16_t* const GA = (bf16_t*)args.out; bf16_t* const GB = (bf16_t*)args.out + (size_t)T * 1024;

    if (IN(0)) { phase_prologue(F, args); SEAM(0); }
    if (IN(1)) {
        pg8::Gemm g{(const bf16_t*)(ws + WS_XN), (const bf16_t*)(ws + WS_WIN), T, NPROJ, 1024, 1024, 1024, 0, 0};
        pg8::StaticOrder S; S.init(T, NPROJ, F.G, (int)blockIdx.x);
        pg8::EpiProj E{(bf16_t*)(ws + WS_QS), (bf16_t*)(ws + WS_KK), (bf16_t*)(ws + WS_VI), (bf16_t*)(ws + WS_SG), (bf16_t*)(ws + WS_VP), GA, GB, (const float*)(ws + WS_OML)};
        pg8::gemm_phase<pg8::EpiProj>(F.lds, g, S, E);
        SEAM(1);
    }
    if (IN(2)) {
        const int nh = F.G > 64 ? 64 : F.G;
        if ((int)blockIdx.x < nh) { for (int u = blockIdx.x; u < 64; u += nh) hgrn_unit(F, args, u); }
        if (F.G <= 64) pool_prep(F, args, (size_t)blockIdx.x * 512 + F.tid, (size_t)F.G * 512);
        else if ((int)blockIdx.x >= 64) pool_prep(F, args, (size_t)(blockIdx.x - 64) * 512 + F.tid, (size_t)(F.G - 64) * 512);
        SEAM(2);
    }
    if (IN(3)) {
        { pg8::Gemm g{(const bf16_t*)(ws + WS_PL), (const bf16_t*)(ws + WS_WPOOL), T, 1024, 256, 512, 256, 1, 256};
          pg8::StaticOrder S; S.init(T, 1024, F.G, (int)blockIdx.x);
          pg8::EpiYB E{(bf16_t*)(ws + WS_YB), GB, args.in[9]};
          pg8::gemm_phase<pg8::EpiYB>(F.lds, g, S, E); }
        { pg8::Gemm g{(const bf16_t*)(ws + WS_OG), (const bf16_t*)(ws + WS_WA), T, 1024, 1024, 1024, 1024, 0, 0};
          pg8::StaticOrder S; S.init(T, 1024, F.G, (int)blockIdx.x);
          pg8::EpiMix E{(bf16_t*)(ws + WS_MIX), GA, (const bf16_t*)(ws + WS_YB)};
          pg8::gemm_phase<pg8::EpiMix>(F.lds, g, S, E); }
        { pg8::Gemm g{(const bf16_t*)(ws + WS_PB), (const bf16_t*)(ws + WS_WPP), T, 1024, 256, 256, 256, 0, 0};
          pg8::StaticOrder S; S.init(T, 1024, F.G, (int)blockIdx.x);
          pg8::EpiPlain E{(bf16_t*)(ws + WS_PP), 1024};
          pg8::gemm_phase<pg8::EpiPlain>(F.lds, g, S, E); }
        SEAM(3);
    }
    if (IN(4)) {
        pg8::Gemm g{(const bf16_t*)(ws + WS_MIX), (const bf16_t*)(ws + WS_WOUT), T, 1024, 1024, 1024, 1024, 0, 0};
        pg8::StaticOrder S; S.init(T, 1024, F.G, (int)blockIdx.x);
        pg8::EpiR1 E{args.out, args.in[0], (const float*)(ws + WS_ST0), args.in[2], args.in[3]};
        pg8::gemm_phase<pg8::EpiR1>(F.lds, g, S, E);
        SEAM(4);
    }
    if (IN(5)) { phase_ln1(F, args); SEAM(5); }
    if (IN(6)) {
        pg8::Gemm g{(const bf16_t*)(ws + WS_H1B), (const bf16_t*)(ws + WS_WPGQ), T, 3072, 1024, 1024, 1024, 0, 0};
        pg8::StaticOrder S; S.init(T, 3072, F.G, (int)blockIdx.x);
        pg8::EpiPgq E{(bf16_t*)(ws + WS_PP), (bf16_t*)(ws + WS_QRY)};
        pg8::gemm_phase<pg8::EpiPgq>(F.lds, g, S, E);
        SEAM(6);
    }
    if (IN(7)) { phase_topk(F, args); SEAM(7); }
    if (IN(8)) { phase_gather(F, args); }
#undef IN
#undef SEAM
}

extern "C" void kernel_launch(void* const* d_in, const int* in_sizes, int n_in, void* d_out, int out_size, void* d_ws, size_t ws_size, hipStream_t stream) {
    static int grid = 0;
    if (grid == 0) {
        if (n_in != 21 || out_size != T * D || ws_size < WS_END) { fprintf(stderr, "kernel_launch: unexpected shapes (n_in %d, out %d, ws %zu)\n", n_in, out_size, ws_size); grid = -1; return; }
        int dev = 0, cus = 0, per_cu = 0;
        if (hipGetDevice(&dev) != hipSuccess || hipDeviceGetAttribute(&cus, hipDeviceAttributeMultiprocessorCount, dev) != hipSuccess) { grid = -1; return; }
        if (hipFuncSetAttribute((const void*)mk_fwd, hipFuncAttributeMaxDynamicSharedMemorySize, LDS_BYTES) != hipSuccess) { fprintf(stderr, "kernel_launch: hipFuncSetAttribute failed\n"); grid = -1; return; }
        if (hipOccupancyMaxActiveBlocksPerMultiprocessor(&per_cu, (const void*)mk_fwd, NWAVES * 64, LDS_BYTES) != hipSuccess || per_cu < 1)
            fprintf(stderr, "kernel_launch: occupancy query reports %d\n", per_cu);
        (void)hipGetLastError();
        grid = cus;
    }
    if (grid < 0) return;
    (void)hipMemsetAsync((char*)d_ws + WS_CTL, 0, CTL_ZERO_BYTES, stream);
    Args a{};
    for (int i = 0; i < 21; ++i) a.in[i] = (const float*)d_in[i];
    a.out = (float*)d_out; a.ws = (unsigned char*)d_ws;
#if MK_ONE_LAUNCH
    a.ph_lo = 0; a.ph_hi = NPHASE;
    hipLaunchKernelGGL(mk_fwd, dim3(grid), dim3(NWAVES * 64), LDS_BYTES, stream, a);
#else
    for (int p = 0; p < NPHASE; ++p) { a.ph_lo = p; a.ph_hi = p + 1; hipLaunchKernelGGL(mk_fwd, dim3(grid), dim3(NWAVES * 64), LDS_BYTES, stream, a); }
#endif
}
```

```cpp
#include <hip/hip_runtime.h>
#include <cstdio>
#include <cstdint>

#ifndef MK_ONE_LAUNCH
#define MK_ONE_LAUNCH 1
#endif

#define LAS __attribute__((address_space(3)))
#define GAS __attribute__((address_space(1)))
typedef unsigned short bf16_t;
typedef short bf16x8 __attribute__((ext_vector_type(8)));
typedef float f32x4 __attribute__((ext_vector_type(4)));
typedef float f32x2 __attribute__((ext_vector_type(2)));
typedef unsigned u32x4 __attribute__((ext_vector_type(4)));
typedef unsigned u32x2 __attribute__((ext_vector_type(2)));

constexpr int BATCH = 8, SEQ = 4096, T = BATCH * SEQ, D = 1024;
constexpr int NPROJ = 6656;
constexpr int NEXP = 16384;
constexpr float ALPHA = 1.189207115002721f;
constexpr float LN_EPS = 1e-5f, RMS_EPS = 1e-6f;
constexpr int NWAVES = 8;

constexpr size_t MiB = 1u << 20;
constexpr size_t WS_CTL = 0, CTL_ZERO_BYTES = 1 * MiB;
constexpr size_t WS_OML = 1 * MiB;
constexpr size_t WS_ST0 = 1 * MiB + 65536;
constexpr size_t WS_WIN = 2 * MiB;
constexpr size_t WS_WA = 15 * MiB;
constexpr size_t WS_WOUT = 17 * MiB;
constexpr size_t WS_WPGQ = 19 * MiB;
constexpr size_t WS_WPP = 25 * MiB;
constexpr size_t WS_WPOOL = 25 * MiB + 512 * 1024;
constexpr size_t WS_SK = 26 * MiB;
constexpr size_t WS_PB = 27 * MiB;
constexpr size_t WS_UT = 43 * MiB;
constexpr size_t WS_VT = 75 * MiB;
constexpr size_t WS_XN = 108 * MiB;
constexpr size_t WS_QS = 172 * MiB, WS_KK = 236 * MiB, WS_VI = 300 * MiB, WS_SG = 364 * MiB;
constexpr size_t WS_VP = 428 * MiB, WS_PL = 460 * MiB;
constexpr size_t WS_END = 492 * MiB;
constexpr size_t WS_OG = WS_XN, WS_YB = WS_QS, WS_MIX = WS_KK, WS_PP = WS_VI, WS_H1B = WS_SG, WS_QRY = WS_QS;
constexpr size_t WS_IDX = WS_VP, WS_GATE = WS_VP + 16 * MiB;

constexpr int RING_BYTES = 131072;
constexpr int LDSCTL_OFF = RING_BYTES, MISC_OFF = LDSCTL_OFF + 320;
constexpr int LDS_BYTES = 147456;

__device__ __forceinline__ unsigned f2bf(float f) { unsigned u = __builtin_bit_cast(unsigned, f); return (u + 0x7fffu + ((u >> 16) & 1u)) >> 16; }
__device__ __forceinline__ unsigned pk2(float lo, float hi) { return f2bf(lo) | (f2bf(hi) << 16); }
__device__ __forceinline__ float bflo(unsigned w) { return __builtin_bit_cast(float, w << 16); }
__device__ __forceinline__ float bfhi(unsigned w) { return __builtin_bit_cast(float, w & 0xffff0000u); }
__device__ __forceinline__ unsigned cvt_pk_bf16(float lo, float hi) { unsigned r; asm volatile("v_cvt_pk_bf16_f32 %0, %1, %2" : "=v"(r) : "v"(lo), "v"(hi)); return r; }
__device__ __forceinline__ float sigmoidf_(float x) { return __builtin_amdgcn_rcpf(1.0f + __expf(-x)); }
__device__ __forceinline__ float wave_sum(float v) {
#pragma unroll
    for (int o = 1; o < 64; o <<= 1) v += __shfl_xor(v, o);
    return v;
}
#define LDS_WAIT() asm volatile("s_waitcnt lgkmcnt(0)" ::: "memory")
#define VM_WAIT() asm volatile("s_waitcnt vmcnt(0)" ::: "memory")

namespace pg8 {
constexpr int BM = 256, BK = 64, HALF = 128, HTB = HALF * BK * 2, STAGE_BYTES = 8 * HTB, NXCD = 8, WGM = 8;
__host__ __device__ __forceinline__ int lds_byte(int r, int c) { const int st = (r >> 4) * 2 + (c >> 5), rr = r & 15, cc = c & 31, ob = rr * 64 + cc * 2; return st * 1024 + (ob ^ (((ob >> 9) & 1) << 5)); }
__host__ __device__ __forceinline__ void stage_rc(int b, int& R, int& C) { const int st = b / 1024, sb = b % 1024, swz = sb ^ (((sb >> 9) & 1) << 5); R = (st >> 1) * 16 + swz / 64; C = (st & 1) * 32 + (swz % 64) / 2; }
__host__ __device__ __forceinline__ int perm32(int rho) { const int n = rho >> 4, i = rho & 15; return 8 * (i >> 2) + 4 * n + (i & 3); }

struct Unit { int pm, pn; };
struct Gemm { const bf16_t* A; const bf16_t* Bt; int M, N, K, lda, ldb, acol_shift, acol_mul; };

struct StaticOrder {
    int nM, nN, nwg, G, c;
    __host__ __device__ void init(int M, int N, int G_, int c_) { nM = M / BM; nN = N / BM; nwg = nM * nN; G = G_; c = c_; }
    __host__ __device__ bool next(int i, Unit& u) const {
        const long L = (long)i * G + c; if (L >= nwg) return false;
        int wgid = (int)L; { const int q = nwg / NXCD, r = nwg % NXCD, xcd = wgid % NXCD, off = wgid / NXCD; wgid = (xcd < r ? xcd * (q + 1) : r * (q + 1) + (xcd - r) * q) + off; }
        const int nig = WGM * nN, gid = wgid / nig, fm = gid * WGM, gsz = (nM - fm) < WGM ? (nM - fm) : WGM;
        u.pm = fm + ((wgid % nig) % gsz); u.pn = (wgid % nig) / gsz; return true;
    }
};


template <class Epi>
__device__ __forceinline__ void gemm_phase(LAS unsigned char* lds, const Gemm g, const StaticOrder& S, const Epi& E) {
    const int tid = threadIdx.x, wid = __builtin_amdgcn_readfirstlane(tid >> 6), lane = tid & 63, wr = wid >> 2, wc = wid & 3, fr = lane & 15, fq = lane >> 4;
    int K_ = g.K; asm volatile("" : "+s"(K_));
    const int K = K_, nt = K / BK;
    unsigned voffA[2], voffB[2];
#pragma unroll
    for (int i = 0; i < 2; ++i) { int R, C; stage_rc(tid * 16 + i * 8192, R, C); const int Rb = Epi::PERM ? ((R & ~31) + perm32(R & 31)) : R;
        voffA[i] = (unsigned)(R * g.lda + C) * 2u; voffB[i] = (unsigned)(Rb * g.ldb + C) * 2u; }
    const size_t kstep = (size_t)(BK * 2);
    const size_t hstepA = (size_t)HALF * g.lda * 2, hstepB = (size_t)HALF * g.ldb * 2;
    const size_t tstepA = 2 * hstepA, tstepB = 2 * hstepB;
    const unsigned ldsw = (unsigned)wid * 1024u;
    const int aoff = lds_byte(wr * 64 + fr, fq * 8), boff = lds_byte(wc * 32 + fr, fq * 8);
#define PG8_SA(b, h) (((b) * 2 + (h)) * HTB)
#define PG8_SB(b, h) ((4 + (b) * 2 + (h)) * HTB)
#define PG8_STAGE(bufoff, gbase, voff) do { _Pragma("unroll") for (int _i = 0; _i < 2; ++_i) \
        __builtin_amdgcn_global_load_lds((const unsigned*)((const char*)(gbase) + (voff)[_i]), (LAS unsigned*)(lds + (bufoff) + ldsw + _i * 8192), 16, 0, 0); } while (0)
#define PG8_LDA(dst, b, h) do { _Pragma("unroll") for (int m = 0; m < 4; ++m) _Pragma("unroll") for (int k = 0; k < 2; ++k) dst[m][k] = *(const LAS bf16x8*)(lds + PG8_SA(b, h) + aoff + m * 2048 + k * 1024); } while (0)
#define PG8_LDB(dst, b, h) do { _Pragma("unroll") for (int n = 0; n < 2; ++n) _Pragma("unroll") for (int k = 0; k < 2; ++k) dst[n][k] = *(const LAS bf16x8*)(lds + PG8_SB(b, h) + boff + n * 2048 + k * 1024); } while (0)
#define PG8_MMA(ai, bj, At, Bt) do { __builtin_amdgcn_s_setprio(1); _Pragma("unroll") for (int m = 0; m < 4; ++m) _Pragma("unroll") for (int n = 0; n < 2; ++n) _Pragma("unroll") for (int k = 0; k < 2; ++k) \
        acc[ai][bj][m][n] = __builtin_amdgcn_mfma_f32_16x16x32_bf16(Bt[n][k], At[m][k], acc[ai][bj][m][n], 0, 0, 0); __builtin_amdgcn_s_setprio(0); } while (0)
#define PG8_WAIT_V(n) asm volatile("s_waitcnt vmcnt(" #n ")" ::: "memory")
#define PG8_WAIT_L(n) asm volatile("s_waitcnt lgkmcnt(" #n ")" ::: "memory")
#define PG8_BAR __builtin_amdgcn_s_barrier()
#define PG8_SCHED __builtin_amdgcn_sched_barrier(0)
    Unit cur, nxt; int ui = 0;
    if (!S.next(0, cur)) return;
    f32x4 acc[2][2][4][2];
#pragma unroll
    for (int a = 0; a < 2; ++a)
#pragma unroll
        for (int b = 0; b < 2; ++b)
#pragma unroll
            for (int m = 0; m < 4; ++m)
#pragma unroll
                for (int n = 0; n < 2; ++n) acc[a][b][m][n] = (f32x4){0.f, 0.f, 0.f, 0.f};
    bf16x8 At[4][2], B0[2][2], B1[2][2];
    const char* cA = (const char*)g.A + (size_t)cur.pm * tstepA + (size_t)((cur.pn >> g.acol_shift) * g.acol_mul) * 2; const char* cB = (const char*)g.Bt + (size_t)cur.pn * tstepB;
    PG8_STAGE(PG8_SB(0, 0), cB, voffB); PG8_STAGE(PG8_SB(0, 1), cB + hstepB, voffB); PG8_STAGE(PG8_SA(0, 0), cA, voffA); PG8_STAGE(PG8_SA(0, 1), cA + hstepA, voffA);
    if (wr == 1) PG8_BAR;
    PG8_WAIT_V(2); PG8_BAR;
    PG8_STAGE(PG8_SB(1, 0), cB + kstep, voffB); PG8_STAGE(PG8_SA(1, 0), cA + kstep, voffA); PG8_STAGE(PG8_SB(1, 1), cB + hstepB + kstep, voffB);
    PG8_WAIT_V(6); PG8_BAR;
    for (;;) {
        const bool has_next = S.next(ui + 1, nxt);
        const char* nA = has_next ? (const char*)g.A + (size_t)nxt.pm * tstepA + (size_t)((nxt.pn >> g.acol_shift) * g.acol_mul) * 2 : cA;
        const char* nB = has_next ? (const char*)g.Bt + (size_t)nxt.pn * tstepB : cB;
        for (int t = 0; t < nt; t += 2) {
            const bool last = (t == nt - 2);
            const char* a1 = cA + (size_t)(t + 1) * kstep;
            const char* a2 = last ? nA : cA + (size_t)(t + 2) * kstep; const char* b2 = last ? nB : cB + (size_t)(t + 2) * kstep;
            const char* a3 = a2 + kstep; const char* b3 = b2 + kstep;
            PG8_LDB(B0, 0, 0); PG8_LDB(B1, 0, 1); PG8_SCHED; PG8_LDA(At, 0, 0); PG8_STAGE(PG8_SA(1, 1), a1 + hstepA, voffA);
            PG8_WAIT_V(8); PG8_WAIT_L(0); PG8_BAR; PG8_MMA(0, 0, At, B0); PG8_MMA(0, 1, At, B1); PG8_BAR; PG8_SCHED;
            PG8_LDA(At, 0, 1); PG8_STAGE(PG8_SB(0, 0), b2, voffB); PG8_STAGE(PG8_SB(0, 1), b2 + hstepB, voffB); PG8_STAGE(PG8_SA(0, 0), a2, voffA);
            PG8_WAIT_V(8); PG8_WAIT_L(0); PG8_BAR; PG8_MMA(1, 0, At, B0); PG8_MMA(1, 1, At, B1); PG8_BAR; PG8_SCHED;
            PG8_LDB(B0, 1, 0); PG8_LDB(B1, 1, 1); PG8_SCHED; PG8_LDA(At, 1, 0); PG8_STAGE(PG8_SA(0, 1), a2 + hstepA, voffA);
            PG8_WAIT_V(8); PG8_WAIT_L(0); PG8_BAR; PG8_MMA(0, 0, At, B0); PG8_MMA(0, 1, At, B1); PG8_BAR; PG8_SCHED;
            PG8_LDA(At, 1, 1); PG8_STAGE(PG8_SB(1, 0), b3, voffB); PG8_STAGE(PG8_SB(1, 1), b3 + hstepB, voffB); PG8_STAGE(PG8_SA(1, 0), a3, voffA);
            PG8_WAIT_V(8); PG8_WAIT_L(0); PG8_BAR; PG8_MMA(1, 0, At, B0); PG8_MMA(1, 1, At, B1); PG8_BAR; PG8_SCHED;
        }
        if (wr == 0) PG8_BAR;
        E(acc, cur, wr, wc, fr, fq);
        if (!has_next) break;
#pragma unroll
        for (int a = 0; a < 2; ++a)
#pragma unroll
            for (int b = 0; b < 2; ++b)
#pragma unroll
                for (int m = 0; m < 4; ++m)
#pragma unroll
                    for (int n = 0; n < 2; ++n) acc[a][b][m][n] = (f32x4){0.f, 0.f, 0.f, 0.f};
        cur = nxt; cA = nA; cB = nB; ++ui;
        if (wr == 1) PG8_BAR;
    }
    PG8_WAIT_V(0);
    PG8_BAR;
#undef PG8_SA
#undef PG8_SB
#undef PG8_STAGE
#undef PG8_LDA
#undef PG8_LDB
#undef PG8_MMA
#undef PG8_WAIT_V
#undef PG8_WAIT_L
#undef PG8_BAR
#undef PG8_SCHED
}

#define EPI_FENCE() asm volatile("" ::: "memory")
__device__ __forceinline__ u32x4 pack8(const f32x4& v0, const f32x4& v1) { u32x4 w; w.x = cvt_pk_bf16(v0[0], v0[1]); w.y = cvt_pk_bf16(v0[2], v0[3]); w.z = cvt_pk_bf16(v1[0], v1[1]); w.w = cvt_pk_bf16(v1[2], v1[3]); return w; }
__device__ __forceinline__ void unpack8(const u32x4& w, f32x4& v0, f32x4& v1) { v0 = (f32x4){bflo(w.x), bfhi(w.x), bflo(w.y), bfhi(w.y)}; v1 = (f32x4){bflo(w.z), bfhi(w.z), bflo(w.w), bfhi(w.w)}; }

struct EpiProj {
    static constexpr bool PERM = true;
    bf16_t *Qs, *Kk, *Vi, *SG, *VP, *GA, *GB; const float* oml;
    __device__ __forceinline__ void operator()(const f32x4 (&acc)[2][2][4][2], const Unit& u, int wr, int wc, int fr, int fq) const {
        const int pn = u.pn; bf16_t* base; int ldc = 1024, ct, mode;
        if (pn < 4) { base = Qs; ct = pn; mode = 0; } else if (pn < 8) { base = Kk; ct = pn - 4; mode = 1; } else if (pn < 12) { base = Vi; ct = pn - 8; mode = 2; }
        else if (pn < 16) { base = SG; ct = pn - 12; mode = 3; } else if (pn < 18) { base = VP; ct = pn - 16; mode = 2; ldc = 512; }
        else if (pn < 22) { base = GA; ct = pn - 18; mode = 4; } else { base = GB; ct = pn - 22; mode = 4; }
        const int row0 = u.pm * BM + wr * 64 + fr, col0 = ct * 256 + wc * 32 + 8 * fq;
        f32x4 om[2][2];
#pragma unroll
        for (int bj = 0; bj < 2; ++bj)
#pragma unroll
            for (int n = 0; n < 2; ++n) om[bj][n] = (mode == 1) ? *(const f32x4*)(oml + col0 + bj * HALF + 4 * n) : (f32x4){1.f, 1.f, 1.f, 1.f};
#pragma unroll
        for (int ai = 0; ai < 2; ++ai)
#pragma unroll
            for (int m = 0; m < 4; ++m) { bf16_t* rowp = base + (size_t)(row0 + ai * HALF + m * 16) * ldc + col0;
#pragma unroll
                for (int bj = 0; bj < 2; ++bj) { f32x4 v[2] = {acc[ai][bj][m][0], acc[ai][bj][m][1]};
#pragma unroll
                    for (int n = 0; n < 2; ++n)
#pragma unroll
                        for (int e = 0; e < 4; ++e) { const float x = v[n][e]; float y;
                            if (mode == 0) y = x * sigmoidf_(x) * 0.08838834764831845f;
                            else if (mode == 1) y = om[bj][n][e] * sigmoidf_(-x);
                            else if (mode == 2) y = x;
                            else if (mode == 3) y = x * sigmoidf_(x);
                            else y = sigmoidf_(x);
                            v[n][e] = y; }
                    *(u32x4*)(rowp + bj * HALF) = pack8(v[0], v[1]); } }
    }
};
struct EpiPlain {
    static constexpr bool PERM = true;
    bf16_t* O; int ldc;
    __device__ __forceinline__ void operator()(const f32x4 (&acc)[2][2][4][2], const Unit& u, int wr, int wc, int fr, int fq) const {
        const int row0 = u.pm * BM + wr * 64 + fr, col0 = u.pn * BM + wc * 32 + 8 * fq;
#pragma unroll
        for (int ai = 0; ai < 2; ++ai)
#pragma unroll
            for (int m = 0; m < 4; ++m) { bf16_t* rowp = O + (size_t)(row0 + ai * HALF + m * 16) * ldc + col0;
#pragma unroll
                for (int bj = 0; bj < 2; ++bj) *(u32x4*)(rowp + bj * HALF) = pack8(acc[ai][bj][m][0], acc[ai][bj][m][1]); }
    }
};
struct EpiYB {
    static constexpr bool PERM = true;
    bf16_t* YB; const bf16_t* GB; const float* scale;
    __device__ __forceinline__ void operator()(const f32x4 (&acc)[2][2][4][2], const Unit& u, int wr, int wc, int fr, int fq) const {
        const int row0 = u.pm * BM + wr * 64 + fr, col0 = u.pn * BM + wc * 32 + 8 * fq;
        f32x4 sc[2][2];
#pragma unroll
        for (int bj = 0; bj < 2; ++bj)
#pragma unroll
            for (int n = 0; n < 2; ++n) sc[bj][n] = *(const f32x4*)(scale + col0 + bj * HALF + 4 * n);
#pragma unroll
        for (int ai = 0; ai < 2; ++ai)
#pragma unroll
            for (int m = 0; m < 4; ++m) { const size_t off = (size_t)(row0 + ai * HALF + m * 16) * 1024 + col0;
#pragma unroll
                for (int bj = 0; bj < 2; ++bj) { const u32x4 gw = *(const u32x4*)(GB + off + bj * HALF); f32x4 g0, g1; unpack8(gw, g0, g1);
                    const f32x4 v0 = acc[ai][bj][m][0] * sc[bj][0] * g0, v1 = acc[ai][bj][m][1] * sc[bj][1] * g1;
                    *(u32x4*)(YB + off + bj * HALF) = pack8(v0, v1); }
                EPI_FENCE(); }
    }
};
struct EpiMix {
    static constexpr bool PERM = true;
    bf16_t* MIX; const bf16_t* GA; const bf16_t* YB;
    __device__ __forceinline__ void operator()(const f32x4 (&acc)[2][2][4][2], const Unit& u, int wr, int wc, int fr, int fq) const {
        const int row0 = u.pm * BM + wr * 64 + fr, col0 = u.pn * BM + wc * 32 + 8 * fq;
#pragma unroll
        for (int ai = 0; ai < 2; ++ai)
#pragma unroll
            for (int m = 0; m < 4; ++m) { const size_t off = (size_t)(row0 + ai * HALF + m * 16) * 1024 + col0;
#pragma unroll
                for (int bj = 0; bj < 2; ++bj) { const u32x4 gw = *(const u32x4*)(GA + off + bj * HALF), yw = *(const u32x4*)(YB + off + bj * HALF);
                    f32x4 g0, g1, y0, y1; unpack8(gw, g0, g1); unpack8(yw, y0, y1);
                    const f32x4 v0 = acc[ai][bj][m][0] * g0 + y0, v1 = acc[ai][bj][m][1] * g1 + y1;
                    *(u32x4*)(MIX + off + bj * HALF) = pack8(v0, v1); }
                EPI_FENCE(); }
    }
};
struct EpiR1 {
    static constexpr bool PERM = false;
    float* R1; const float* x; const float* st0; const float* g0; const float* b0;
    __device__ __forceinline__ void operator()(const f32x4 (&acc)[2][2][4][2], const Unit& u, int wr, int wc, int fr, int fq) const {
        const int row0 = u.pm * BM + wr * 64 + fr, col0 = u.pn * BM + wc * 32 + 4 * fq;
        f32x4 gg[2][2], bb[2][2];
#pragma unroll
        for (int bj = 0; bj < 2; ++bj)
#pragma unroll
            for (int n = 0; n < 2; ++n) { gg[bj][n] = *(const f32x4*)(g0 + col0 + bj * HALF + 16 * n); bb[bj][n] = *(const f32x4*)(b0 + col0 + bj * HALF + 16 * n); }
#pragma unroll
        for (int ai = 0; ai < 2; ++ai)
#pragma unroll
            for (int m = 0; m < 4; ++m) { const int r = row0 + ai * HALF + m * 16; const size_t off = (size_t)r * 1024 + col0; const f32x2 ms = *(const f32x2*)(st0 + 2 * (size_t)r);
#pragma unroll
                for (int bj = 0; bj < 2; ++bj)
#pragma unroll
                    for (int n = 0; n < 2; ++n) { const f32x4 xv = *(const f32x4*)(x + off + bj * HALF + 16 * n);
                        const f32x4 h = (xv - ms.x) * ms.y * gg[bj][n] + bb[bj][n];
                        *(f32x4*)(R1 + off + bj * HALF + 16 * n) = h * ALPHA + acc[ai][bj][m][n]; }
                EPI_FENCE(); }
    }
};
struct EpiPgq {
    static constexpr bool PERM = true;
    bf16_t* PP; bf16_t* QRY;
    __device__ __forceinline__ void operator()(const f32x4 (&acc)[2][2][4][2], const Unit& u, int wr, int wc, int fr, int fq) const {
        const int row0 = u.pm * BM + wr * 64 + fr;
        if (u.pn < 4) {
            const int col0 = u.pn * BM + wc * 32 + 8 * fq;
#pragma unroll
            for (int ai = 0; ai < 2; ++ai)
#pragma unroll
                for (int m = 0; m < 4; ++m) { const size_t off = (size_t)(row0 + ai * HALF + m * 16) * 1024 + col0;
#pragma unroll
                    for (int bj = 0; bj < 2; ++bj) { const u32x4 pw = *(const u32x4*)(PP + off + bj * HALF); f32x4 p0, p1; unpack8(pw, p0, p1); f32x4 v0, v1;
#pragma unroll
                        for (int e = 0; e < 4; ++e) { v0[e] = sigmoidf_(acc[ai][bj][m][0][e]) * p0[e]; v1[e] = sigmoidf_(acc[ai][bj][m][1][e]) * p1[e]; }
                        *(u32x4*)(PP + off + bj * HALF) = pack8(v0, v1); }
                    EPI_FENCE(); }
        } else {
            const int col0 = (u.pn - 4) * BM + wc * 32 + 8 * fq;
#pragma unroll
            for (int ai = 0; ai < 2; ++ai)
#pragma unroll
                for (int m = 0; m < 4; ++m) { bf16_t* rowp = QRY + (size_t)(row0 + ai * HALF + m * 16) * 2048 + col0;
#pragma unroll
                    for (int bj = 0; bj < 2; ++bj) *(u32x4*)(rowp + bj * HALF) = pack8(acc[ai][bj][m][0], acc[ai][bj][m][1]); }
        }
    }
};
}

typedef GAS unsigned gu32;
#define RLX_AGENT __ATOMIC_RELAXED, __HIP_MEMORY_SCOPE_AGENT
#define XB_TMO      128
#define XB_XCNT(j)  (256  + 64 * (j))
#define XB_XSUB(j)  (1280 + 64 * (j))
#define XB_XGEN(j)  (2304 + 64 * (j))
#define XB_TOP      3328
#define XB_TOPGEN   3392
#define XCD_BAR_WORDS 3456
#define XB_SPIN_CAP (1u << 22)
constexpr int CW_BAR = 4096;
__device__ __forceinline__ unsigned xb_ld(unsigned* p)              { return __hip_atomic_load(p, __ATOMIC_RELAXED, __HIP_MEMORY_SCOPE_AGENT); }
__device__ __forceinline__ unsigned xb_add(unsigned* p, unsigned v) { return __hip_atomic_fetch_add(p, v, __ATOMIC_RELAXED, __HIP_MEMORY_SCOPE_AGENT); }
__device__ __forceinline__ unsigned xb_xcc_id() { return (unsigned)__builtin_amdgcn_s_getreg((3 << 11) | 20) & 0xFu; }
#define XB_SPIN(cond, bar) do { unsigned _sp = 0; while (cond) { __builtin_amdgcn_s_sleep(1); \
    if ((++_sp & 255u) == 0u) { if (xb_ld(&(bar)[XB_TMO])) break; if (_sp > XB_SPIN_CAP) { atomicAdd(&(bar)[XB_TMO], 1u); break; } } } } while (0)
struct XcdBarrier { unsigned* bar; unsigned x; volatile LAS unsigned* st; };
__device__ __forceinline__ XcdBarrier xcd_barrier_post(unsigned* bar, volatile LAS unsigned* st) {
    XcdBarrier b; b.bar = bar; b.x = xb_xcc_id(); b.st = st;
    if (threadIdx.x == 0) (void)xb_add(&bar[XB_XCNT(b.x)], 1u);
    return b;
}
__device__ __forceinline__ void xcd_barrier_complete(unsigned* bar, unsigned x, unsigned& nloc, unsigned& nx) {
    const unsigned G = gridDim.x * gridDim.y * gridDim.z;
    unsigned sum, cnt, mine, sp = 0u;
    for (;;) {
        sum = 0u; cnt = 0u; mine = 0u;
#pragma unroll
        for (unsigned j = 0; j < 16; ++j) { const unsigned c = xb_ld(&bar[XB_XCNT(j)]); sum += c; cnt += (c > 0u) ? 1u : 0u; mine = (j == x) ? c : mine; }
        if (sum == G) break;
        __builtin_amdgcn_s_sleep(1);
        if ((++sp & 255u) == 0u) { if (xb_ld(&bar[XB_TMO])) break; if (sp > XB_SPIN_CAP) { atomicAdd(&bar[XB_TMO], 1u); break; } }
    }
    nloc = mine > 0u ? mine : 1u; nx = cnt > 0u ? cnt : 1u;
}
__device__ __forceinline__ void xcd_barrier(const XcdBarrier& b) {
    asm volatile("s_waitcnt vmcnt(0)" ::: "memory");
    __syncthreads();
    if (threadIdx.x == 0) {
        unsigned* bar = b.bar;
        __builtin_amdgcn_s_waitcnt(0);
        unsigned nloc = b.st[0], nx = b.st[1];
        if (nloc == 0u) { xcd_barrier_complete(bar, b.x, nloc, nx); b.st[0] = nloc; b.st[1] = nx; }
        const unsigned old = xb_add(&bar[XB_XSUB(b.x)], 1u);
        const unsigned gen = old / nloc;
        if (old + 1u == (gen + 1u) * nloc) {
            __builtin_amdgcn_fence(__ATOMIC_RELEASE, "agent");
            asm volatile("s_waitcnt vmcnt(0)" ::: "memory");
            const unsigned og = xb_add(&bar[XB_TOP], 1u);
            const unsigned tg = og / nx;
            if (og + 1u == (tg + 1u) * nx) xb_add(&bar[XB_TOPGEN], 1u);
            else XB_SPIN(xb_ld(&bar[XB_TOPGEN]) == tg, bar);
            __builtin_amdgcn_fence(__ATOMIC_ACQUIRE, "agent");
            xb_add(&bar[XB_XGEN(b.x)], 1u);
            asm volatile("s_waitcnt vmcnt(0)" ::: "memory");
        } else {
            XB_SPIN(xb_ld(&bar[XB_XGEN(b.x)]) == gen, bar);
            __builtin_amdgcn_fence(__ATOMIC_ACQUIRE, "agent");
            asm volatile("s_waitcnt vmcnt(0)" ::: "memory");
        }
    }
    __syncthreads();
}

struct Args { const float* in[21]; float* out; unsigned char* ws; int ph_lo, ph_hi; };
struct Frame {
    LAS unsigned char* lds; volatile LAS unsigned* MISC; gu32* ctl;
    int tid, lane, wave, vcu, G;
};

__device__ __forceinline__ void p0_transpose_item(const float* W, int K, int N, bf16_t* WT, int row_off, LAS float* scr, int item, int lane) {
    const int nblk = N / 32, kb = item / nblk, nb = item % nblk, k0 = 64 * kb, n0 = 32 * nb;
#pragma unroll 8
    for (int i = 0; i < 32; ++i) { const int kk = 2 * i + (lane >> 5); scr[kk * 33 + (lane & 31)] = W[(size_t)(k0 + kk) * N + n0 + (lane & 31)]; }
    LDS_WAIT(); asm volatile("" ::: "memory");
    const int c = lane & 7;
#pragma unroll
    for (int j = 0; j < 4; ++j) { const int n = (lane >> 3) + 8 * j; const LAS float* s = scr + (8 * c) * 33 + n;
        u32x4 o; o.x = pk2(s[0 * 33], s[1 * 33]); o.y = pk2(s[2 * 33], s[3 * 33]); o.z = pk2(s[4 * 33], s[5 * 33]); o.w = pk2(s[6 * 33], s[7 * 33]);
        *(GAS u32x4*)(WT + (size_t)(row_off + n0 + n) * K + k0 + 8 * c) = o; }
    LDS_WAIT(); asm volatile("" ::: "memory");
}
__device__ __forceinline__ void cvt_stream(const float* src, bf16_t* dst, size_t n4, size_t gtid, size_t nthr) {
    for (size_t i = gtid; i < n4; i += nthr) { const f32x4 v = ((const GAS f32x4*)src)[i]; u32x2 o; o.x = pk2(v[0], v[1]); o.y = pk2(v[2], v[3]); ((GAS u32x2*)dst)[i] = o; }
}

__device__ __forceinline__ void phase_prologue(Frame& F, const Args& a) {
    unsigned char* ws = a.ws;
    LAS float* scr = (LAS float*)(F.lds + F.wave * 16384);
    const int gw = F.vcu * NWAVES + F.wave, NGW = F.G * NWAVES;
    const size_t gtid = (size_t)gw * 64 + F.lane, nthr = (size_t)NGW * 64;
    constexpr int I_IN = 16 * (NPROJ / 32), I_SQ = 16 * 32, I_Q = 16 * 64, I_PP = 4 * 32;
    constexpr int NITEMS = I_IN + 3 * I_SQ + I_Q + I_PP;
    for (int it = gw; it < NITEMS; it += NGW) {
        int r = it;
        if (r < I_IN) { p0_transpose_item(a.in[4], 1024, NPROJ, (bf16_t*)(ws + WS_WIN), 0, scr, r, F.lane); continue; } r -= I_IN;
        if (r < I_SQ) { p0_transpose_item(a.in[7], 1024, 1024, (bf16_t*)(ws + WS_WA), 0, scr, r, F.lane); continue; } r -= I_SQ;
        if (r < I_SQ) { p0_transpose_item(a.in[10], 1024, 1024, (bf16_t*)(ws + WS_WOUT), 0, scr, r, F.lane); continue; } r -= I_SQ;
        if (r < I_SQ) { p0_transpose_item(a.in[17], 1024, 1024, (bf16_t*)(ws + WS_WPGQ), 0, scr, r, F.lane); continue; } r -= I_SQ;
        if (r < I_Q) { p0_transpose_item(a.in[13], 1024, 2048, (bf16_t*)(ws + WS_WPGQ), 1024, scr, r, F.lane); continue; } r -= I_Q;
        p0_transpose_item(a.in[18], 256, 1024, (bf16_t*)(ws + WS_WPP), 0, scr, r, F.lane);
    }
    { bf16_t* wp = (bf16_t*)(ws + WS_WPOOL); const float* pw = a.in[8];
      for (size_t i = gtid; i < 1024 * 256; i += nthr) { const int o = (int)(i >> 8), j = (int)(i & 255), g = o >> 8, gsrc = 2 * (g >> 1) + (j >> 7);
          const float v = (gsrc == g) ? pw[((size_t)g * 128 + (j & 127)) * 256 + (o & 255)] : 0.f; wp[i] = (bf16_t)f2bf(v); } }
    { float* oml = (float*)(ws + WS_OML); const float* lb = a.in[5]; for (size_t i = gtid; i < 1024; i += nthr) oml[i] = sigmoidf_(lb[1024 + i] - lb[i]); }
    cvt_stream(a.in[14], (bf16_t*)(ws + WS_SK), (size_t)16 * 128 * 128 / 4, gtid, nthr);
    cvt_stream(a.in[1], (bf16_t*)(ws + WS_PB), (size_t)T * 256 / 4, gtid, nthr);
    cvt_stream(a.in[15], (bf16_t*)(ws + WS_UT), (size_t)NEXP * 1024 / 4, gtid, nthr);
    cvt_stream(a.in[16], (bf16_t*)(ws + WS_VT), (size_t)NEXP * 1024 / 4, gtid, nthr);
    { const float* x = a.in[0]; const float* g0 = a.in[2]; const float* b0 = a.in[3]; bf16_t* XN = (bf16_t*)(ws + WS_XN); float* st = (float*)(ws + WS_ST0);
      for (int m = gw; m < T; m += NGW) {
          const GAS f32x4* xr = (const GAS f32x4*)(x + (size_t)m * D) + F.lane;
          f32x4 v[4]; float s = 0.f;
#pragma unroll
          for (int j = 0; j < 4; ++j) { v[j] = xr[64 * j]; s += (v[j][0] + v[j][1]) + (v[j][2] + v[j][3]); }
          const float mean = wave_sum(s) * (1.f / D); float s2 = 0.f;
#pragma unroll
          for (int j = 0; j < 4; ++j) { v[j] = v[j] - mean; s2 += (v[j][0] * v[j][0] + v[j][1] * v[j][1]) + (v[j][2] * v[j][2] + v[j][3] * v[j][3]); }
          const float rstd = 1.f / sqrtf(wave_sum(s2) * (1.f / D) + LN_EPS);
          if (F.lane == 0) { st[2 * (size_t)m] = mean; st[2 * (size_t)m + 1] = rstd; }
          GAS u32x2* o8 = (GAS u32x2*)(XN + (size_t)m * D) + F.lane;
#pragma unroll
          for (int j = 0; j < 4; ++j) { const f32x4 gg = ((const GAS f32x4*)g0)[64 * j + F.lane], bb = ((const GAS f32x4*)b0)[64 * j + F.lane];
              const f32x4 h = v[j] * rstd * gg + bb; u32x2 o; o.x = pk2(h[0], h[1]); o.y = pk2(h[2], h[3]); o8[64 * j] = o; }
      } }
}

__device__ __forceinline__ void hgrn_unit(Frame& F, const Args& a, int unit) {
    unsigned char* ws = a.ws;
    const bf16_t* Qs = (const bf16_t*)(ws + WS_QS); const bf16_t* Kk = (const bf16_t*)(ws + WS_KK); const bf16_t* Vi = (const bf16_t*)(ws + WS_VI); const bf16_t* SG = (const bf16_t*)(ws + WS_SG);
    bf16_t* OG = (bf16_t*)(ws + WS_OG); const float* ng = a.in[6];
    const int b = unit >> 3, h = unit & 7, tid = F.tid;
    LAS float* Lq = (LAS float*)F.lds; LAS float* Lk = Lq + 4096; LAS float* Lf = Lk + 4096; LAS float* Lv = Lf + 4096; LAS float* Lo = Lv + 4096;
    const int dv = tid & 127, g = tid >> 7;
    float S[32];
#pragma unroll
    for (int j = 0; j < 32; ++j) S[j] = 0.f;
    const int lr = tid >> 4, lc = (tid & 15) * 8;
    for (int n = 0; n < SEQ / 32; ++n) {
        const size_t t0 = (size_t)b * SEQ + (size_t)n * 32;
        const size_t goff = (t0 + lr) * 1024 + h * 128 + lc;
        const u32x4 rq = *(const GAS u32x4*)(Qs + goff), rk = *(const GAS u32x4*)(Kk + goff), rv = *(const GAS u32x4*)(Vi + goff);
        f32x4 q0, q1, k0, k1, v0, v1; pg8::unpack8(rq, q0, q1); pg8::unpack8(rk, k0, k1); pg8::unpack8(rv, v0, v1);
        const int lo = lr * 128 + lc;
        *(LAS f32x4*)(Lq + lo) = q0; *(LAS f32x4*)(Lq + lo + 4) = q1;
        *(LAS f32x4*)(Lk + lo) = k0; *(LAS f32x4*)(Lk + lo + 4) = k1;
        *(LAS f32x4*)(Lf + lo) = 1.0f - k0; *(LAS f32x4*)(Lf + lo + 4) = 1.0f - k1;
        *(LAS f32x4*)(Lv + lo) = v0; *(LAS f32x4*)(Lv + lo + 4) = v1;
        __syncthreads();
#pragma unroll 2
        for (int tok = 0; tok < 32; ++tok) {
            const float vv = Lv[tok * 128 + dv]; float o = 0.f;
#pragma unroll
            for (int j4 = 0; j4 < 8; ++j4) {
                const f32x4 ff = *(const LAS f32x4*)(Lf + tok * 128 + 32 * g + 4 * j4), kk = *(const LAS f32x4*)(Lk + tok * 128 + 32 * g + 4 * j4), qq = *(const LAS f32x4*)(Lq + tok * 128 + 32 * g + 4 * j4);
#pragma unroll
                for (int i = 0; i < 4; ++i) { S[4 * j4 + i] = ff[i] * S[4 * j4 + i] + kk[i] * vv; o += S[4 * j4 + i] * qq[i]; }
            }
            Lo[(tok * 4 + g) * 128 + dv] = o;
        }
        __syncthreads();
        { const int tok = tid >> 4, c8 = (tid & 15) * 8; float ov[8]; float ss = 0.f;
#pragma unroll
          for (int i = 0; i < 8; ++i) { ov[i] = (Lo[(tok * 4 + 0) * 128 + c8 + i] + Lo[(tok * 4 + 1) * 128 + c8 + i]) + (Lo[(tok * 4 + 2) * 128 + c8 + i] + Lo[(tok * 4 + 3) * 128 + c8 + i]); ss += ov[i] * ov[i]; }
          ss += __shfl_xor(ss, 1); ss += __shfl_xor(ss, 2); ss += __shfl_xor(ss, 4); ss += __shfl_xor(ss, 8);
          const float rstd = 1.0f / sqrtf(ss * (1.0f / 128.0f) + RMS_EPS);
          const size_t go = (t0 + tok) * 1024 + h * 128 + c8;
          const u32x4 sgw = *(const GAS u32x4*)(SG + go); f32x4 s0, s1; pg8::unpack8(sgw, s0, s1);
          const f32x4 n0 = *(const GAS f32x4*)(ng + c8), n1 = *(const GAS f32x4*)(ng + c8 + 4);
          f32x4 r0, r1;
#pragma unroll
          for (int i = 0; i < 4; ++i) { r0[i] = ov[i] * rstd * n0[i] * s0[i]; r1[i] = ov[4 + i] * rstd * n1[i] * s1[i]; }
          *(GAS u32x4*)(OG + go) = pg8::pack8(r0, r1); }
    }
    __syncthreads();
}
__device__ __forceinline__ void pool_prep(Frame& F, const Args& a, size_t gtid, size_t nthr) {
    const bf16_t* VP = (const bf16_t*)(a.ws + WS_VP); bf16_t* PL = (bf16_t*)(a.ws + WS_PL);
    for (size_t item = gtid; item < (size_t)T * 64; item += nthr) {
        const int t = (int)(item >> 6), c8 = (int)(item & 63) * 8, gi = c8 >> 7, w = 2 << gi, pos = t & (SEQ - 1), cnt = (pos + 1 < w) ? pos + 1 : w;
        f32x4 s0 = {0.f, 0.f, 0.f, 0.f}, s1 = {0.f, 0.f, 0.f, 0.f}, c0, c1;
        for (int j = 0; j < cnt; ++j) { const u32x4 r = *(const GAS u32x4*)(VP + (size_t)(t - j) * 512 + c8); f32x4 a0, a1; pg8::unpack8(r, a0, a1); s0 += a0; s1 += a1; if (j == 0) { c0 = a0; c1 = a1; } }
        const float inv = 1.0f / (float)cnt;
        *(GAS u32x4*)(PL + (size_t)t * 512 + c8) = pg8::pack8(s0 * inv - c0, s1 * inv - c1);
    }
}

__device__ __forceinline__ void phase_ln1(Frame& F, const Args& a) {
    float* R1 = a.out; bf16_t* H1b = (bf16_t*)(a.ws + WS_H1B); const float* g1 = a.in[11]; const float* b1 = a.in[12];
    const int gw = F.vcu * NWAVES + F.wave, NGW = F.G * NWAVES;
    for (int m = gw; m < T; m += NGW) {
        GAS f32x4* xr = (GAS f32x4*)(R1 + (size_t)m * D) + F.lane;
        f32x4 v[4]; float s = 0.f;
#pragma unroll
        for (int j = 0; j < 4; ++j) { v[j] = xr[64 * j]; s += (v[j][0] + v[j][1]) + (v[j][2] + v[j][3]); }
        const float mean = wave_sum(s) * (1.f / D); float s2 = 0.f;
#pragma unroll
        for (int j = 0; j < 4; ++j) { v[j] = v[j] - mean; s2 += (v[j][0] * v[j][0] + v[j][1] * v[j][1]) + (v[j][2] * v[j][2] + v[j][3] * v[j][3]); }
        const float rstd = 1.f / sqrtf(wave_sum(s2) * (1.f / D) + LN_EPS);
        GAS u32x2* o8 = (GAS u32x2*)(H1b + (size_t)m * D) + F.lane;
#pragma unroll
        for (int j = 0; j < 4; ++j) { const f32x4 gg = ((const GAS f32x4*)g1)[64 * j + F.lane], bb = ((const GAS f32x4*)b1)[64 * j + F.lane];
            const f32x4 h = v[j] * rstd * gg + bb; xr[64 * j] = h; u32x2 o; o.x = pk2(h[0], h[1]); o.y = pk2(h[2], h[3]); o8[64 * j] = o; }
    }
}

typedef float f32x16 __attribute__((ext_vector_type(16)));
__device__ __forceinline__ int ordi(float f) { const int b = __builtin_bit_cast(int, f); return b ^ ((b >> 31) & 0x7fffffff); }
__device__ __forceinline__ float unordi(int k) { const int b = k ^ ((k >> 31) & 0x7fffffff); return __builtin_bit_cast(float, b); }
__device__ __forceinline__ int imax_(int a, int b) { return a > b ? a : b; }
__device__ __forceinline__ int imin_(int a, int b) { return a < b ? a : b; }
__device__ __forceinline__ void tk_insert(int (&a)[16], int x) {
#pragma unroll
    for (int s_ = 0; s_ < 16; ++s_) { const int t = imax_(a[s_], x); x = imin_(a[s_], x); a[s_] = t; }
}
__device__ __forceinline__ void tk_bitonic_merge(int (&c)[16]) {
#pragma unroll
    for (int d = 8; d >= 1; d >>= 1)
#pragma unroll
        for (int s_ = 0; s_ < 16; ++s_) if ((s_ & d) == 0) { const int hi = imax_(c[s_], c[s_ + d]), lo = imin_(c[s_], c[s_ + d]); c[s_] = hi; c[s_ + d] = lo; }
}
__device__ __forceinline__ void tk_pair_merge(int (&a)[16]) {
    int pb[16];
#pragma unroll
    for (int s_ = 0; s_ < 16; ++s_) pb[s_] = __shfl_xor(a[s_], 32);
#pragma unroll
    for (int s_ = 0; s_ < 16; ++s_) a[s_] = imax_(a[s_], pb[15 - s_]);
    tk_bitonic_merge(a);
}
__device__ __forceinline__ int tk_lookup(unsigned long long lo, unsigned long long hi, int a) {
    const unsigned long long sel = (a & 8) ? hi : lo;
    return (int)((sel >> ((a & 7) * 8)) & 0xFFull);
}
__device__ __forceinline__ void phase_topk(Frame& F, const Args& a) {
    const bf16_t* SK = (const bf16_t*)(a.ws + WS_SK); const bf16_t* QRY = (const bf16_t*)(a.ws + WS_QRY);
    int* IDX = (int*)(a.ws + WS_IDX); float* GATE = (float*)(a.ws + WS_GATE);
    const int gw = F.vcu * NWAVES + F.wave, NGW = F.G * NWAVES, lane = F.lane, r = lane & 31, hh = lane >> 5;
    constexpr int IMIN = (int)0x80000000;
    for (int task = gw; task < (T / 32) * 2; task += NGW) {
        const int tile = task >> 1, hg = task & 1; const size_t token = (size_t)tile * 32 + r;
#pragma unroll 1
        for (int hi = 0; hi < 4; ++hi) {
            const int h = hg * 4 + hi;
            int L[2][16];
#pragma unroll
            for (int p = 0; p < 2; ++p) {
                bf16x8 qf[8], af[8];
                const bf16_t* qp = QRY + token * 2048 + h * 256 + p * 128 + hh * 8;
#pragma unroll
                for (int ks = 0; ks < 8; ++ks) qf[ks] = *(const GAS bf16x8*)(qp + ks * 16);
                const bf16_t* skp = SK + ((size_t)(h * 2 + p) * 128 + r) * 128 + hh * 8;
#pragma unroll
                for (int ks = 0; ks < 8; ++ks) af[ks] = *(const GAS bf16x8*)(skp + ks * 16);
                int lst[16];
#pragma unroll
                for (int s_ = 0; s_ < 16; ++s_) lst[s_] = IMIN;
#pragma unroll 1
                for (int mt = 0; mt < 4; ++mt) {
                    f32x16 acc;
#pragma unroll
                    for (int i = 0; i < 16; ++i) acc[i] = 0.f;
#pragma unroll
                    for (int ks = 0; ks < 8; ++ks) acc = __builtin_amdgcn_mfma_f32_32x32x16_bf16(af[ks], qf[ks], acc, 0, 0, 0);
                    const int mtn = (mt < 3) ? mt + 1 : 3;
#pragma unroll
                    for (int ks = 0; ks < 8; ++ks) af[ks] = *(const GAS bf16x8*)(skp + (size_t)mtn * 32 * 128 + ks * 16);
                    const int sub = 32 * mt + 4 * hh;
#pragma unroll
                    for (int i = 0; i < 16; ++i) { const int base = 127 - ((i & 3) + 8 * (i >> 2)); const float sc = acc[i]; const int key = ((ordi(sc) & ~0x7F) | base) - sub; tk_insert(lst, key); }
                }
                tk_pair_merge(lst);
#pragma unroll
                for (int s_ = 0; s_ < 16; ++s_) L[p][s_] = lst[s_];
            }
            float fx[16], fy[16];
#pragma unroll
            for (int s_ = 0; s_ < 16; ++s_) { const int X = hh ? L[1][s_] : L[0][s_], Y = hh ? L[0][s_] : L[1][s_]; fx[s_] = unordi(X); fy[s_] = unordi(Y); }
            int cl[16];
#pragma unroll
            for (int s_ = 0; s_ < 16; ++s_) cl[s_] = IMIN;
#pragma unroll
            for (int ap = 0; ap < 4; ++ap)
#pragma unroll
                for (int bp = ap; bp < 16; ++bp) if ((ap + 1) * (bp + 1) <= 16) {
                    const float sum = fx[ap] + fy[bp];
                    const int pos = hh ? (bp * 16 + ap) : (ap * 16 + bp);
                    int key = (ordi(sum) & ~0xFF) | (255 - pos);
                    if (ap == bp) key = hh ? IMIN : key;
                    tk_insert(cl, key);
                }
            tk_pair_merge(cl);
            unsigned long long aLo = 0ull, aHi = 0ull, bLo = 0ull, bHi = 0ull;
#pragma unroll
            for (int j = 0; j < 8; ++j) { aLo |= (unsigned long long)(unsigned)(127 - (L[0][j] & 0x7F)) << (8 * j); aHi |= (unsigned long long)(unsigned)(127 - (L[0][8 + j] & 0x7F)) << (8 * j);
                bLo |= (unsigned long long)(unsigned)(127 - (L[1][j] & 0x7F)) << (8 * j); bHi |= (unsigned long long)(unsigned)(127 - (L[1][8 + j] & 0x7F)) << (8 * j); }
            int ex[16]; float ev[16]; float esum = 0.f; const float vmax = unordi(cl[0]);
#pragma unroll
            for (int s_ = 0; s_ < 16; ++s_) { const int pos = 255 - (cl[s_] & 0xFF); ex[s_] = tk_lookup(aLo, aHi, pos >> 4) * 128 + tk_lookup(bLo, bHi, pos & 15);
                ev[s_] = __expf(unordi(cl[s_]) - vmax); esum += ev[s_]; }
            const float inv = 1.0f / esum;
            if (hh == 0) { GAS u32x4* ip = (GAS u32x4*)(IDX + token * 128 + h * 16);
#pragma unroll
                for (int w = 0; w < 4; ++w) ip[w] = (u32x4){(unsigned)ex[4 * w], (unsigned)ex[4 * w + 1], (unsigned)ex[4 * w + 2], (unsigned)ex[4 * w + 3]}; }
            else { GAS f32x4* gp = (GAS f32x4*)(GATE + token * 128 + h * 16);
#pragma unroll
                for (int w = 0; w < 4; ++w) gp[w] = (f32x4){ev[4 * w] * inv, ev[4 * w + 1] * inv, ev[4 * w + 2] * inv, ev[4 * w + 3] * inv}; }
        }
    }
}

typedef __bf16 bf16x2_t __attribute__((ext_vector_type(2)));
__device__ __forceinline__ float dot2bf(unsigned a, unsigned b, float acc) { return __builtin_amdgcn_fdot2_f32_bf16(__builtin_bit_cast(bf16x2_t, a), __builtin_bit_cast(bf16x2_t, b), acc, false); }
template <int CTRL> __device__ __forceinline__ float dppf(float x) { return __builtin_bit_cast(float, __builtin_amdgcn_mov_dpp(__builtin_bit_cast(int, x), CTRL, 0xf, 0xf, true)); }
__device__ __forceinline__ float gelu1(float v) {
    const float av = __builtin_fabsf(v), t = __builtin_amdgcn_rcpf(av * 0.2316418882f + 1.0f);
    float q = t * 0.5307027145f + (-0.7265760135f); q = q * t + 0.7107068705f; q = q * t + (-0.142248368f); q = q * t + 0.127414796f; q = q * t;
    const float e = __builtin_amdgcn_exp2f((v * v) * (-0.72134752044f));
    const float m = v * (q * e);
    return v < 0.f ? m : v - m;
}
struct GStage { u32x4 u[2][2], v[2][2]; };
__device__ __forceinline__ void phase_gather(Frame& F, const Args& a, float* OUTP) {
    const bf16_t* UT = (const bf16_t*)(a.ws + WS_UT); const bf16_t* VT = (const bf16_t*)(a.ws + WS_VT); const bf16_t* PLE = (const bf16_t*)(a.ws + WS_PP); const bf16_t* H1b = (const bf16_t*)(a.ws + WS_H1B);
    const int* IDX = (const int*)(a.ws + WS_IDX); const float* GATE = (const float*)(a.ws + WS_GATE);
    float* H = a.out; const float* g2 = a.in[19]; const float* b2 = a.in[20];
    const int gw = F.vcu * NWAVES + F.wave, NGW = F.G * NWAVES, lane = F.lane;
    for (int t = gw; t < T; t += NGW) {
        const int id0 = IDX[(size_t)t * 128 + lane], id1 = IDX[(size_t)t * 128 + 64 + lane];
        const float gt0 = GATE[(size_t)t * 128 + lane], gt1 = GATE[(size_t)t * 128 + 64 + lane];
        u32x4 hb[2];
        hb[0] = *((const GAS u32x4*)(H1b + (size_t)t * D) + lane); hb[1] = *((const GAS u32x4*)(H1b + (size_t)t * D + 512) + lane);
        float acc[16];
#pragma unroll
        for (int i = 0; i < 16; ++i) acc[i] = 0.f;
        GStage st[4];
#define G_LOAD(S_, idv, kk) do { _Pragma("unroll") for (int j_ = 0; j_ < 2; ++j_) { const int e_ = __builtin_amdgcn_readlane(idv, (kk) + j_); \
            const GAS u32x4* up_ = (const GAS u32x4*)(UT + (size_t)e_ * D) + lane; const GAS u32x4* vp_ = (const GAS u32x4*)(VT + (size_t)e_ * D) + lane; \
            st[S_].u[j_][0] = up_[0]; st[S_].u[j_][1] = up_[64]; st[S_].v[j_][0] = vp_[0]; st[S_].v[j_][1] = vp_[64]; } } while (0)
#define G_COMP(S_, gtv, kk) do { float d_[2]; _Pragma("unroll") for (int j_ = 0; j_ < 2; ++j_) { float x_ = 0.f; \
            _Pragma("unroll") for (int c_ = 0; c_ < 4; ++c_) { x_ = dot2bf(st[S_].u[j_][0][c_], hb[0][c_], x_); x_ = dot2bf(st[S_].u[j_][1][c_], hb[1][c_], x_); } d_[j_] = x_; } \
            const auto sw_ = __builtin_amdgcn_permlane32_swap(__builtin_bit_cast(unsigned, d_[0]), __builtin_bit_cast(unsigned, d_[1]), false, false); \
            const unsigned sw0_ = sw_[0], sw1_ = sw_[1]; float x_ = __builtin_bit_cast(float, sw0_) + __builtin_bit_cast(float, sw1_); \
            const auto s16_ = __builtin_amdgcn_permlane16_swap(__builtin_bit_cast(unsigned, x_), __builtin_bit_cast(unsigned, x_), false, false); \
            const unsigned s160_ = s16_[0], s161_ = s16_[1]; x_ = __builtin_bit_cast(float, s160_) + __builtin_bit_cast(float, s161_); \
            x_ += dppf<0x128>(x_); x_ += dppf<0x141>(x_); x_ += dppf<0x4E>(x_); x_ += dppf<0xB1>(x_); \
            const float g0_ = __builtin_bit_cast(float, __builtin_amdgcn_readlane(__builtin_bit_cast(int, gtv), (kk))), g1_ = __builtin_bit_cast(float, __builtin_amdgcn_readlane(__builtin_bit_cast(int, gtv), (kk) + 1)); \
            const float act_ = gelu1(x_) * (lane < 32 ? g0_ : g1_); \
            const float a0_ = __builtin_bit_cast(float, __builtin_amdgcn_readlane(__builtin_bit_cast(int, act_), 0)), a1_ = __builtin_bit_cast(float, __builtin_amdgcn_readlane(__builtin_bit_cast(int, act_), 32)); \
            _Pragma("unroll") for (int hf_ = 0; hf_ < 2; ++hf_) _Pragma("unroll") for (int c_ = 0; c_ < 4; ++c_) { \
                const unsigned w0_ = st[S_].v[0][hf_][c_], w1_ = st[S_].v[1][hf_][c_]; \
                acc[hf_ * 8 + 2 * c_] += a0_ * bflo(w0_); acc[hf_ * 8 + 2 * c_ + 1] += a0_ * bfhi(w0_); \
                acc[hf_ * 8 + 2 * c_] += a1_ * bflo(w1_); acc[hf_ * 8 + 2 * c_ + 1] += a1_ * bfhi(w1_); } } while (0)
#pragma unroll
        for (int hh = 0; hh < 2; ++hh) {
            const int idv = hh ? id1 : id0; const float gtv = hh ? gt1 : gt0;
            G_LOAD(0, idv, 0); G_LOAD(1, idv, 2); G_LOAD(2, idv, 4);
            for (int k = 0; k < 64; k += 8) {
                G_LOAD(3, idv, k + 6); G_COMP(0, gtv, k);
                if (k + 8 < 64) G_LOAD(0, idv, k + 8);
                G_COMP(1, gtv, k + 2);
                if (k + 8 < 64) G_LOAD(1, idv, k + 10);
                G_COMP(2, gtv, k + 4);
                if (k + 8 < 64) G_LOAD(2, idv, k + 12);
                G_COMP(3, gtv, k + 6);
            }
        }
#undef G_LOAD
#undef G_COMP
        GAS f32x4* hp = (GAS f32x4*)(H + (size_t)t * D) + lane * 2;
        f32x4 hv[4]; hv[0] = hp[0]; hv[1] = hp[1]; hv[2] = hp[128]; hv[3] = hp[129];
        const u32x4 pa = *((const GAS u32x4*)(PLE + (size_t)t * D) + lane), pb = *((const GAS u32x4*)(PLE + (size_t)t * D + 512) + lane);
        f32x4 p0, p1, p2, p3; pg8::unpack8(pa, p0, p1); pg8::unpack8(pb, p2, p3);
        f32x4 r[4];
        r[0] = hv[0] * ALPHA + (f32x4){acc[0], acc[1], acc[2], acc[3]} + p0; r[1] = hv[1] * ALPHA + (f32x4){acc[4], acc[5], acc[6], acc[7]} + p1;
        r[2] = hv[2] * ALPHA + (f32x4){acc[8], acc[9], acc[10], acc[11]} + p2; r[3] = hv[3] * ALPHA + (f32x4){acc[12], acc[13], acc[14], acc[15]} + p3;
        float s = 0.f;
#pragma unroll
        for (int i = 0; i < 4; ++i) s += (r[i][0] + r[i][1]) + (r[i][2] + r[i][3]);
        const float mean = wave_sum(s) * (1.f / D); float s2 = 0.f;
#pragma unroll
        for (int i = 0; i < 4; ++i) { r[i] = r[i] - mean; s2 += (r[i][0] * r[i][0] + r[i][1] * r[i][1]) + (r[i][2] * r[i][2] + r[i][3] * r[i][3]); }
        const float rstd = 1.f / sqrtf(wave_sum(s2) * (1.f / D) + LN_EPS);
        const GAS f32x4* gp = (const GAS f32x4*)g2 + lane * 2; const GAS f32x4* bp = (const GAS f32x4*)b2 + lane * 2;
        GAS f32x4* op = (GAS f32x4*)(OUTP + (size_t)t * D) + lane * 2;
        op[0] = r[0] * rstd * gp[0] + bp[0]; op[1] = r[1] * rstd * gp[1] + bp[1]; op[128] = r[2] * rstd * gp[128] + bp[128]; op[129] = r[3] * rstd * gp[129] + bp[129];
    }
}

constexpr int NPHASE = 9;
__global__ void __launch_bounds__(NWAVES * 64, 2) mk_fwd(Args args) {
    extern __shared__ __attribute__((aligned(16))) unsigned char lds[];
    Frame F;
    F.lds = (LAS unsigned char*)lds;
    F.MISC = (volatile LAS unsigned*)(F.lds + MISC_OFF);
    F.tid = threadIdx.x; F.lane = F.tid & 63; F.wave = __builtin_amdgcn_readfirstlane(F.tid >> 6);
    F.G = gridDim.x; { const int bx = blockIdx.x; F.vcu = (F.G % 8 == 0) ? (bx % 8) * (F.G / 8) + bx / 8 : bx; }
    unsigned char* ws = args.ws;
    F.ctl = (gu32*)(ws + WS_CTL);
    for (int u = F.tid; u < (LDS_BYTES - LDSCTL_OFF) / 4; u += NWAVES * 64) ((LAS unsigned*)(F.lds + LDSCTL_OFF))[u] = 0u;
    __syncthreads();
    const int lo = args.ph_lo, hi = args.ph_hi;
    const bool one = (hi - lo) > 1;
    XcdBarrier bar; bar.bar = (unsigned*)(F.ctl + CW_BAR); bar.x = 0; bar.st = nullptr;
    if (one) bar = xcd_barrier_post((unsigned*)(F.ctl + CW_BAR), F.MISC + 8);
#ifndef PH_MASK
#define PH_MASK 0xFFFF
#endif
#define IN(k) (((PH_MASK >> (k)) & 1) && lo <= (k) && (k) < hi)
#define SEAM(k) do { if (IN(k) && IN((k) + 1)) xcd_barrier(bar); } while (0)
#ifndef REP_MASK
#define REP_MASK 0
#define REP_N 1
#endif
#define REPS(k) for (int rep_ = (((REP_MASK >> (k)) & 1) ? REP_N : 1); rep_ > 0; --rep_)
    bf16_t* const GA = (bf16_t*)args.out; bf16_t* const GB = (bf16_t*)args.out + (size_t)T * 1024;

    if (IN(0)) REPS(0) { phase_prologue(F, args); SEAM(0); }
    if (IN(1)) REPS(1) {
        pg8::Gemm g{(const bf16_t*)(ws + WS_XN), (const bf16_t*)(ws + WS_WIN), T, NPROJ, 1024, 1024, 1024, 0, 0};
        pg8::StaticOrder S; S.init(T, NPROJ, F.G, (int)blockIdx.x);
        pg8::EpiProj E{(bf16_t*)(ws + WS_QS), (bf16_t*)(ws + WS_KK), (bf16_t*)(ws + WS_VI), (bf16_t*)(ws + WS_SG), (bf16_t*)(ws + WS_VP), GA, GB, (const float*)(ws + WS_OML)};
        pg8::gemm_phase<pg8::EpiProj>(F.lds, g, S, E);
        SEAM(1);
    }
    if (IN(2)) REPS(2) {
        const int nh = F.G > 64 ? 64 : F.G;
        if ((int)blockIdx.x < nh) { for (int u = blockIdx.x; u < 64; u += nh) hgrn_unit(F, args, u); }
        if (F.G <= 64) pool_prep(F, args, (size_t)blockIdx.x * 512 + F.tid, (size_t)F.G * 512);
        else if ((int)blockIdx.x >= 64) pool_prep(F, args, (size_t)(blockIdx.x - 64) * 512 + F.tid, (size_t)(F.G - 64) * 512);
        SEAM(2);
    }
    if (IN(3)) REPS(3) {
        { pg8::Gemm g{(const bf16_t*)(ws + WS_PL), (const bf16_t*)(ws + WS_WPOOL), T, 1024, 256, 512, 256, 1, 256};
          pg8::StaticOrder S; S.init(T, 1024, F.G, (int)blockIdx.x);
          pg8::EpiYB E{(bf16_t*)(ws + WS_YB), GB, args.in[9]};
          pg8::gemm_phase<pg8::EpiYB>(F.lds, g, S, E); }
        { pg8::Gemm g{(const bf16_t*)(ws + WS_OG), (const bf16_t*)(ws + WS_WA), T, 1024, 1024, 1024, 1024, 0, 0};
          pg8::StaticOrder S; S.init(T, 1024, F.G, (int)blockIdx.x);
          pg8::EpiMix E{(bf16_t*)(ws + WS_MIX), GA, (const bf16_t*)(ws + WS_YB)};
          pg8::gemm_phase<pg8::EpiMix>(F.lds, g, S, E); }
        { pg8::Gemm g{(const bf16_t*)(ws + WS_PB), (const bf16_t*)(ws + WS_WPP), T, 1024, 256, 256, 256, 0, 0};
          pg8::StaticOrder S; S.init(T, 1024, F.G, (int)blockIdx.x);
          pg8::EpiPlain E{(bf16_t*)(ws + WS_PP), 1024};
          pg8::gemm_phase<pg8::EpiPlain>(F.lds, g, S, E); }
        SEAM(3);
    }
    if (IN(4)) REPS(4) {
        pg8::Gemm g{(const bf16_t*)(ws + WS_MIX), (const bf16_t*)(ws + WS_WOUT), T, 1024, 1024, 1024, 1024, 0, 0};
        pg8::StaticOrder S; S.init(T, 1024, F.G, (int)blockIdx.x);
        pg8::EpiR1 E{args.out, args.in[0], (const float*)(ws + WS_ST0), args.in[2], args.in[3]};
        pg8::gemm_phase<pg8::EpiR1>(F.lds, g, S, E);
        SEAM(4);
    }
    if (IN(5)) { phase_ln1(F, args); SEAM(5); }
    if (IN(6)) {
        pg8::Gemm g{(const bf16_t*)(ws + WS_H1B), (const bf16_t*)(ws + WS_WPGQ), T, 3072, 1024, 1024, 1024, 0, 0};
        pg8::StaticOrder S; S.init(T, 3072, F.G, (int)blockIdx.x);
        pg8::EpiPgq E{(bf16_t*)(ws + WS_PP), (bf16_t*)(ws + WS_QRY)};
        pg8::gemm_phase<pg8::EpiPgq>(F.lds, g, S, E);
        SEAM(6);
    }
    if (IN(7)) REPS(7) { phase_topk(F, args); SEAM(7); }
    if (IN(8)) REPS(8) { phase_gather(F, args, rep_ > 1 ? (float*)(ws + WS_QS) : args.out); if (rep_ > 1) xcd_barrier(bar); }
#undef IN
#undef SEAM
}

extern "C" void kernel_launch(void* const* d_in, const int* in_sizes, int n_in, void* d_out, int out_size, void* d_ws, size_t ws_size, hipStream_t stream) {
    static int grid = 0;
    if (grid == 0) {
        if (n_in != 21 || out_size != T * D || ws_size < WS_END) { fprintf(stderr, "kernel_launch: unexpected shapes (n_in %d, out %d, ws %zu)\n", n_in, out_size, ws_size); grid = -1; return; }
        int dev = 0, cus = 0, per_cu = 0;
        if (hipGetDevice(&dev) != hipSuccess || hipDeviceGetAttribute(&cus, hipDeviceAttributeMultiprocessorCount, dev) != hipSuccess) { grid = -1; return; }
        if (hipFuncSetAttribute((const void*)mk_fwd, hipFuncAttributeMaxDynamicSharedMemorySize, LDS_BYTES) != hipSuccess) { fprintf(stderr, "kernel_launch: hipFuncSetAttribute failed\n"); grid = -1; return; }
        if (hipOccupancyMaxActiveBlocksPerMultiprocessor(&per_cu, (const void*)mk_fwd, NWAVES * 64, LDS_BYTES) != hipSuccess || per_cu < 1)
            fprintf(stderr, "kernel_launch: occupancy query reports %d\n", per_cu);
        (void)hipGetLastError();
        grid = cus;
    }
    if (grid < 0) return;
    (void)hipMemsetAsync((char*)d_ws + WS_CTL, 0, CTL_ZERO_BYTES, stream);
    Args a{};
    for (int i = 0; i < 21; ++i) a.in[i] = (const float*)d_in[i];
    a.out = (float*)d_out; a.ws = (unsigned char*)d_ws;
#if MK_ONE_LAUNCH
    a.ph_lo = 0; a.ph_hi = NPHASE;
    hipLaunchKernelGGL(mk_fwd, dim3(grid), dim3(NWAVES * 64), LDS_BYTES, stream, a);
#else
    for (int p = 0; p < NPHASE; ++p) { a.ph_lo = p; a.ph_hi = p + 1; hipLaunchKernelGGL(mk_fwd, dim3(grid), dim3(NWAVES * 64), LDS_BYTES, stream, a); }
#endif
}
```

```cpp
#include <hip/hip_runtime.h>
#include <cstdio>
#include <cstdint>

#ifndef MK_ONE_LAUNCH
#define MK_ONE_LAUNCH 1
#endif

#define LAS __attribute__((address_space(3)))
#define GAS __attribute__((address_space(1)))
typedef unsigned short bf16_t;
typedef short bf16x8 __attribute__((ext_vector_type(8)));
typedef float f32x4 __attribute__((ext_vector_type(4)));
typedef float f32x2 __attribute__((ext_vector_type(2)));
typedef unsigned u32x4 __attribute__((ext_vector_type(4)));
typedef unsigned u32x2 __attribute__((ext_vector_type(2)));

constexpr int BATCH = 8, SEQ = 4096, T = BATCH * SEQ, D = 1024;
constexpr int NPROJ = 6656;
constexpr int NEXP = 16384;
constexpr float ALPHA = 1.189207115002721f;
constexpr float LN_EPS = 1e-5f, RMS_EPS = 1e-6f;
constexpr int NWAVES = 8;

constexpr size_t MiB = 1u << 20;
constexpr size_t WS_CTL = 0, CTL_ZERO_BYTES = 1 * MiB;
constexpr size_t WS_OML = 1 * MiB;
constexpr size_t WS_ST0 = 1 * MiB + 65536;
constexpr size_t WS_WIN = 2 * MiB;
constexpr size_t WS_WA = 15 * MiB;
constexpr size_t WS_WOUT = 17 * MiB;
constexpr size_t WS_WPGQ = 19 * MiB;
constexpr size_t WS_WPP = 25 * MiB;
constexpr size_t WS_WPOOL = 25 * MiB + 512 * 1024;
constexpr size_t WS_SK = 26 * MiB;
constexpr size_t WS_PB = 27 * MiB;
constexpr size_t WS_UT = 43 * MiB;
constexpr size_t WS_VT = 75 * MiB;
constexpr size_t WS_XN = 108 * MiB;
constexpr size_t WS_QS = 172 * MiB, WS_KK = 236 * MiB, WS_VI = 300 * MiB, WS_SG = 364 * MiB;
constexpr size_t WS_VP = 428 * MiB, WS_PL = 460 * MiB;
constexpr size_t WS_END = 492 * MiB;
constexpr size_t WS_OG = WS_XN, WS_YB = WS_QS, WS_MIX = WS_KK, WS_PP = WS_VI, WS_H1B = WS_SG, WS_QRY = WS_QS;
constexpr size_t WS_IDX = WS_VP, WS_GATE = WS_VP + 16 * MiB;

constexpr int RING_BYTES = 131072;
constexpr int LDSCTL_OFF = RING_BYTES, MISC_OFF = LDSCTL_OFF + 320;
constexpr int LDS_BYTES = 147456;

__device__ __forceinline__ unsigned f2bf(float f) { unsigned u = __builtin_bit_cast(unsigned, f); return (u + 0x7fffu + ((u >> 16) & 1u)) >> 16; }
__device__ __forceinline__ unsigned pk2(float lo, float hi) { return f2bf(lo) | (f2bf(hi) << 16); }
__device__ __forceinline__ float bflo(unsigned w) { return __builtin_bit_cast(float, w << 16); }
__device__ __forceinline__ float bfhi(unsigned w) { return __builtin_bit_cast(float, w & 0xffff0000u); }
typedef __bf16 bf16x2_t __attribute__((ext_vector_type(2)));
__device__ __forceinline__ unsigned cvt_pk_bf16(float lo, float hi) { bf16x2_t v; v[0] = (__bf16)lo; v[1] = (__bf16)hi; return __builtin_bit_cast(unsigned, v); }
__device__ __forceinline__ float sigmoidf_(float x) { return __builtin_amdgcn_rcpf(1.0f + __expf(-x)); }
__device__ __forceinline__ float wave_sum(float v) {
#pragma unroll
    for (int o = 1; o < 64; o <<= 1) v += __shfl_xor(v, o);
    return v;
}
#define LDS_WAIT() asm volatile("s_waitcnt lgkmcnt(0)" ::: "memory")
#define VM_WAIT() asm volatile("s_waitcnt vmcnt(0)" ::: "memory")

namespace pg8 {
constexpr int BM = 256, BK = 64, HALF = 128, HTB = HALF * BK * 2, STAGE_BYTES = 8 * HTB, NXCD = 8, WGM = 8;
__host__ __device__ __forceinline__ int lds_byte(int r, int c) { const int st = (r >> 4) * 2 + (c >> 5), rr = r & 15, cc = c & 31, ob = rr * 64 + cc * 2; return st * 1024 + (ob ^ (((ob >> 9) & 1) << 5)); }
__host__ __device__ __forceinline__ void stage_rc(int b, int& R, int& C) { const int st = b / 1024, sb = b % 1024, swz = sb ^ (((sb >> 9) & 1) << 5); R = (st >> 1) * 16 + swz / 64; C = (st & 1) * 32 + (swz % 64) / 2; }
__host__ __device__ __forceinline__ int perm32(int rho) { const int n = rho >> 4, i = rho & 15; return 8 * (i >> 2) + 4 * n + (i & 3); }

struct Unit { int pm, pn; };
struct Gemm { const bf16_t* A; const bf16_t* Bt; int M, N, K, lda, ldb, acol_shift, acol_mul; };

struct StaticOrder {
    int nM, nN, nwg, G, c;
    __host__ __device__ void init(int M, int N, int G_, int c_) { nM = M / BM; nN = N / BM; nwg = nM * nN; G = G_; c = c_; }
    __host__ __device__ bool next(int i, Unit& u) const {
        const long L = (long)i * G + c; if (L >= nwg) return false;
        int wgid = (int)L; { const int q = nwg / NXCD, r = nwg % NXCD, xcd = wgid % NXCD, off = wgid / NXCD; wgid = (xcd < r ? xcd * (q + 1) : r * (q + 1) + (xcd - r) * q) + off; }
        const int nig = WGM * nN, gid = wgid / nig, fm = gid * WGM, gsz = (nM - fm) < WGM ? (nM - fm) : WGM;
        u.pm = fm + ((wgid % nig) % gsz); u.pn = (wgid % nig) / gsz; return true;
    }
};


template <class Epi>
__device__ __forceinline__ void gemm_phase(LAS unsigned char* lds, const Gemm g, const StaticOrder& S, const Epi& E) {
    const int tid = threadIdx.x, wid = __builtin_amdgcn_readfirstlane(tid >> 6), lane = tid & 63, wr = wid >> 2, wc = wid & 3, fr = lane & 15, fq = lane >> 4;
    int K_ = g.K; asm volatile("" : "+s"(K_));
    const int K = K_, nt = K / BK;
    unsigned voffA[2], voffB[2];
#pragma unroll
    for (int i = 0; i < 2; ++i) { int R, C; stage_rc(tid * 16 + i * 8192, R, C); const int Rb = Epi::PERM ? ((R & ~31) + perm32(R & 31)) : R;
        voffA[i] = (unsigned)(R * g.lda + C) * 2u; voffB[i] = (unsigned)(Rb * g.ldb + C) * 2u; }
    const size_t kstep = (size_t)(BK * 2);
    const size_t hstepA = (size_t)HALF * g.lda * 2, hstepB = (size_t)HALF * g.ldb * 2;
    const size_t tstepA = 2 * hstepA, tstepB = 2 * hstepB;
    const unsigned ldsw = (unsigned)wid * 1024u;
    const int aoff = lds_byte(wr * 64 + fr, fq * 8), boff = lds_byte(wc * 32 + fr, fq * 8);
#define PG8_SA(b, h) (((b) * 2 + (h)) * HTB)
#define PG8_SB(b, h) ((4 + (b) * 2 + (h)) * HTB)
#define PG8_STAGE(bufoff, gbase, voff) do { _Pragma("unroll") for (int _i = 0; _i < 2; ++_i) \
        __builtin_amdgcn_global_load_lds((const unsigned*)((const char*)(gbase) + (voff)[_i]), (LAS unsigned*)(lds + (bufoff) + ldsw + _i * 8192), 16, 0, 0); } while (0)
#define PG8_LDA(dst, b, h) do { _Pragma("unroll") for (int m = 0; m < 4; ++m) _Pragma("unroll") for (int k = 0; k < 2; ++k) dst[m][k] = *(const LAS bf16x8*)(lds + PG8_SA(b, h) + aoff + m * 2048 + k * 1024); } while (0)
#define PG8_LDB(dst, b, h) do { _Pragma("unroll") for (int n = 0; n < 2; ++n) _Pragma("unroll") for (int k = 0; k < 2; ++k) dst[n][k] = *(const LAS bf16x8*)(lds + PG8_SB(b, h) + boff + n * 2048 + k * 1024); } while (0)
#define PG8_MMA(ai, bj, At, Bt) do { __builtin_amdgcn_s_setprio(1); _Pragma("unroll") for (int m = 0; m < 4; ++m) _Pragma("unroll") for (int n = 0; n < 2; ++n) _Pragma("unroll") for (int k = 0; k < 2; ++k) \
        acc[ai][bj][m][n] = __builtin_amdgcn_mfma_f32_16x16x32_bf16(Bt[n][k], At[m][k], acc[ai][bj][m][n], 0, 0, 0); __builtin_amdgcn_s_setprio(0); } while (0)
#define PG8_WAIT_V(n) asm volatile("s_waitcnt vmcnt(" #n ")" ::: "memory")
#define PG8_WAIT_L(n) asm volatile("s_waitcnt lgkmcnt(" #n ")" ::: "memory")
#define PG8_BAR __builtin_amdgcn_s_barrier()
#define PG8_SCHED __builtin_amdgcn_sched_barrier(0)
    Unit cur, nxt; int ui = 0;
    if (!S.next(0, cur)) return;
    f32x4 acc[2][2][4][2];
#pragma unroll
    for (int a = 0; a < 2; ++a)
#pragma unroll
        for (int b = 0; b < 2; ++b)
#pragma unroll
            for (int m = 0; m < 4; ++m)
#pragma unroll
                for (int n = 0; n < 2; ++n) acc[a][b][m][n] = (f32x4){0.f, 0.f, 0.f, 0.f};
    bf16x8 At[4][2], B0[2][2], B1[2][2];
    const char* cA = (const char*)g.A + (size_t)cur.pm * tstepA + (size_t)((cur.pn >> g.acol_shift) * g.acol_mul) * 2; const char* cB = (const char*)g.Bt + (size_t)cur.pn * tstepB;
    PG8_STAGE(PG8_SB(0, 0), cB, voffB); PG8_STAGE(PG8_SB(0, 1), cB + hstepB, voffB); PG8_STAGE(PG8_SA(0, 0), cA, voffA); PG8_STAGE(PG8_SA(0, 1), cA + hstepA, voffA);
    if (wr == 1) PG8_BAR;
    PG8_WAIT_V(2); PG8_BAR;
    PG8_STAGE(PG8_SB(1, 0), cB + kstep, voffB); PG8_STAGE(PG8_SA(1, 0), cA + kstep, voffA); PG8_STAGE(PG8_SB(1, 1), cB + hstepB + kstep, voffB);
    PG8_WAIT_V(6); PG8_BAR;
    for (;;) {
        const bool has_next = S.next(ui + 1, nxt);
        const char* nA = has_next ? (const char*)g.A + (size_t)nxt.pm * tstepA + (size_t)((nxt.pn >> g.acol_shift) * g.acol_mul) * 2 : cA;
        const char* nB = has_next ? (const char*)g.Bt + (size_t)nxt.pn * tstepB : cB;
        for (int t = 0; t < nt; t += 2) {
            const bool last = (t == nt - 2);
            const char* a1 = cA + (size_t)(t + 1) * kstep;
            const char* a2 = last ? nA : cA + (size_t)(t + 2) * kstep; const char* b2 = last ? nB : cB + (size_t)(t + 2) * kstep;
            const char* a3 = a2 + kstep; const char* b3 = b2 + kstep;
            PG8_LDB(B0, 0, 0); PG8_LDB(B1, 0, 1); PG8_SCHED; PG8_LDA(At, 0, 0); PG8_STAGE(PG8_SA(1, 1), a1 + hstepA, voffA);
            PG8_WAIT_V(8); PG8_WAIT_L(0); PG8_BAR; PG8_MMA(0, 0, At, B0); PG8_MMA(0, 1, At, B1); PG8_BAR; PG8_SCHED;
            PG8_LDA(At, 0, 1); PG8_STAGE(PG8_SB(0, 0), b2, voffB); PG8_STAGE(PG8_SB(0, 1), b2 + hstepB, voffB); PG8_STAGE(PG8_SA(0, 0), a2, voffA);
            PG8_WAIT_V(8); PG8_WAIT_L(0); PG8_BAR; PG8_MMA(1, 0, At, B0); PG8_MMA(1, 1, At, B1); PG8_BAR; PG8_SCHED;
            PG8_LDB(B0, 1, 0); PG8_LDB(B1, 1, 1); PG8_SCHED; PG8_LDA(At, 1, 0); PG8_STAGE(PG8_SA(0, 1), a2 + hstepA, voffA);
            PG8_WAIT_V(8); PG8_WAIT_L(0); PG8_BAR; PG8_MMA(0, 0, At, B0); PG8_MMA(0, 1, At, B1); PG8_BAR; PG8_SCHED;
            PG8_LDA(At, 1, 1); PG8_STAGE(PG8_SB(1, 0), b3, voffB); PG8_STAGE(PG8_SB(1, 1), b3 + hstepB, voffB); PG8_STAGE(PG8_SA(1, 0), a3, voffA);
            PG8_WAIT_V(8); PG8_WAIT_L(0); PG8_BAR; PG8_MMA(1, 0, At, B0); PG8_MMA(1, 1, At, B1); PG8_BAR; PG8_SCHED;
        }
        if (wr == 0) PG8_BAR;
        E(acc, cur, wr, wc, fr, fq);
        if (!has_next) break;
#pragma unroll
        for (int a = 0; a < 2; ++a)
#pragma unroll
            for (int b = 0; b < 2; ++b)
#pragma unroll
                for (int m = 0; m < 4; ++m)
#pragma unroll
                    for (int n = 0; n < 2; ++n) acc[a][b][m][n] = (f32x4){0.f, 0.f, 0.f, 0.f};
        cur = nxt; cA = nA; cB = nB; ++ui;
        if (wr == 1) PG8_BAR;
    }
    PG8_WAIT_V(0);
    PG8_BAR;
#undef PG8_SA
#undef PG8_SB
#undef PG8_STAGE
#undef PG8_LDA
#undef PG8_LDB
#undef PG8_MMA
#undef PG8_WAIT_V
#undef PG8_WAIT_L
#undef PG8_BAR
#undef PG8_SCHED
}

#define EPI_FENCE() asm volatile("" ::: "memory")
__device__ __forceinline__ u32x4 pack8(const f32x4& v0, const f32x4& v1) { u32x4 w; w.x = cvt_pk_bf16(v0[0], v0[1]); w.y = cvt_pk_bf16(v0[2], v0[3]); w.z = cvt_pk_bf16(v1[0], v1[1]); w.w = cvt_pk_bf16(v1[2], v1[3]); return w; }
__device__ __forceinline__ void unpack8(const u32x4& w, f32x4& v0, f32x4& v1) { v0 = (f32x4){bflo(w.x), bfhi(w.x), bflo(w.y), bfhi(w.y)}; v1 = (f32x4){bflo(w.z), bfhi(w.z), bflo(w.w), bfhi(w.w)}; }

struct EpiProj {
    static constexpr bool PERM = true;
    bf16_t *Qs, *Kk, *Vi, *SG, *VP, *GA, *GB; const float* oml;
    __device__ __forceinline__ void operator()(const f32x4 (&acc)[2][2][4][2], const Unit& u, int wr, int wc, int fr, int fq) const {
        const int pn = u.pn; bf16_t* base; int ldc = 1024, ct, mode;
        if (pn < 4) { base = Qs; ct = pn; mode = 0; } else if (pn < 8) { base = Kk; ct = pn - 4; mode = 1; } else if (pn < 12) { base = Vi; ct = pn - 8; mode = 2; }
        else if (pn < 16) { base = SG; ct = pn - 12; mode = 3; } else if (pn < 18) { base = VP; ct = pn - 16; mode = 2; ldc = 512; }
        else if (pn < 22) { base = GA; ct = pn - 18; mode = 4; } else { base = GB; ct = pn - 22; mode = 4; }
        const int row0 = u.pm * BM + wr * 64 + fr, col0 = ct * 256 + wc * 32 + 8 * fq;
        f32x4 om[2][2];
#pragma unroll
        for (int bj = 0; bj < 2; ++bj)
#pragma unroll
            for (int n = 0; n < 2; ++n) om[bj][n] = (mode == 1) ? *(const f32x4*)(oml + col0 + bj * HALF + 4 * n) : (f32x4){1.f, 1.f, 1.f, 1.f};
#pragma unroll
        for (int ai = 0; ai < 2; ++ai)
#pragma unroll
            for (int m = 0; m < 4; ++m) { bf16_t* rowp = base + (size_t)(row0 + ai * HALF + m * 16) * ldc + col0;
#pragma unroll
                for (int bj = 0; bj < 2; ++bj) { f32x4 v[2] = {acc[ai][bj][m][0], acc[ai][bj][m][1]};
#pragma unroll
                    for (int n = 0; n < 2; ++n)
#pragma unroll
                        for (int e = 0; e < 4; ++e) { const float x = v[n][e]; float y;
                            if (mode == 0) y = x * sigmoidf_(x) * 0.08838834764831845f;
                            else if (mode == 1) y = om[bj][n][e] * sigmoidf_(-x);
                            else if (mode == 2) y = x;
                            else if (mode == 3) y = x * sigmoidf_(x);
                            else y = sigmoidf_(x);
                            v[n][e] = y; }
                    *(u32x4*)(rowp + bj * HALF) = pack8(v[0], v[1]); } }
    }
};
struct EpiPlain {
    static constexpr bool PERM = true;
    bf16_t* O; int ldc;
    __device__ __forceinline__ void operator()(const f32x4 (&acc)[2][2][4][2], const Unit& u, int wr, int wc, int fr, int fq) const {
        const int row0 = u.pm * BM + wr * 64 + fr, col0 = u.pn * BM + wc * 32 + 8 * fq;
#pragma unroll
        for (int ai = 0; ai < 2; ++ai)
#pragma unroll
            for (int m = 0; m < 4; ++m) { bf16_t* rowp = O + (size_t)(row0 + ai * HALF + m * 16) * ldc + col0;
#pragma unroll
                for (int bj = 0; bj < 2; ++bj) *(u32x4*)(rowp + bj * HALF) = pack8(acc[ai][bj][m][0], acc[ai][bj][m][1]); }
    }
};
struct EpiYB {
    static constexpr bool PERM = true;
    bf16_t* YB; const bf16_t* GB; const float* scale;
    __device__ __forceinline__ void operator()(const f32x4 (&acc)[2][2][4][2], const Unit& u, int wr, int wc, int fr, int fq) const {
        const int row0 = u.pm * BM + wr * 64 + fr, col0 = u.pn * BM + wc * 32 + 8 * fq;
        f32x4 sc[2][2];
#pragma unroll
        for (int bj = 0; bj < 2; ++bj)
#pragma unroll
            for (int n = 0; n < 2; ++n) sc[bj][n] = *(const f32x4*)(scale + col0 + bj * HALF + 4 * n);
#pragma unroll
        for (int ai = 0; ai < 2; ++ai)
#pragma unroll
            for (int m = 0; m < 4; ++m) { const size_t off = (size_t)(row0 + ai * HALF + m * 16) * 1024 + col0;
#pragma unroll
                for (int bj = 0; bj < 2; ++bj) { const u32x4 gw = *(const u32x4*)(GB + off + bj * HALF); f32x4 g0, g1; unpack8(gw, g0, g1);
                    const f32x4 v0 = acc[ai][bj][m][0] * sc[bj][0] * g0, v1 = acc[ai][bj][m][1] * sc[bj][1] * g1;
                    *(u32x4*)(YB + off + bj * HALF) = pack8(v0, v1); }
                EPI_FENCE(); }
    }
};
struct EpiMix {
    static constexpr bool PERM = true;
    bf16_t* MIX; const bf16_t* GA; const bf16_t* YB;
    __device__ __forceinline__ void operator()(const f32x4 (&acc)[2][2][4][2], const Unit& u, int wr, int wc, int fr, int fq) const {
        const int row0 = u.pm * BM + wr * 64 + fr, col0 = u.pn * BM + wc * 32 + 8 * fq;
#pragma unroll
        for (int ai = 0; ai < 2; ++ai)
#pragma unroll
            for (int m = 0; m < 4; ++m) { const size_t off = (size_t)(row0 + ai * HALF + m * 16) * 1024 + col0;
#pragma unroll
                for (int bj = 0; bj < 2; ++bj) { const u32x4 gw = *(const u32x4*)(GA + off + bj * HALF), yw = *(const u32x4*)(YB + off + bj * HALF);
                    f32x4 g0, g1, y0, y1; unpack8(gw, g0, g1); unpack8(yw, y0, y1);
                    const f32x4 v0 = acc[ai][bj][m][0] * g0 + y0, v1 = acc[ai][bj][m][1] * g1 + y1;
                    *(u32x4*)(MIX + off + bj * HALF) = pack8(v0, v1); }
                EPI_FENCE(); }
    }
};
struct EpiR1 {
    static constexpr bool PERM = false;
    float* R1; const float* x; const float* st0; const float* g0; const float* b0;
    __device__ __forceinline__ void operator()(const f32x4 (&acc)[2][2][4][2], const Unit& u, int wr, int wc, int fr, int fq) const {
        const int row0 = u.pm * BM + wr * 64 + fr, col0 = u.pn * BM + wc * 32 + 4 * fq;
        f32x4 gg[2][2], bb[2][2];
#pragma unroll
        for (int bj = 0; bj < 2; ++bj)
#pragma unroll
            for (int n = 0; n < 2; ++n) { gg[bj][n] = *(const f32x4*)(g0 + col0 + bj * HALF + 16 * n); bb[bj][n] = *(const f32x4*)(b0 + col0 + bj * HALF + 16 * n); }
#pragma unroll
        for (int ai = 0; ai < 2; ++ai)
#pragma unroll
            for (int m = 0; m < 4; ++m) { const int r = row0 + ai * HALF + m * 16; const size_t off = (size_t)r * 1024 + col0; const f32x2 ms = *(const f32x2*)(st0 + 2 * (size_t)r);
#pragma unroll
                for (int bj = 0; bj < 2; ++bj)
#pragma unroll
                    for (int n = 0; n < 2; ++n) { const f32x4 xv = *(const f32x4*)(x + off + bj * HALF + 16 * n);
                        const f32x4 h = (xv - ms.x) * ms.y * gg[bj][n] + bb[bj][n];
                        *(f32x4*)(R1 + off + bj * HALF + 16 * n) = h * ALPHA + acc[ai][bj][m][n]; }
                EPI_FENCE(); }
    }
};
struct EpiPgq {
    static constexpr bool PERM = true;
    bf16_t* PP; bf16_t* QRY;
    __device__ __forceinline__ void operator()(const f32x4 (&acc)[2][2][4][2], const Unit& u, int wr, int wc, int fr, int fq) const {
        const int row0 = u.pm * BM + wr * 64 + fr;
        if (u.pn < 4) {
            const int col0 = u.pn * BM + wc * 32 + 8 * fq;
#pragma unroll
            for (int ai = 0; ai < 2; ++ai)
#pragma unroll
                for (int m = 0; m < 4; ++m) { const size_t off = (size_t)(row0 + ai * HALF + m * 16) * 1024 + col0;
#pragma unroll
                    for (int bj = 0; bj < 2; ++bj) { const u32x4 pw = *(const u32x4*)(PP + off + bj * HALF); f32x4 p0, p1; unpack8(pw, p0, p1); f32x4 v0, v1;
#pragma unroll
                        for (int e = 0; e < 4; ++e) { v0[e] = sigmoidf_(acc[ai][bj][m][0][e]) * p0[e]; v1[e] = sigmoidf_(acc[ai][bj][m][1][e]) * p1[e]; }
                        *(u32x4*)(PP + off + bj * HALF) = pack8(v0, v1); }
                    EPI_FENCE(); }
        } else {
            const int col0 = (u.pn - 4) * BM + wc * 32 + 8 * fq;
#pragma unroll
            for (int ai = 0; ai < 2; ++ai)
#pragma unroll
                for (int m = 0; m < 4; ++m) { bf16_t* rowp = QRY + (size_t)(row0 + ai * HALF + m * 16) * 2048 + col0;
#pragma unroll
                    for (int bj = 0; bj < 2; ++bj) *(u32x4*)(rowp + bj * HALF) = pack8(acc[ai][bj][m][0], acc[ai][bj][m][1]); }
        }
    }
};
}

typedef GAS unsigned gu32;
#define RLX_AGENT __ATOMIC_RELAXED, __HIP_MEMORY_SCOPE_AGENT
#define XB_TMO      128
#define XB_XCNT(j)  (256  + 64 * (j))
#define XB_XSUB(j)  (1280 + 64 * (j))
#define XB_XGEN(j)  (2304 + 64 * (j))
#define XB_TOP      3328
#define XB_TOPGEN   3392
#define XCD_BAR_WORDS 3456
#define XB_SPIN_CAP (1u << 22)
constexpr int CW_BAR = 4096;
__device__ __forceinline__ unsigned xb_ld(unsigned* p)              { return __hip_atomic_load(p, __ATOMIC_RELAXED, __HIP_MEMORY_SCOPE_AGENT); }
__device__ __forceinline__ unsigned xb_add(unsigned* p, unsigned v) { return __hip_atomic_fetch_add(p, v, __ATOMIC_RELAXED, __HIP_MEMORY_SCOPE_AGENT); }
__device__ __forceinline__ unsigned xb_xcc_id() { return (unsigned)__builtin_amdgcn_s_getreg((3 << 11) | 20) & 0xFu; }
#define XB_SPIN(cond, bar) do { unsigned _sp = 0; while (cond) { __builtin_amdgcn_s_sleep(1); \
    if ((++_sp & 255u) == 0u) { if (xb_ld(&(bar)[XB_TMO])) break; if (_sp > XB_SPIN_CAP) { atomicAdd(&(bar)[XB_TMO], 1u); break; } } } } while (0)
struct XcdBarrier { unsigned* bar; unsigned x; volatile LAS unsigned* st; };
__device__ __forceinline__ XcdBarrier xcd_barrier_post(unsigned* bar, volatile LAS unsigned* st) {
    XcdBarrier b; b.bar = bar; b.x = xb_xcc_id(); b.st = st;
    if (threadIdx.x == 0) (void)xb_add(&bar[XB_XCNT(b.x)], 1u);
    return b;
}
__device__ __forceinline__ void xcd_barrier_complete(unsigned* bar, unsigned x, unsigned& nloc, unsigned& nx) {
    const unsigned G = gridDim.x * gridDim.y * gridDim.z;
    unsigned sum, cnt, mine, sp = 0u;
    for (;;) {
        sum = 0u; cnt = 0u; mine = 0u;
#pragma unroll
        for (unsigned j = 0; j < 16; ++j) { const unsigned c = xb_ld(&bar[XB_XCNT(j)]); sum += c; cnt += (c > 0u) ? 1u : 0u; mine = (j == x) ? c : mine; }
        if (sum == G) break;
        __builtin_amdgcn_s_sleep(1);
        if ((++sp & 255u) == 0u) { if (xb_ld(&bar[XB_TMO])) break; if (sp > XB_SPIN_CAP) { atomicAdd(&bar[XB_TMO], 1u); break; } }
    }
    nloc = mine > 0u ? mine : 1u; nx = cnt > 0u ? cnt : 1u;
}
__device__ __forceinline__ void xcd_barrier(const XcdBarrier& b) {
    asm volatile("s_waitcnt vmcnt(0)" ::: "memory");
    __syncthreads();
    if (threadIdx.x == 0) {
        unsigned* bar = b.bar;
        __builtin_amdgcn_s_waitcnt(0);
        unsigned nloc = b.st[0], nx = b.st[1];
        if (nloc == 0u) { xcd_barrier_complete(bar, b.x, nloc, nx); b.st[0] = nloc; b.st[1] = nx; }
        const unsigned old = xb_add(&bar[XB_XSUB(b.x)], 1u);
        const unsigned gen = old / nloc;
        if (old + 1u == (gen + 1u) * nloc) {
            __builtin_amdgcn_fence(__ATOMIC_RELEASE, "agent");
            asm volatile("s_waitcnt vmcnt(0)" ::: "memory");
            const unsigned og = xb_add(&bar[XB_TOP], 1u);
            const unsigned tg = og / nx;
            if (og + 1u == (tg + 1u) * nx) xb_add(&bar[XB_TOPGEN], 1u);
            else XB_SPIN(xb_ld(&bar[XB_TOPGEN]) == tg, bar);
            __builtin_amdgcn_fence(__ATOMIC_ACQUIRE, "agent");
            xb_add(&bar[XB_XGEN(b.x)], 1u);
            asm volatile("s_waitcnt vmcnt(0)" ::: "memory");
        } else {
            XB_SPIN(xb_ld(&bar[XB_XGEN(b.x)]) == gen, bar);
            __builtin_amdgcn_fence(__ATOMIC_ACQUIRE, "agent");
            asm volatile("s_waitcnt vmcnt(0)" ::: "memory");
        }
    }
    __syncthreads();
}

struct Args { const float* in[21]; float* out; unsigned char* ws; int ph_lo, ph_hi; };
struct Frame {
    LAS unsigned char* lds; volatile LAS unsigned* MISC; gu32* ctl;
    int tid, lane, wave, vcu, G;
};

__device__ __forceinline__ void p0_transpose_item(const float* W, int K, int N, bf16_t* WT, int row_off, LAS float* scr, int item, int lane) {
    const int nblk = N / 32, kb = item / nblk, nb = item % nblk, k0 = 64 * kb, n0 = 32 * nb;
#pragma unroll 8
    for (int i = 0; i < 32; ++i) { const int kk = 2 * i + (lane >> 5); scr[kk * 33 + (lane & 31)] = W[(size_t)(k0 + kk) * N + n0 + (lane & 31)]; }
    LDS_WAIT(); asm volatile("" ::: "memory");
    const int c = lane & 7;
#pragma unroll
    for (int j = 0; j < 4; ++j) { const int n = (lane >> 3) + 8 * j; const LAS float* s = scr + (8 * c) * 33 + n;
        u32x4 o; o.x = pk2(s[0 * 33], s[1 * 33]); o.y = pk2(s[2 * 33], s[3 * 33]); o.z = pk2(s[4 * 33], s[5 * 33]); o.w = pk2(s[6 * 33], s[7 * 33]);
        *(GAS u32x4*)(WT + (size_t)(row_off + n0 + n) * K + k0 + 8 * c) = o; }
    LDS_WAIT(); asm volatile("" ::: "memory");
}
__device__ __forceinline__ void cvt_stream(const float* src, bf16_t* dst, size_t n4, size_t gtid, size_t nthr) {
    for (size_t i = gtid; i < n4; i += nthr) { const f32x4 v = ((const GAS f32x4*)src)[i]; u32x2 o; o.x = pk2(v[0], v[1]); o.y = pk2(v[2], v[3]); ((GAS u32x2*)dst)[i] = o; }
}

__device__ __forceinline__ void phase_prologue(Frame& F, const Args& a) {
    unsigned char* ws = a.ws;
    LAS float* scr = (LAS float*)(F.lds + F.wave * 16384);
    const int gw = F.vcu * NWAVES + F.wave, NGW = F.G * NWAVES;
    const size_t gtid = (size_t)gw * 64 + F.lane, nthr = (size_t)NGW * 64;
    constexpr int I_IN = 16 * (NPROJ / 32), I_SQ = 16 * 32, I_Q = 16 * 64, I_PP = 4 * 32;
    constexpr int NITEMS = I_IN + 3 * I_SQ + I_Q + I_PP;
    for (int it = gw; it < NITEMS; it += NGW) {
        int r = it;
        if (r < I_IN) { p0_transpose_item(a.in[4], 1024, NPROJ, (bf16_t*)(ws + WS_WIN), 0, scr, r, F.lane); continue; } r -= I_IN;
        if (r < I_SQ) { p0_transpose_item(a.in[7], 1024, 1024, (bf16_t*)(ws + WS_WA), 0, scr, r, F.lane); continue; } r -= I_SQ;
        if (r < I_SQ) { p0_transpose_item(a.in[10], 1024, 1024, (bf16_t*)(ws + WS_WOUT), 0, scr, r, F.lane); continue; } r -= I_SQ;
        if (r < I_SQ) { p0_transpose_item(a.in[17], 1024, 1024, (bf16_t*)(ws + WS_WPGQ), 0, scr, r, F.lane); continue; } r -= I_SQ;
        if (r < I_Q) { p0_transpose_item(a.in[13], 1024, 2048, (bf16_t*)(ws + WS_WPGQ), 1024, scr, r, F.lane); continue; } r -= I_Q;
        p0_transpose_item(a.in[18], 256, 1024, (bf16_t*)(ws + WS_WPP), 0, scr, r, F.lane);
    }
    { bf16_t* wp = (bf16_t*)(ws + WS_WPOOL); const float* pw = a.in[8];
      for (size_t i = gtid; i < 1024 * 256; i += nthr) { const int o = (int)(i >> 8), j = (int)(i & 255), g = o >> 8, gsrc = 2 * (g >> 1) + (j >> 7);
          const float v = (gsrc == g) ? pw[((size_t)g * 128 + (j & 127)) * 256 + (o & 255)] : 0.f; wp[i] = (bf16_t)f2bf(v); } }
    { float* oml = (float*)(ws + WS_OML); const float* lb = a.in[5]; for (size_t i = gtid; i < 1024; i += nthr) oml[i] = sigmoidf_(lb[1024 + i] - lb[i]); }
    cvt_stream(a.in[14], (bf16_t*)(ws + WS_SK), (size_t)16 * 128 * 128 / 4, gtid, nthr);
    cvt_stream(a.in[1], (bf16_t*)(ws + WS_PB), (size_t)T * 256 / 4, gtid, nthr);
    cvt_stream(a.in[15], (bf16_t*)(ws + WS_UT), (size_t)NEXP * 1024 / 4, gtid, nthr);
    cvt_stream(a.in[16], (bf16_t*)(ws + WS_VT), (size_t)NEXP * 1024 / 4, gtid, nthr);
    { const float* x = a.in[0]; const float* g0 = a.in[2]; const float* b0 = a.in[3]; bf16_t* XN = (bf16_t*)(ws + WS_XN); float* st = (float*)(ws + WS_ST0);
      for (int m = gw; m < T; m += NGW) {
          const GAS f32x4* xr = (const GAS f32x4*)(x + (size_t)m * D) + F.lane;
          f32x4 v[4]; float s = 0.f;
#pragma unroll
          for (int j = 0; j < 4; ++j) { v[j] = xr[64 * j]; s += (v[j][0] + v[j][1]) + (v[j][2] + v[j][3]); }
          const float mean = wave_sum(s) * (1.f / D); float s2 = 0.f;
#pragma unroll
          for (int j = 0; j < 4; ++j) { v[j] = v[j] - mean; s2 += (v[j][0] * v[j][0] + v[j][1] * v[j][1]) + (v[j][2] * v[j][2] + v[j][3] * v[j][3]); }
          const float rstd = 1.f / sqrtf(wave_sum(s2) * (1.f / D) + LN_EPS);
          if (F.lane == 0) { st[2 * (size_t)m] = mean; st[2 * (size_t)m + 1] = rstd; }
          GAS u32x2* o8 = (GAS u32x2*)(XN + (size_t)m * D) + F.lane;
#pragma unroll
          for (int j = 0; j < 4; ++j) { const f32x4 gg = ((const GAS f32x4*)g0)[64 * j + F.lane], bb = ((const GAS f32x4*)b0)[64 * j + F.lane];
              const f32x4 h = v[j] * rstd * gg + bb; u32x2 o; o.x = pk2(h[0], h[1]); o.y = pk2(h[2], h[3]); o8[64 * j] = o; }
      } }
}

constexpr int HG_QD = 0, HG_KI = 8704, HG_KET = 17408, HG_VT = 25600, HG_DEC = 33792, HG_SEG = 34304, HG_PART = 38400;
__device__ __forceinline__ int hg_toff(int row, int slot) { return row * 64 + ((slot ^ ((row >> 1) & 7)) << 3); }
__device__ __forceinline__ float xrow16_sum(float x) {
    const auto s_ = __builtin_amdgcn_permlane16_swap(__builtin_bit_cast(unsigned, x), __builtin_bit_cast(unsigned, x), false, false);
    const unsigned s0 = s_[0], s1 = s_[1]; x = __builtin_bit_cast(float, s0) + __builtin_bit_cast(float, s1);
    const auto t_ = __builtin_amdgcn_permlane32_swap(__builtin_bit_cast(unsigned, x), __builtin_bit_cast(unsigned, x), false, false);
    const unsigned t0 = t_[0], t1 = t_[1]; return __builtin_bit_cast(float, t0) + __builtin_bit_cast(float, t1);
}
__device__ __forceinline__ bf16x8 mk_frag(unsigned a, unsigned b, unsigned c, unsigned d) { const u32x4 v = {a, b, c, d}; return __builtin_bit_cast(bf16x8, v); }
__device__ __forceinline__ bf16x8 ld_frag2(const LAS unsigned char* p0, const LAS unsigned char* p1) { const u32x2 a = *(const LAS u32x2*)p0, b = *(const LAS u32x2*)p1; return mk_frag(a.x, a.y, b.x, b.y); }
#define MFMA16(A_, B_, C_) __builtin_amdgcn_mfma_f32_16x16x32_bf16((A_), (B_), (C_), 0, 0, 0)
__device__ __forceinline__ void hgrn_unit(Frame& F, const Args& a, int unit) {
    unsigned char* ws = a.ws;
    const bf16_t* Qs = (const bf16_t*)(ws + WS_QS); const bf16_t* Kk = (const bf16_t*)(ws + WS_KK); const bf16_t* Vi = (const bf16_t*)(ws + WS_VI); const bf16_t* SG = (const bf16_t*)(ws + WS_SG);
    bf16_t* OG = (bf16_t*)(ws + WS_OG);
    const int b = unit >> 3, h = unit & 7, lane = F.lane, w = F.wave, r = lane & 15, q = lane >> 4, cp = lane;
    LAS unsigned char* L = F.lds;
    const f32x4 ngv = *(const GAS f32x4*)(a.in[6] + 16 * w + 4 * q);
    f32x4 S[8];
#pragma unroll
    for (int t = 0; t < 8; ++t) S[t] = (f32x4){0.f, 0.f, 0.f, 0.f};
    f32x4 O[2]; O[0] = O[1] = (f32x4){0.f, 0.f, 0.f, 0.f};
    u32x2 sgc[2], sgn[2]; sgc[0] = sgc[1] = sgn[0] = sgn[1] = (u32x2){0u, 0u};
    unsigned rq[4], rk[4], rv[4];
    const size_t tb = (size_t)b * SEQ;
    {
        const size_t g0 = (tb + 4 * w) * 1024 + h * 128 + 2 * cp;
#pragma unroll
        for (int i = 0; i < 4; ++i) { rq[i] = *(const GAS unsigned*)(Qs + g0 + (size_t)i * 1024); rk[i] = *(const GAS unsigned*)(Kk + g0 + (size_t)i * 1024); rv[i] = *(const GAS unsigned*)(Vi + g0 + (size_t)i * 1024); }
#pragma unroll
        for (int ct = 0; ct < 2; ++ct) sgn[ct] = *(const GAS u32x2*)(SG + (tb + 16 * ct + r) * 1024 + h * 128 + 16 * w + 4 * q);
    }
    for (int n = 0; n <= SEQ / 32; ++n) {
        const bool live = n < SEQ / 32;
        const size_t t0 = tb + (size_t)n * 32;
        float kv[4][2], qv[4][2], vv[4][2], cum[4][2];
        if (live) {
#pragma unroll
            for (int i = 0; i < 4; ++i) { kv[i][0] = bflo(rk[i]); kv[i][1] = bfhi(rk[i]); qv[i][0] = bflo(rq[i]); qv[i][1] = bfhi(rq[i]); vv[i][0] = bflo(rv[i]); vv[i][1] = bfhi(rv[i]); }
#pragma unroll
            for (int e = 0; e < 2; ++e) { float c_ = 0.f;
#pragma unroll
                for (int i = 0; i < 4; ++i) { c_ += __logf(1.0f - kv[i][e]); cum[i][e] = c_; } }
            *(LAS f32x2*)(L + HG_SEG + (w * 128 + 2 * cp) * 4) = (f32x2){cum[3][0], cum[3][1]};
            if (n + 1 < SEQ / 32) {
                const size_t g0 = (t0 + 32 + 4 * w) * 1024 + h * 128 + 2 * cp;
#pragma unroll
                for (int i = 0; i < 4; ++i) { rq[i] = *(const GAS unsigned*)(Qs + g0 + (size_t)i * 1024); rk[i] = *(const GAS unsigned*)(Kk + g0 + (size_t)i * 1024); rv[i] = *(const GAS unsigned*)(Vi + g0 + (size_t)i * 1024); }
            }
        }
        __syncthreads();
        if (n > 0) {
            const size_t tp = t0 - 32;
#pragma unroll
            for (int ct = 0; ct < 2; ++ct) { float tot = 0.f;
#pragma unroll
                for (int ww = 0; ww < 8; ++ww) tot += *(const LAS float*)(L + HG_PART + (ww * 32 + 16 * ct + r) * 4);
                const float rstd = 1.0f / sqrtf(tot * (1.0f / 128.0f) + RMS_EPS);
                const f32x4 sg = {bflo(sgc[ct].x), bfhi(sgc[ct].x), bflo(sgc[ct].y), bfhi(sgc[ct].y)};
                const f32x4 o = O[ct] * rstd * ngv * sg;
                u32x2 pk; pk.x = cvt_pk_bf16(o[0], o[1]); pk.y = cvt_pk_bf16(o[2], o[3]);
                *(GAS u32x2*)(OG + (tp + 16 * ct + r) * 1024 + h * 128 + 16 * w + 4 * q) = pk; }
        }
        if (!live) break;
        sgc[0] = sgn[0]; sgc[1] = sgn[1];
        if (n + 1 < SEQ / 32) {
#pragma unroll
            for (int ct = 0; ct < 2; ++ct) sgn[ct] = *(const GAS u32x2*)(SG + (t0 + 32 + 16 * ct + r) * 1024 + h * 128 + 16 * w + 4 * q);
        }
        {
            float pre[2] = {0.f, 0.f}, tot[2] = {0.f, 0.f};
#pragma unroll
            for (int s_ = 0; s_ < 8; ++s_) { const f32x2 v = *(const LAS f32x2*)(L + HG_SEG + (s_ * 128 + 2 * cp) * 4); tot[0] += v.x; tot[1] += v.y; if (s_ < w) { pre[0] += v.x; pre[1] += v.y; } }
            float dec[2] = {__expf(tot[0]), __expf(tot[1])};
            if (w == 0) *(LAS f32x2*)(L + HG_DEC + 2 * cp * 4) = (f32x2){dec[0], dec[1]};
            float ke[4][2];
#pragma unroll
            for (int i = 0; i < 4; ++i) { float qd[2], ki[2];
#pragma unroll
                for (int e = 0; e < 2; ++e) { const float eb = __expf(pre[e] + cum[i][e]), ieb = __builtin_amdgcn_rcpf(eb); qd[e] = qv[i][e] * eb; ki[e] = kv[i][e] * ieb; ke[i][e] = ki[e] * dec[e]; }
                *(LAS unsigned*)(L + HG_QD + (4 * w + i) * 272 + 4 * cp) = cvt_pk_bf16(qd[0], qd[1]);
                *(LAS unsigned*)(L + HG_KI + (4 * w + i) * 272 + 4 * cp) = cvt_pk_bf16(ki[0], ki[1]); }
#pragma unroll
            for (int e = 0; e < 2; ++e) { const int row = 2 * cp + e;
                *(LAS u32x2*)(L + HG_KET + hg_toff(row, w)) = (u32x2){cvt_pk_bf16(ke[0][e], ke[1][e]), cvt_pk_bf16(ke[2][e], ke[3][e])};
                *(LAS u32x2*)(L + HG_VT + hg_toff(row, w)) = (u32x2){cvt_pk_bf16(vv[0][e], vv[1][e]), cvt_pk_bf16(vv[2][e], vv[3][e])}; }
        }
        __syncthreads();
        {
            f32x4 X00 = {0.f, 0.f, 0.f, 0.f}, X01 = X00, X11 = X00;
#pragma unroll
            for (int kk = 0; kk < 4; ++kk) {
                const bf16x8 ka0 = *(const LAS bf16x8*)(L + HG_KI + r * 272 + 64 * kk + 16 * q), ka1 = *(const LAS bf16x8*)(L + HG_KI + (16 + r) * 272 + 64 * kk + 16 * q);
                const bf16x8 qb0 = *(const LAS bf16x8*)(L + HG_QD + r * 272 + 64 * kk + 16 * q), qb1 = *(const LAS bf16x8*)(L + HG_QD + (16 + r) * 272 + 64 * kk + 16 * q);
                X00 = MFMA16(ka0, qb0, X00); X01 = MFMA16(ka0, qb1, X01); X11 = MFMA16(ka1, qb1, X11);
            }
#pragma unroll
            for (int i = 0; i < 4; ++i) { const bool keep = (4 * q + i) <= r; X00[i] = keep ? X00[i] : 0.f; X11[i] = keep ? X11[i] : 0.f; }
            const bf16x8 xb0 = mk_frag(cvt_pk_bf16(X00[0], X00[1]), cvt_pk_bf16(X00[2], X00[3]), 0u, 0u);
            const bf16x8 xb1 = mk_frag(cvt_pk_bf16(X01[0], X01[1]), cvt_pk_bf16(X01[2], X01[3]), cvt_pk_bf16(X11[0], X11[1]), cvt_pk_bf16(X11[2], X11[3]));
            const int vrow = 16 * w + r;
            const bf16x8 va = ld_frag2(L + HG_VT + hg_toff(vrow, q), L + HG_VT + hg_toff(vrow, 4 + q));
            O[0] = MFMA16(va, xb0, ((f32x4){0.f, 0.f, 0.f, 0.f})); O[1] = MFMA16(va, xb1, ((f32x4){0.f, 0.f, 0.f, 0.f}));
#pragma unroll
            for (int kk = 0; kk < 4; ++kk) {
                const bf16x8 sa = mk_frag(cvt_pk_bf16(S[2 * kk][0], S[2 * kk][1]), cvt_pk_bf16(S[2 * kk][2], S[2 * kk][3]), cvt_pk_bf16(S[2 * kk + 1][0], S[2 * kk + 1][1]), cvt_pk_bf16(S[2 * kk + 1][2], S[2 * kk + 1][3]));
                const bf16x8 qb0 = ld_frag2(L + HG_QD + r * 272 + 64 * kk + 8 * q, L + HG_QD + r * 272 + 64 * kk + 32 + 8 * q);
                const bf16x8 qb1 = ld_frag2(L + HG_QD + (16 + r) * 272 + 64 * kk + 8 * q, L + HG_QD + (16 + r) * 272 + 64 * kk + 32 + 8 * q);
                O[0] = MFMA16(sa, qb0, O[0]); O[1] = MFMA16(sa, qb1, O[1]);
            }
            const bf16x8 vb = ld_frag2(L + HG_VT + hg_toff(vrow, 2 * q), L + HG_VT + hg_toff(vrow, 2 * q + 1));
#pragma unroll
            for (int t = 0; t < 8; ++t) {
                const f32x4 dc = *(const LAS f32x4*)(L + HG_DEC + (16 * t + 4 * q) * 4);
                const int krow = 16 * t + r;
                const bf16x8 ka = ld_frag2(L + HG_KET + hg_toff(krow, 2 * q), L + HG_KET + hg_toff(krow, 2 * q + 1));
                S[t] = MFMA16(ka, vb, S[t] * dc);
            }
#pragma unroll
            for (int ct = 0; ct < 2; ++ct) { const float ss = xrow16_sum((O[ct][0] * O[ct][0] + O[ct][1] * O[ct][1]) + (O[ct][2] * O[ct][2] + O[ct][3] * O[ct][3]));
                if (q == 0) *(LAS float*)(L + HG_PART + (w * 32 + 16 * ct + r) * 4) = ss; }
        }
    }
    __syncthreads();
}
__device__ __forceinline__ void pool_prep(Frame& F, const Args& a, size_t gtid, size_t nthr) {
    const bf16_t* VP = (const bf16_t*)(a.ws + WS_VP); bf16_t* PL = (bf16_t*)(a.ws + WS_PL);
    for (size_t item = gtid; item < (size_t)T * 64; item += nthr) {
        const int t = (int)(item >> 6), c8 = (int)(item & 63) * 8, gi = c8 >> 7, w = 2 << gi, pos = t & (SEQ - 1), cnt = (pos + 1 < w) ? pos + 1 : w;
        f32x4 s0 = {0.f, 0.f, 0.f, 0.f}, s1 = {0.f, 0.f, 0.f, 0.f}, c0, c1;
        for (int j = 0; j < cnt; ++j) { const u32x4 r = *(const GAS u32x4*)(VP + (size_t)(t - j) * 512 + c8); f32x4 a0, a1; pg8::unpack8(r, a0, a1); s0 += a0; s1 += a1; if (j == 0) { c0 = a0; c1 = a1; } }
        const float inv = 1.0f / (float)cnt;
        *(GAS u32x4*)(PL + (size_t)t * 512 + c8) = pg8::pack8(s0 * inv - c0, s1 * inv - c1);
    }
}

__device__ __forceinline__ void phase_ln1(Frame& F, const Args& a) {
    float* R1 = a.out; bf16_t* H1b = (bf16_t*)(a.ws + WS_H1B); const float* g1 = a.in[11]; const float* b1 = a.in[12];
    const int gw = F.vcu * NWAVES + F.wave, NGW = F.G * NWAVES;
    for (int m = gw; m < T; m += NGW) {
        GAS f32x4* xr = (GAS f32x4*)(R1 + (size_t)m * D) + F.lane;
        f32x4 v[4]; float s = 0.f;
#pragma unroll
        for (int j = 0; j < 4; ++j) { v[j] = xr[64 * j]; s += (v[j][0] + v[j][1]) + (v[j][2] + v[j][3]); }
        const float mean = wave_sum(s) * (1.f / D); float s2 = 0.f;
#pragma unroll
        for (int j = 0; j < 4; ++j) { v[j] = v[j] - mean; s2 += (v[j][0] * v[j][0] + v[j][1] * v[j][1]) + (v[j][2] * v[j][2] + v[j][3] * v[j][3]); }
        const float rstd = 1.f / sqrtf(wave_sum(s2) * (1.f / D) + LN_EPS);
        GAS u32x2* o8 = (GAS u32x2*)(H1b + (size_t)m * D) + F.lane;
#pragma unroll
        for (int j = 0; j < 4; ++j) { const f32x4 gg = ((const GAS f32x4*)g1)[64 * j + F.lane], bb = ((const GAS f32x4*)b1)[64 * j + F.lane];
            const f32x4 h = v[j] * rstd * gg + bb; xr[64 * j] = h; u32x2 o; o.x = pk2(h[0], h[1]); o.y = pk2(h[2], h[3]); o8[64 * j] = o; }
    }
}

typedef float f32x16 __attribute__((ext_vector_type(16)));
__device__ __forceinline__ int ordi(float f) { const int b = __builtin_bit_cast(int, f); return b ^ ((b >> 31) & 0x7fffffff); }
__device__ __forceinline__ float unordi(int k) { const int b = k ^ ((k >> 31) & 0x7fffffff); return __builtin_bit_cast(float, b); }
__device__ __forceinline__ int imax_(int a, int b) { return a > b ? a : b; }
__device__ __forceinline__ int imin_(int a, int b) { return a < b ? a : b; }
__device__ __forceinline__ void tk_insert(int (&a)[16], int x) {
#pragma unroll
    for (int s_ = 0; s_ < 16; ++s_) { const int t = imax_(a[s_], x); x = imin_(a[s_], x); a[s_] = t; }
}
__device__ __forceinline__ void tk_bitonic_merge(int (&c)[16]) {
#pragma unroll
    for (int d = 8; d >= 1; d >>= 1)
#pragma unroll
        for (int s_ = 0; s_ < 16; ++s_) if ((s_ & d) == 0) { const int hi = imax_(c[s_], c[s_ + d]), lo = imin_(c[s_], c[s_ + d]); c[s_] = hi; c[s_ + d] = lo; }
}
__device__ __forceinline__ void tk_pair_merge(int (&a)[16]) {
    int pb[16];
#pragma unroll
    for (int s_ = 0; s_ < 16; ++s_) pb[s_] = __shfl_xor(a[s_], 32);
#pragma unroll
    for (int s_ = 0; s_ < 16; ++s_) a[s_] = imax_(a[s_], pb[15 - s_]);
    tk_bitonic_merge(a);
}
__device__ __forceinline__ int tk_lookup(unsigned long long lo, unsigned long long hi, int a) {
    const unsigned long long sel = (a & 8) ? hi : lo;
    return (int)((sel >> ((a & 7) * 8)) & 0xFFull);
}
__device__ __forceinline__ void phase_topk(Frame& F, const Args& a) {
    const bf16_t* SK = (const bf16_t*)(a.ws + WS_SK); const bf16_t* QRY = (const bf16_t*)(a.ws + WS_QRY);
    int* IDX = (int*)(a.ws + WS_IDX); float* GATE = (float*)(a.ws + WS_GATE);
    const int gw = F.vcu * NWAVES + F.wave, NGW = F.G * NWAVES, lane = F.lane, r = lane & 31, hh = lane >> 5;
    constexpr int IMIN = (int)0x80000000;
    for (int task = gw; task < (T / 32) * 2; task += NGW) {
        const int tile = task >> 1, hg = task & 1; const size_t token = (size_t)tile * 32 + r;
#pragma unroll 1
        for (int hi = 0; hi < 4; ++hi) {
            const int h = hg * 4 + hi;
            int L[2][16];
#pragma unroll
            for (int p = 0; p < 2; ++p) {
                bf16x8 qf[8], af[8];
                const bf16_t* qp = QRY + token * 2048 + h * 256 + p * 128 + hh * 8;
#pragma unroll
                for (int ks = 0; ks < 8; ++ks) qf[ks] = *(const GAS bf16x8*)(qp + ks * 16);
                const bf16_t* skp = SK + ((size_t)(h * 2 + p) * 128 + r) * 128 + hh * 8;
#pragma unroll
                for (int ks = 0; ks < 8; ++ks) af[ks] = *(const GAS bf16x8*)(skp + ks * 16);
                int lst[16];
#pragma unroll
                for (int s_ = 0; s_ < 16; ++s_) lst[s_] = IMIN;
#pragma unroll 1
                for (int mt = 0; mt < 4; ++mt) {
                    f32x16 acc;
#pragma unroll
                    for (int i = 0; i < 16; ++i) acc[i] = 0.f;
#pragma unroll
                    for (int ks = 0; ks < 8; ++ks) acc = __builtin_amdgcn_mfma_f32_32x32x16_bf16(af[ks], qf[ks], acc, 0, 0, 0);
                    const int mtn = (mt < 3) ? mt + 1 : 3;
#pragma unroll
                    for (int ks = 0; ks < 8; ++ks) af[ks] = *(const GAS bf16x8*)(skp + (size_t)mtn * 32 * 128 + ks * 16);
                    const int sub = 32 * mt + 4 * hh;
#pragma unroll
                    for (int i = 0; i < 16; ++i) { const int base = 127 - ((i & 3) + 8 * (i >> 2)); const float sc = acc[i]; const int key = ((ordi(sc) & ~0x7F) | base) - sub; tk_insert(lst, key); }
                }
                tk_pair_merge(lst);
#pragma unroll
                for (int s_ = 0; s_ < 16; ++s_) L[p][s_] = lst[s_];
            }
            float fx[16], fy[16];
#pragma unroll
            for (int s_ = 0; s_ < 16; ++s_) { const int X = hh ? L[1][s_] : L[0][s_], Y = hh ? L[0][s_] : L[1][s_]; fx[s_] = unordi(X); fy[s_] = unordi(Y); }
            int cl[16];
#pragma unroll
            for (int s_ = 0; s_ < 16; ++s_) cl[s_] = IMIN;
#pragma unroll
            for (int ap = 0; ap < 4; ++ap)
#pragma unroll
                for (int bp = ap; bp < 16; ++bp) if ((ap + 1) * (bp + 1) <= 16) {
                    const float sum = fx[ap] + fy[bp];
                    const int pos = hh ? (bp * 16 + ap) : (ap * 16 + bp);
                    int key = (ordi(sum) & ~0xFF) | (255 - pos);
                    if (ap == bp) key = hh ? IMIN : key;
                    tk_insert(cl, key);
                }
            tk_pair_merge(cl);
            unsigned long long aLo = 0ull, aHi = 0ull, bLo = 0ull, bHi = 0ull;
#pragma unroll
            for (int j = 0; j < 8; ++j) { aLo |= (unsigned long long)(unsigned)(127 - (L[0][j] & 0x7F)) << (8 * j); aHi |= (unsigned long long)(unsigned)(127 - (L[0][8 + j] & 0x7F)) << (8 * j);
                bLo |= (unsigned long long)(unsigned)(127 - (L[1][j] & 0x7F)) << (8 * j); bHi |= (unsigned long long)(unsigned)(127 - (L[1][8 + j] & 0x7F)) << (8 * j); }
            int ex[16]; float ev[16]; float esum = 0.f; const float vmax = unordi(cl[0]);
#pragma unroll
            for (int s_ = 0; s_ < 16; ++s_) { const int pos = 255 - (cl[s_] & 0xFF); ex[s_] = tk_lookup(aLo, aHi, pos >> 4) * 128 + tk_lookup(bLo, bHi, pos & 15);
                ev[s_] = __expf(unordi(cl[s_]) - vmax); esum += ev[s_]; }
            const float inv = 1.0f / esum;
            if (hh == 0) { GAS u32x4* ip = (GAS u32x4*)(IDX + token * 128 + h * 16);
#pragma unroll
                for (int w = 0; w < 4; ++w) ip[w] = (u32x4){(unsigned)ex[4 * w], (unsigned)ex[4 * w + 1], (unsigned)ex[4 * w + 2], (unsigned)ex[4 * w + 3]}; }
            else { GAS f32x4* gp = (GAS f32x4*)(GATE + token * 128 + h * 16);
#pragma unroll
                for (int w = 0; w < 4; ++w) gp[w] = (f32x4){ev[4 * w] * inv, ev[4 * w + 1] * inv, ev[4 * w + 2] * inv, ev[4 * w + 3] * inv}; }
        }
    }
}

__device__ __forceinline__ float dot2bf(unsigned a, unsigned b, float acc) { return __builtin_amdgcn_fdot2_f32_bf16(__builtin_bit_cast(bf16x2_t, a), __builtin_bit_cast(bf16x2_t, b), acc, false); }
template <int CTRL> __device__ __forceinline__ float dppf(float x) { return __builtin_bit_cast(float, __builtin_amdgcn_mov_dpp(__builtin_bit_cast(int, x), CTRL, 0xf, 0xf, true)); }
__device__ __forceinline__ float gelu1(float v) {
    const float av = __builtin_fabsf(v), t = __builtin_amdgcn_rcpf(av * 0.2316418882f + 1.0f);
    float q = t * 0.5307027145f + (-0.7265760135f); q = q * t + 0.7107068705f; q = q * t + (-0.142248368f); q = q * t + 0.127414796f; q = q * t;
    const float e = __builtin_amdgcn_exp2f((v * v) * (-0.72134752044f));
    const float m = v * (q * e);
    return v < 0.f ? m : v - m;
}
struct GStage { u32x4 u[2][2], v[2][2]; };
__device__ __forceinline__ void phase_gather(Frame& F, const Args& a, float* OUTP) {
    const bf16_t* UT = (const bf16_t*)(a.ws + WS_UT); const bf16_t* VT = (const bf16_t*)(a.ws + WS_VT); const bf16_t* PLE = (const bf16_t*)(a.ws + WS_PP); const bf16_t* H1b = (const bf16_t*)(a.ws + WS_H1B);
    const int* IDX = (const int*)(a.ws + WS_IDX); const float* GATE = (const float*)(a.ws + WS_GATE);
    float* H = a.out; const float* g2 = a.in[19]; const float* b2 = a.in[20];
    const int gw = F.vcu * NWAVES + F.wave, NGW = F.G * NWAVES, lane = F.lane;
    for (int t = gw; t < T; t += NGW) {
        const int id0 = IDX[(size_t)t * 128 + lane], id1 = IDX[(size_t)t * 128 + 64 + lane];
        const float gt0 = GATE[(size_t)t * 128 + lane], gt1 = GATE[(size_t)t * 128 + 64 + lane];
        u32x4 hb[2];
        hb[0] = *((const GAS u32x4*)(H1b + (size_t)t * D) + lane); hb[1] = *((const GAS u32x4*)(H1b + (size_t)t * D + 512) + lane);
        float acc[16];
#pragma unroll
        for (int i = 0; i < 16; ++i) acc[i] = 0.f;
        GStage st[4];
#define G_LOAD(S_, idv, kk) do { _Pragma("unroll") for (int j_ = 0; j_ < 2; ++j_) { const int e_ = __builtin_amdgcn_readlane(idv, (kk) + j_); \
            const GAS u32x4* up_ = (const GAS u32x4*)(UT + (size_t)e_ * D) + lane; const GAS u32x4* vp_ = (const GAS u32x4*)(VT + (size_t)e_ * D) + lane; \
            st[S_].u[j_][0] = up_[0]; st[S_].u[j_][1] = up_[64]; st[S_].v[j_][0] = vp_[0]; st[S_].v[j_][1] = vp_[64]; } } while (0)
#define G_COMP(S_, gtv, kk) do { float d_[2]; _Pragma("unroll") for (int j_ = 0; j_ < 2; ++j_) { float x_ = 0.f; \
            _Pragma("unroll") for (int c_ = 0; c_ < 4; ++c_) { x_ = dot2bf(st[S_].u[j_][0][c_], hb[0][c_], x_); x_ = dot2bf(st[S_].u[j_][1][c_], hb[1][c_], x_); } d_[j_] = x_; } \
            const auto sw_ = __builtin_amdgcn_permlane32_swap(__builtin_bit_cast(unsigned, d_[0]), __builtin_bit_cast(unsigned, d_[1]), false, false); \
            const unsigned sw0_ = sw_[0], sw1_ = sw_[1]; float x_ = __builtin_bit_cast(float, sw0_) + __builtin_bit_cast(float, sw1_); \
            const auto s16_ = __builtin_amdgcn_permlane16_swap(__builtin_bit_cast(unsigned, x_), __builtin_bit_cast(unsigned, x_), false, false); \
            const unsigned s160_ = s16_[0], s161_ = s16_[1]; x_ = __builtin_bit_cast(float, s160_) + __builtin_bit_cast(float, s161_); \
            x_ += dppf<0x128>(x_); x_ += dppf<0x141>(x_); x_ += dppf<0x4E>(x_); x_ += dppf<0xB1>(x_); \
            const float g0_ = __builtin_bit_cast(float, __builtin_amdgcn_readlane(__builtin_bit_cast(int, gtv), (kk))), g1_ = __builtin_bit_cast(float, __builtin_amdgcn_readlane(__builtin_bit_cast(int, gtv), (kk) + 1)); \
            const float act_ = gelu1(x_) * (lane < 32 ? g0_ : g1_); \
            const float a0_ = __builtin_bit_cast(float, __builtin_amdgcn_readlane(__builtin_bit_cast(int, act_), 0)), a1_ = __builtin_bit_cast(float, __builtin_amdgcn_readlane(__builtin_bit_cast(int, act_), 32)); \
            _Pragma("unroll") for (int hf_ = 0; hf_ < 2; ++hf_) _Pragma("unroll") for (int c_ = 0; c_ < 4; ++c_) { \
                const unsigned w0_ = st[S_].v[0][hf_][c_], w1_ = st[S_].v[1][hf_][c_]; \
                acc[hf_ * 8 + 2 * c_] += a0_ * bflo(w0_); acc[hf_ * 8 + 2 * c_ + 1] += a0_ * bfhi(w0_); \
                acc[hf_ * 8 + 2 * c_] += a1_ * bflo(w1_); acc[hf_ * 8 + 2 * c_ + 1] += a1_ * bfhi(w1_); } } while (0)
#pragma unroll
        for (int hh = 0; hh < 2; ++hh) {
            const int idv = hh ? id1 : id0; const float gtv = hh ? gt1 : gt0;
            G_LOAD(0, idv, 0); G_LOAD(1, idv, 2); G_LOAD(2, idv, 4);
            for (int k = 0; k < 64; k += 8) {
                G_LOAD(3, idv, k + 6); G_COMP(0, gtv, k);
                if (k + 8 < 64) G_LOAD(0, idv, k + 8);
                G_COMP(1, gtv, k + 2);
                if (k + 8 < 64) G_LOAD(1, idv, k + 10);
                G_COMP(2, gtv, k + 4);
                if (k + 8 < 64) G_LOAD(2, idv, k + 12);
                G_COMP(3, gtv, k + 6);
            }
        }
#undef G_LOAD
#undef G_COMP
        GAS f32x4* hp = (GAS f32x4*)(H + (size_t)t * D) + lane * 2;
        f32x4 hv[4]; hv[0] = hp[0]; hv[1] = hp[1]; hv[2] = hp[128]; hv[3] = hp[129];
        const u32x4 pa = *((const GAS u32x4*)(PLE + (size_t)t * D) + lane), pb = *((const GAS u32x4*)(PLE + (size_t)t * D + 512) + lane);
        f32x4 p0, p1, p2, p3; pg8::unpack8(pa, p0, p1); pg8::unpack8(pb, p2, p3);
        f32x4 r[4];
        r[0] = hv[0] * ALPHA + (f32x4){acc[0], acc[1], acc[2], acc[3]} + p0; r[1] = hv[1] * ALPHA + (f32x4){acc[4], acc[5], acc[6], acc[7]} + p1;
        r[2] = hv[2] * ALPHA + (f32x4){acc[8], acc[9], acc[10], acc[11]} + p2; r[3] = hv[3] * ALPHA + (f32x4){acc[12], acc[13], acc[14], acc[15]} + p3;
        float s = 0.f;
#pragma unroll
        for (int i = 0; i < 4; ++i) s += (r[i][0] + r[i][1]) + (r[i][2] + r[i][3]);
        const float mean = wave_sum(s) * (1.f / D); float s2 = 0.f;
#pragma unroll
        for (int i = 0; i < 4; ++i) { r[i] = r[i] - mean; s2 += (r[i][0] * r[i][0] + r[i][1] * r[i][1]) + (r[i][2] * r[i][2] + r[i][3] * r[i][3]); }
        const float rstd = 1.f / sqrtf(wave_sum(s2) * (1.f / D) + LN_EPS);
        const GAS f32x4* gp = (const GAS f32x4*)g2 + lane * 2; const GAS f32x4* bp = (const GAS f32x4*)b2 + lane * 2;
        GAS f32x4* op = (GAS f32x4*)(OUTP + (size_t)t * D) + lane * 2;
        op[0] = r[0] * rstd * gp[0] + bp[0]; op[1] = r[1] * rstd * gp[1] + bp[1]; op[128] = r[2] * rstd * gp[128] + bp[128]; op[129] = r[3] * rstd * gp[129] + bp[129];
    }
}

constexpr int NPHASE = 9;
__global__ void __launch_bounds__(NWAVES * 64, 2) mk_fwd(Args args) {
    extern __shared__ __attribute__((aligned(16))) unsigned char lds[];
    Frame F;
    F.lds = (LAS unsigned char*)lds;
    F.MISC = (volatile LAS unsigned*)(F.lds + MISC_OFF);
    F.tid = threadIdx.x; F.lane = F.tid & 63; F.wave = __builtin_amdgcn_readfirstlane(F.tid >> 6);
    F.G = gridDim.x; { const int bx = blockIdx.x; F.vcu = (F.G % 8 == 0) ? (bx % 8) * (F.G / 8) + bx / 8 : bx; }
    unsigned char* ws = args.ws;
    F.ctl = (gu32*)(ws + WS_CTL);
    for (int u = F.tid; u < (LDS_BYTES - LDSCTL_OFF) / 4; u += NWAVES * 64) ((LAS unsigned*)(F.lds + LDSCTL_OFF))[u] = 0u;
    __syncthreads();
    const int lo = args.ph_lo, hi = args.ph_hi;
    const bool one = (hi - lo) > 1;
    XcdBarrier bar; bar.bar = (unsigned*)(F.ctl + CW_BAR); bar.x = 0; bar.st = nullptr;
    if (one) bar = xcd_barrier_post((unsigned*)(F.ctl + CW_BAR), F.MISC + 8);
#ifndef PH_MASK
#define PH_MASK 0xFFFF
#endif
#define IN(k) (((PH_MASK >> (k)) & 1) && lo <= (k) && (k) < hi)
#define SEAM(k) do { if (IN(k) && IN((k) + 1)) xcd_barrier(bar); } while (0)
#ifndef REP_MASK
#define REP_MASK 0
#define REP_N 1
#endif
#define REPS(k) for (int rep_ = (((REP_MASK >> (k)) & 1) ? REP_N : 1); rep_ > 0; --rep_)
    bf16_t* const GA = (bf16_t*)args.out; bf16_t* const GB = (bf16_t*)args.out + (size_t)T * 1024;

    if (IN(0)) REPS(0) { phase_prologue(F, args); SEAM(0); }
    if (IN(1)) REPS(1) {
        pg8::Gemm g{(const bf16_t*)(ws + WS_XN), (const bf16_t*)(ws + WS_WIN), T, NPROJ, 1024, 1024, 1024, 0, 0};
        pg8::StaticOrder S; S.init(T, NPROJ, F.G, (int)blockIdx.x);
        pg8::EpiProj E{(bf16_t*)(ws + WS_QS), (bf16_t*)(ws + WS_KK), (bf16_t*)(ws + WS_VI), (bf16_t*)(ws + WS_SG), (bf16_t*)(ws + WS_VP), GA, GB, (const float*)(ws + WS_OML)};
        pg8::gemm_phase<pg8::EpiProj>(F.lds, g, S, E);
        SEAM(1);
    }
    if (IN(2)) REPS(2) {
        const int nh = F.G > 64 ? 64 : F.G;
        if ((int)blockIdx.x < nh) { for (int u = blockIdx.x; u < 64; u += nh) hgrn_unit(F, args, u); }
        if (F.G <= 64) pool_prep(F, args, (size_t)blockIdx.x * 512 + F.tid, (size_t)F.G * 512);
        else if ((int)blockIdx.x >= 64) pool_prep(F, args, (size_t)(blockIdx.x - 64) * 512 + F.tid, (size_t)(F.G - 64) * 512);
        SEAM(2);
    }
    if (IN(3)) REPS(3) {
        { pg8::Gemm g{(const bf16_t*)(ws + WS_PL), (const bf16_t*)(ws + WS_WPOOL), T, 1024, 256, 512, 256, 1, 256};
          pg8::StaticOrder S; S.init(T, 1024, F.G, (int)blockIdx.x);
          pg8::EpiYB E{(bf16_t*)(ws + WS_YB), GB, args.in[9]};
          pg8::gemm_phase<pg8::EpiYB>(F.lds, g, S, E); }
        { pg8::Gemm g{(const bf16_t*)(ws + WS_OG), (const bf16_t*)(ws + WS_WA), T, 1024, 1024, 1024, 1024, 0, 0};
          pg8::StaticOrder S; S.init(T, 1024, F.G, (int)blockIdx.x);
          pg8::EpiMix E{(bf16_t*)(ws + WS_MIX), GA, (const bf16_t*)(ws + WS_YB)};
          pg8::gemm_phase<pg8::EpiMix>(F.lds, g, S, E); }
        { pg8::Gemm g{(const bf16_t*)(ws + WS_PB), (const bf16_t*)(ws + WS_WPP), T, 1024, 256, 256, 256, 0, 0};
          pg8::StaticOrder S; S.init(T, 1024, F.G, (int)blockIdx.x);
          pg8::EpiPlain E{(bf16_t*)(ws + WS_PP), 1024};
          pg8::gemm_phase<pg8::EpiPlain>(F.lds, g, S, E); }
        SEAM(3);
    }
    if (IN(4)) REPS(4) {
        pg8::Gemm g{(const bf16_t*)(ws + WS_MIX), (const bf16_t*)(ws + WS_WOUT), T, 1024, 1024, 1024, 1024, 0, 0};
        pg8::StaticOrder S; S.init(T, 1024, F.G, (int)blockIdx.x);
        pg8::EpiR1 E{args.out, args.in[0], (const float*)(ws + WS_ST0), args.in[2], args.in[3]};
        pg8::gemm_phase<pg8::EpiR1>(F.lds, g, S, E);
        SEAM(4);
    }
    if (IN(5)) { phase_ln1(F, args); SEAM(5); }
    if (IN(6)) {
        pg8::Gemm g{(const bf16_t*)(ws + WS_H1B), (const bf16_t*)(ws + WS_WPGQ), T, 3072, 1024, 1024, 1024, 0, 0};
        pg8::StaticOrder S; S.init(T, 3072, F.G, (int)blockIdx.x);
        pg8::EpiPgq E{(bf16_t*)(ws + WS_PP), (bf16_t*)(ws + WS_QRY)};
        pg8::gemm_phase<pg8::EpiPgq>(F.lds, g, S, E);
        SEAM(6);
    }
    if (IN(7)) REPS(7) { phase_topk(F, args); SEAM(7); }
    if (IN(8)) REPS(8) { phase_gather(F, args, rep_ > 1 ? (float*)(ws + WS_QS) : args.out); if (rep_ > 1) xcd_barrier(bar); }
#undef IN
#undef SEAM
}

extern "C" void kernel_launch(void* const* d_in, const int* in_sizes, int n_in, void* d_out, int out_size, void* d_ws, size_t ws_size, hipStream_t stream) {
    static int grid = 0;
    if (grid == 0) {
        if (n_in != 21 || out_size != T * D || ws_size < WS_END) { fprintf(stderr, "kernel_launch: unexpected shapes (n_in %d, out %d, ws %zu)\n", n_in, out_size, ws_size); grid = -1; return; }
        int dev = 0, cus = 0, per_cu = 0;
        if (hipGetDevice(&dev) != hipSuccess || hipDeviceGetAttribute(&cus, hipDeviceAttributeMultiprocessorCount, dev) != hipSuccess) { grid = -1; return; }
        if (hipFuncSetAttribute((const void*)mk_fwd, hipFuncAttributeMaxDynamicSharedMemorySize, LDS_BYTES) != hipSuccess) { fprintf(stderr, "kernel_launch: hipFuncSetAttribute failed\n"); grid = -1; return; }
        if (hipOccupancyMaxActiveBlocksPerMultiprocessor(&per_cu, (const void*)mk_fwd, NWAVES * 64, LDS_BYTES) != hipSuccess || per_cu < 1)
            fprintf(stderr, "kernel_launch: occupancy query reports %d\n", per_cu);
        (void)hipGetLastError();
        grid = cus;
    }
    if (grid < 0) return;
    (void)hipMemsetAsync((char*)d_ws + WS_CTL, 0, CTL_ZERO_BYTES, stream);
    Args a{};
    for (int i = 0; i < 21; ++i) a.in[i] = (const float*)d_in[i];
    a.out = (float*)d_out; a.ws = (unsigned char*)d_ws;
#if MK_ONE_LAUNCH
    a.ph_lo = 0; a.ph_hi = NPHASE;
    hipLaunchKernelGGL(mk_fwd, dim3(grid), dim3(NWAVES * 64), LDS_BYTES, stream, a);
#else
    for (int p = 0; p < NPHASE; ++p) { a.ph_lo = p; a.ph_hi = p + 1; hipLaunchKernelGGL(mk_fwd, dim3(grid), dim3(NWAVES * 64), LDS_BYTES, stream, a); }
#endif
}
```

```cpp
#include <hip/hip_runtime.h>
#include <cstdio>
#include <cstdint>

#ifndef MK_ONE_LAUNCH
#define MK_ONE_LAUNCH 1
#endif

#define LAS __attribute__((address_space(3)))
#define GAS __attribute__((address_space(1)))
typedef unsigned short bf16_t;
typedef short bf16x8 __attribute__((ext_vector_type(8)));
typedef float f32x4 __attribute__((ext_vector_type(4)));
typedef float f32x2 __attribute__((ext_vector_type(2)));
typedef unsigned u32x4 __attribute__((ext_vector_type(4)));
typedef unsigned u32x2 __attribute__((ext_vector_type(2)));

constexpr int BATCH = 8, SEQ = 4096, T = BATCH * SEQ, D = 1024;
constexpr int NPROJ = 6656;
constexpr int NEXP = 16384;
constexpr float ALPHA = 1.189207115002721f;
constexpr float LN_EPS = 1e-5f, RMS_EPS = 1e-6f;
constexpr int NWAVES = 8;

constexpr size_t MiB = 1u << 20;
constexpr size_t WS_CTL = 0, CTL_ZERO_BYTES = 1 * MiB;
constexpr size_t WS_OML = 1 * MiB;
constexpr size_t WS_ST0 = 1 * MiB + 65536;
constexpr size_t WS_WIN = 2 * MiB;
constexpr size_t WS_WA = 15 * MiB;
constexpr size_t WS_WOUT = 17 * MiB;
constexpr size_t WS_WPGQ = 19 * MiB;
constexpr size_t WS_WPP = 25 * MiB;
constexpr size_t WS_WPOOL = 25 * MiB + 512 * 1024;
constexpr size_t WS_SK = 26 * MiB;
constexpr size_t WS_PB = 27 * MiB;
constexpr size_t WS_UT = 43 * MiB;
constexpr size_t WS_VT = 59 * MiB;
constexpr size_t WS_US = 75 * MiB, WS_VS = 75 * MiB + 65536;
constexpr size_t WS_XN = 108 * MiB;
constexpr size_t WS_QS = 172 * MiB, WS_KK = 236 * MiB, WS_VI = 300 * MiB, WS_SG = 364 * MiB;
constexpr size_t WS_VP = 428 * MiB, WS_PL = 460 * MiB;
constexpr size_t WS_END = 492 * MiB;
constexpr size_t WS_OG = WS_XN, WS_YB = WS_QS, WS_MIX = WS_KK, WS_PP = WS_VI, WS_H1B = WS_SG, WS_QRY = WS_QS;
constexpr size_t WS_IDX = WS_VP, WS_GATE = WS_VP + 16 * MiB;
constexpr size_t WS_USG = WS_PL;

constexpr int RING_BYTES = 131072;
constexpr int LDSCTL_OFF = RING_BYTES, MISC_OFF = LDSCTL_OFF + 320;
constexpr int LDS_BYTES = 147456;

__device__ __forceinline__ unsigned f2bf(float f) { unsigned u = __builtin_bit_cast(unsigned, f); return (u + 0x7fffu + ((u >> 16) & 1u)) >> 16; }
__device__ __forceinline__ unsigned pk2(float lo, float hi) { return f2bf(lo) | (f2bf(hi) << 16); }
__device__ __forceinline__ float bflo(unsigned w) { return __builtin_bit_cast(float, w << 16); }
__device__ __forceinline__ float bfhi(unsigned w) { return __builtin_bit_cast(float, w & 0xffff0000u); }
typedef __bf16 bf16x2_t __attribute__((ext_vector_type(2)));
__device__ __forceinline__ unsigned cvt_pk_bf16(float lo, float hi) { bf16x2_t v; v[0] = (__bf16)lo; v[1] = (__bf16)hi; return __builtin_bit_cast(unsigned, v); }
__device__ __forceinline__ float sigmoidf_(float x) { return __builtin_amdgcn_rcpf(1.0f + __expf(-x)); }
__device__ __forceinline__ float wave_sum(float v) {
#pragma unroll
    for (int o = 1; o < 64; o <<= 1) v += __shfl_xor(v, o);
    return v;
}
#define LDS_WAIT() asm volatile("s_waitcnt lgkmcnt(0)" ::: "memory")
#define VM_WAIT() asm volatile("s_waitcnt vmcnt(0)" ::: "memory")

namespace pg8 {
constexpr int BM = 256, BK = 64, HALF = 128, HTB = HALF * BK * 2, STAGE_BYTES = 8 * HTB, NXCD = 8, WGM = 8;
__host__ __device__ __forceinline__ int lds_byte(int r, int c) { const int st = (r >> 4) * 2 + (c >> 5), rr = r & 15, cc = c & 31, ob = rr * 64 + cc * 2; return st * 1024 + (ob ^ (((ob >> 9) & 1) << 5)); }
__host__ __device__ __forceinline__ void stage_rc(int b, int& R, int& C) { const int st = b / 1024, sb = b % 1024, swz = sb ^ (((sb >> 9) & 1) << 5); R = (st >> 1) * 16 + swz / 64; C = (st & 1) * 32 + (swz % 64) / 2; }
__host__ __device__ __forceinline__ int perm32(int rho) { const int n = rho >> 4, i = rho & 15; return 8 * (i >> 2) + 4 * n + (i & 3); }

struct Unit { int pm, pn; };
struct Gemm { const bf16_t* A; const bf16_t* Bt; int M, N, K, lda, ldb, acol_shift, acol_mul; };

struct StaticOrder {
    int nM, nN, nwg, G, c;
    __host__ __device__ void init(int M, int N, int G_, int c_) { nM = M / BM; nN = N / BM; nwg = nM * nN; G = G_; c = c_; }
    __host__ __device__ bool next(int i, Unit& u) const {
        const long L = (long)i * G + c; if (L >= nwg) return false;
        int wgid = (int)L; { const int q = nwg / NXCD, r = nwg % NXCD, xcd = wgid % NXCD, off = wgid / NXCD; wgid = (xcd < r ? xcd * (q + 1) : r * (q + 1) + (xcd - r) * q) + off; }
        const int nig = WGM * nN, gid = wgid / nig, fm = gid * WGM, gsz = (nM - fm) < WGM ? (nM - fm) : WGM;
        u.pm = fm + ((wgid % nig) % gsz); u.pn = (wgid % nig) / gsz; return true;
    }
};


template <class Epi>
__device__ __forceinline__ void gemm_phase(LAS unsigned char* lds, const Gemm g, const StaticOrder& S, const Epi& E) {
    const int tid = threadIdx.x, wid = __builtin_amdgcn_readfirstlane(tid >> 6), lane = tid & 63, wr = wid >> 2, wc = wid & 3, fr = lane & 15, fq = lane >> 4;
    int K_ = g.K; asm volatile("" : "+s"(K_));
    const int K = K_, nt = K / BK;
    unsigned voffA[2], voffB[2];
#pragma unroll
    for (int i = 0; i < 2; ++i) { int R, C; stage_rc(tid * 16 + i * 8192, R, C); const int Rb = Epi::PERM ? ((R & ~31) + perm32(R & 31)) : R;
        voffA[i] = (unsigned)(R * g.lda + C) * 2u; voffB[i] = (unsigned)(Rb * g.ldb + C) * 2u; }
    const size_t kstep = (size_t)(BK * 2);
    const size_t hstepA = (size_t)HALF * g.lda * 2, hstepB = (size_t)HALF * g.ldb * 2;
    const size_t tstepA = 2 * hstepA, tstepB = 2 * hstepB;
    const unsigned ldsw = (unsigned)wid * 1024u;
    const int aoff = lds_byte(wr * 64 + fr, fq * 8), boff = lds_byte(wc * 32 + fr, fq * 8);
#define PG8_SA(b, h) (((b) * 2 + (h)) * HTB)
#define PG8_SB(b, h) ((4 + (b) * 2 + (h)) * HTB)
#define PG8_STAGE(bufoff, gbase, voff) do { _Pragma("unroll") for (int _i = 0; _i < 2; ++_i) \
        __builtin_amdgcn_global_load_lds((const unsigned*)((const char*)(gbase) + (voff)[_i]), (LAS unsigned*)(lds + (bufoff) + ldsw + _i * 8192), 16, 0, 0); } while (0)
#define PG8_LDA(dst, b, h) do { _Pragma("unroll") for (int m = 0; m < 4; ++m) _Pragma("unroll") for (int k = 0; k < 2; ++k) dst[m][k] = *(const LAS bf16x8*)(lds + PG8_SA(b, h) + aoff + m * 2048 + k * 1024); } while (0)
#define PG8_LDB(dst, b, h) do { _Pragma("unroll") for (int n = 0; n < 2; ++n) _Pragma("unroll") for (int k = 0; k < 2; ++k) dst[n][k] = *(const LAS bf16x8*)(lds + PG8_SB(b, h) + boff + n * 2048 + k * 1024); } while (0)
#define PG8_MMA(ai, bj, At, Bt) do { __builtin_amdgcn_s_setprio(1); _Pragma("unroll") for (int m = 0; m < 4; ++m) _Pragma("unroll") for (int n = 0; n < 2; ++n) _Pragma("unroll") for (int k = 0; k < 2; ++k) \
        acc[ai][bj][m][n] = __builtin_amdgcn_mfma_f32_16x16x32_bf16(Bt[n][k], At[m][k], acc[ai][bj][m][n], 0, 0, 0); __builtin_amdgcn_s_setprio(0); } while (0)
#define PG8_WAIT_V(n) asm volatile("s_waitcnt vmcnt(" #n ")" ::: "memory")
#define PG8_WAIT_L(n) asm volatile("s_waitcnt lgkmcnt(" #n ")" ::: "memory")
#define PG8_BAR __builtin_amdgcn_s_barrier()
#define PG8_SCHED __builtin_amdgcn_sched_barrier(0)
    Unit cur, nxt; int ui = 0;
    if (!S.next(0, cur)) return;
    f32x4 acc[2][2][4][2];
#pragma unroll
    for (int a = 0; a < 2; ++a)
#pragma unroll
        for (int b = 0; b < 2; ++b)
#pragma unroll
            for (int m = 0; m < 4; ++m)
#pragma unroll
                for (int n = 0; n < 2; ++n) acc[a][b][m][n] = (f32x4){0.f, 0.f, 0.f, 0.f};
    bf16x8 At[4][2], B0[2][2], B1[2][2];
    const char* cA = (const char*)g.A + (size_t)cur.pm * tstepA + (size_t)((cur.pn >> g.acol_shift) * g.acol_mul) * 2; const char* cB = (const char*)g.Bt + (size_t)cur.pn * tstepB;
    PG8_STAGE(PG8_SB(0, 0), cB, voffB); PG8_STAGE(PG8_SB(0, 1), cB + hstepB, voffB); PG8_STAGE(PG8_SA(0, 0), cA, voffA); PG8_STAGE(PG8_SA(0, 1), cA + hstepA, voffA);
    if (wr == 1) PG8_BAR;
    PG8_WAIT_V(2); PG8_BAR;
    PG8_STAGE(PG8_SB(1, 0), cB + kstep, voffB); PG8_STAGE(PG8_SA(1, 0), cA + kstep, voffA); PG8_STAGE(PG8_SB(1, 1), cB + hstepB + kstep, voffB);
    PG8_WAIT_V(6); PG8_BAR;
    for (;;) {
        const bool has_next = S.next(ui + 1, nxt);
        const char* nA = has_next ? (const char*)g.A + (size_t)nxt.pm * tstepA + (size_t)((nxt.pn >> g.acol_shift) * g.acol_mul) * 2 : cA;
        const char* nB = has_next ? (const char*)g.Bt + (size_t)nxt.pn * tstepB : cB;
        for (int t = 0; t < nt; t += 2) {
            const bool last = (t == nt - 2);
            const char* a1 = cA + (size_t)(t + 1) * kstep;
            const char* a2 = last ? nA : cA + (size_t)(t + 2) * kstep; const char* b2 = last ? nB : cB + (size_t)(t + 2) * kstep;
            const char* a3 = a2 + kstep; const char* b3 = b2 + kstep;
            PG8_LDB(B0, 0, 0); PG8_LDB(B1, 0, 1); PG8_SCHED; PG8_LDA(At, 0, 0); PG8_STAGE(PG8_SA(1, 1), a1 + hstepA, voffA);
            PG8_WAIT_V(8); PG8_WAIT_L(0); PG8_BAR; PG8_MMA(0, 0, At, B0); PG8_MMA(0, 1, At, B1); PG8_BAR; PG8_SCHED;
            PG8_LDA(At, 0, 1); PG8_STAGE(PG8_SB(0, 0), b2, voffB); PG8_STAGE(PG8_SB(0, 1), b2 + hstepB, voffB); PG8_STAGE(PG8_SA(0, 0), a2, voffA);
            PG8_WAIT_V(8); PG8_WAIT_L(0); PG8_BAR; PG8_MMA(1, 0, At, B0); PG8_MMA(1, 1, At, B1); PG8_BAR; PG8_SCHED;
            PG8_LDB(B0, 1, 0); PG8_LDB(B1, 1, 1); PG8_SCHED; PG8_LDA(At, 1, 0); PG8_STAGE(PG8_SA(0, 1), a2 + hstepA, voffA);
            PG8_WAIT_V(8); PG8_WAIT_L(0); PG8_BAR; PG8_MMA(0, 0, At, B0); PG8_MMA(0, 1, At, B1); PG8_BAR; PG8_SCHED;
            PG8_LDA(At, 1, 1); PG8_STAGE(PG8_SB(1, 0), b3, voffB); PG8_STAGE(PG8_SB(1, 1), b3 + hstepB, voffB); PG8_STAGE(PG8_SA(1, 0), a3, voffA);
            PG8_WAIT_V(8); PG8_WAIT_L(0); PG8_BAR; PG8_MMA(1, 0, At, B0); PG8_MMA(1, 1, At, B1); PG8_BAR; PG8_SCHED;
        }
        if (wr == 0) PG8_BAR;
        E(acc, cur, wr, wc, fr, fq);
        if (!has_next) break;
#pragma unroll
        for (int a = 0; a < 2; ++a)
#pragma unroll
            for (int b = 0; b < 2; ++b)
#pragma unroll
                for (int m = 0; m < 4; ++m)
#pragma unroll
                    for (int n = 0; n < 2; ++n) acc[a][b][m][n] = (f32x4){0.f, 0.f, 0.f, 0.f};
        cur = nxt; cA = nA; cB = nB; ++ui;
        if (wr == 1) PG8_BAR;
    }
    PG8_WAIT_V(0);
    PG8_BAR;
#undef PG8_SA
#undef PG8_SB
#undef PG8_STAGE
#undef PG8_LDA
#undef PG8_LDB
#undef PG8_MMA
#undef PG8_WAIT_V
#undef PG8_WAIT_L
#undef PG8_BAR
#undef PG8_SCHED
}

#define EPI_FENCE() asm volatile("" ::: "memory")
__device__ __forceinline__ u32x4 pack8(const f32x4& v0, const f32x4& v1) { u32x4 w; w.x = cvt_pk_bf16(v0[0], v0[1]); w.y = cvt_pk_bf16(v0[2], v0[3]); w.z = cvt_pk_bf16(v1[0], v1[1]); w.w = cvt_pk_bf16(v1[2], v1[3]); return w; }
__device__ __forceinline__ void unpack8(const u32x4& w, f32x4& v0, f32x4& v1) { v0 = (f32x4){bflo(w.x), bfhi(w.x), bflo(w.y), bfhi(w.y)}; v1 = (f32x4){bflo(w.z), bfhi(w.z), bflo(w.w), bfhi(w.w)}; }

struct EpiProj {
    static constexpr bool PERM = true;
    bf16_t *Qs, *Kk, *Vi, *SG, *VP, *GA, *GB; const float* oml;
    __device__ __forceinline__ void operator()(const f32x4 (&acc)[2][2][4][2], const Unit& u, int wr, int wc, int fr, int fq) const {
        const int pn = u.pn; bf16_t* base; int ldc = 1024, ct, mode;
        if (pn < 4) { base = Qs; ct = pn; mode = 0; } else if (pn < 8) { base = Kk; ct = pn - 4; mode = 1; } else if (pn < 12) { base = Vi; ct = pn - 8; mode = 2; }
        else if (pn < 16) { base = SG; ct = pn - 12; mode = 3; } else if (pn < 18) { base = VP; ct = pn - 16; mode = 2; ldc = 512; }
        else if (pn < 22) { base = GA; ct = pn - 18; mode = 4; } else { base = GB; ct = pn - 22; mode = 4; }
        const int row0 = u.pm * BM + wr * 64 + fr, col0 = ct * 256 + wc * 32 + 8 * fq;
        f32x4 om[2][2];
#pragma unroll
        for (int bj = 0; bj < 2; ++bj)
#pragma unroll
            for (int n = 0; n < 2; ++n) om[bj][n] = (mode == 1) ? *(const f32x4*)(oml + col0 + bj * HALF + 4 * n) : (f32x4){1.f, 1.f, 1.f, 1.f};
#pragma unroll
        for (int ai = 0; ai < 2; ++ai)
#pragma unroll
            for (int m = 0; m < 4; ++m) { bf16_t* rowp = base + (size_t)(row0 + ai * HALF + m * 16) * ldc + col0;
#pragma unroll
                for (int bj = 0; bj < 2; ++bj) { f32x4 v[2] = {acc[ai][bj][m][0], acc[ai][bj][m][1]};
#pragma unroll
                    for (int n = 0; n < 2; ++n)
#pragma unroll
                        for (int e = 0; e < 4; ++e) { const float x = v[n][e]; float y;
                            if (mode == 0) y = x * sigmoidf_(x) * 0.08838834764831845f;
                            else if (mode == 1) y = om[bj][n][e] * sigmoidf_(-x);
                            else if (mode == 2) y = x;
                            else if (mode == 3) y = x * sigmoidf_(x);
                            else y = sigmoidf_(x);
                            v[n][e] = y; }
                    *(u32x4*)(rowp + bj * HALF) = pack8(v[0], v[1]); } }
    }
};
struct EpiPlain {
    static constexpr bool PERM = true;
    bf16_t* O; int ldc;
    __device__ __forceinline__ void operator()(const f32x4 (&acc)[2][2][4][2], const Unit& u, int wr, int wc, int fr, int fq) const {
        const int row0 = u.pm * BM + wr * 64 + fr, col0 = u.pn * BM + wc * 32 + 8 * fq;
#pragma unroll
        for (int ai = 0; ai < 2; ++ai)
#pragma unroll
            for (int m = 0; m < 4; ++m) { bf16_t* rowp = O + (size_t)(row0 + ai * HALF + m * 16) * ldc + col0;
#pragma unroll
                for (int bj = 0; bj < 2; ++bj) *(u32x4*)(rowp + bj * HALF) = pack8(acc[ai][bj][m][0], acc[ai][bj][m][1]); }
    }
};
struct EpiYB {
    static constexpr bool PERM = true;
    bf16_t* YB; const bf16_t* GB; const float* scale;
    __device__ __forceinline__ void operator()(const f32x4 (&acc)[2][2][4][2], const Unit& u, int wr, int wc, int fr, int fq) const {
        const int row0 = u.pm * BM + wr * 64 + fr, col0 = u.pn * BM + wc * 32 + 8 * fq;
        f32x4 sc[2][2];
#pragma unroll
        for (int bj = 0; bj < 2; ++bj)
#pragma unroll
            for (int n = 0; n < 2; ++n) sc[bj][n] = *(const f32x4*)(scale + col0 + bj * HALF + 4 * n);
#pragma unroll
        for (int ai = 0; ai < 2; ++ai)
#pragma unroll
            for (int m = 0; m < 4; ++m) { const size_t off = (size_t)(row0 + ai * HALF + m * 16) * 1024 + col0;
#pragma unroll
                for (int bj = 0; bj < 2; ++bj) { const u32x4 gw = *(const u32x4*)(GB + off + bj * HALF); f32x4 g0, g1; unpack8(gw, g0, g1);
                    const f32x4 v0 = acc[ai][bj][m][0] * sc[bj][0] * g0, v1 = acc[ai][bj][m][1] * sc[bj][1] * g1;
                    *(u32x4*)(YB + off + bj * HALF) = pack8(v0, v1); }
                EPI_FENCE(); }
    }
};
struct EpiMix {
    static constexpr bool PERM = true;
    bf16_t* MIX; const bf16_t* GA; const bf16_t* YB;
    __device__ __forceinline__ void operator()(const f32x4 (&acc)[2][2][4][2], const Unit& u, int wr, int wc, int fr, int fq) const {
        const int row0 = u.pm * BM + wr * 64 + fr, col0 = u.pn * BM + wc * 32 + 8 * fq;
#pragma unroll
        for (int ai = 0; ai < 2; ++ai)
#pragma unroll
            for (int m = 0; m < 4; ++m) { const size_t off = (size_t)(row0 + ai * HALF + m * 16) * 1024 + col0;
#pragma unroll
                for (int bj = 0; bj < 2; ++bj) { const u32x4 gw = *(const u32x4*)(GA + off + bj * HALF), yw = *(const u32x4*)(YB + off + bj * HALF);
                    f32x4 g0, g1, y0, y1; unpack8(gw, g0, g1); unpack8(yw, y0, y1);
                    const f32x4 v0 = acc[ai][bj][m][0] * g0 + y0, v1 = acc[ai][bj][m][1] * g1 + y1;
                    *(u32x4*)(MIX + off + bj * HALF) = pack8(v0, v1); }
                EPI_FENCE(); }
    }
};
struct EpiR1 {
    static constexpr bool PERM = false;
    float* R1; const float* x; const float* st0; const float* g0; const float* b0;
    __device__ __forceinline__ void operator()(const f32x4 (&acc)[2][2][4][2], const Unit& u, int wr, int wc, int fr, int fq) const {
        const int row0 = u.pm * BM + wr * 64 + fr, col0 = u.pn * BM + wc * 32 + 4 * fq;
        f32x4 gg[2][2], bb[2][2];
#pragma unroll
        for (int bj = 0; bj < 2; ++bj)
#pragma unroll
            for (int n = 0; n < 2; ++n) { gg[bj][n] = *(const f32x4*)(g0 + col0 + bj * HALF + 16 * n); bb[bj][n] = *(const f32x4*)(b0 + col0 + bj * HALF + 16 * n); }
#pragma unroll
        for (int ai = 0; ai < 2; ++ai)
#pragma unroll
            for (int m = 0; m < 4; ++m) { const int r = row0 + ai * HALF + m * 16; const size_t off = (size_t)r * 1024 + col0; const f32x2 ms = *(const f32x2*)(st0 + 2 * (size_t)r);
#pragma unroll
                for (int bj = 0; bj < 2; ++bj)
#pragma unroll
                    for (int n = 0; n < 2; ++n) { const f32x4 xv = *(const f32x4*)(x + off + bj * HALF + 16 * n);
                        const f32x4 h = (xv - ms.x) * ms.y * gg[bj][n] + bb[bj][n];
                        *(f32x4*)(R1 + off + bj * HALF + 16 * n) = h * ALPHA + acc[ai][bj][m][n]; }
                EPI_FENCE(); }
    }
};
struct EpiPgq {
    static constexpr bool PERM = true;
    bf16_t* PP; bf16_t* QRY;
    __device__ __forceinline__ void operator()(const f32x4 (&acc)[2][2][4][2], const Unit& u, int wr, int wc, int fr, int fq) const {
        const int row0 = u.pm * BM + wr * 64 + fr;
        if (u.pn < 4) {
            const int col0 = u.pn * BM + wc * 32 + 8 * fq;
#pragma unroll
            for (int ai = 0; ai < 2; ++ai)
#pragma unroll
                for (int m = 0; m < 4; ++m) { const size_t off = (size_t)(row0 + ai * HALF + m * 16) * 1024 + col0;
#pragma unroll
                    for (int bj = 0; bj < 2; ++bj) { const u32x4 pw = *(const u32x4*)(PP + off + bj * HALF); f32x4 p0, p1; unpack8(pw, p0, p1); f32x4 v0, v1;
#pragma unroll
                        for (int e = 0; e < 4; ++e) { v0[e] = sigmoidf_(acc[ai][bj][m][0][e]) * p0[e]; v1[e] = sigmoidf_(acc[ai][bj][m][1][e]) * p1[e]; }
                        *(u32x4*)(PP + off + bj * HALF) = pack8(v0, v1); }
                    EPI_FENCE(); }
        } else {
            const int col0 = (u.pn - 4) * BM + wc * 32 + 8 * fq;
#pragma unroll
            for (int ai = 0; ai < 2; ++ai)
#pragma unroll
                for (int m = 0; m < 4; ++m) { bf16_t* rowp = QRY + (size_t)(row0 + ai * HALF + m * 16) * 2048 + col0;
#pragma unroll
                    for (int bj = 0; bj < 2; ++bj) *(u32x4*)(rowp + bj * HALF) = pack8(acc[ai][bj][m][0], acc[ai][bj][m][1]); }
        }
    }
};
}

typedef GAS unsigned gu32;
#define RLX_AGENT __ATOMIC_RELAXED, __HIP_MEMORY_SCOPE_AGENT
#define XB_TMO      128
#define XB_XCNT(j)  (256  + 64 * (j))
#define XB_XSUB(j)  (1280 + 64 * (j))
#define XB_XGEN(j)  (2304 + 64 * (j))
#define XB_TOP      3328
#define XB_TOPGEN   3392
#define XCD_BAR_WORDS 3456
#define XB_SPIN_CAP (1u << 22)
constexpr int CW_BAR = 4096;
__device__ __forceinline__ unsigned xb_ld(unsigned* p)              { return __hip_atomic_load(p, __ATOMIC_RELAXED, __HIP_MEMORY_SCOPE_AGENT); }
__device__ __forceinline__ unsigned xb_add(unsigned* p, unsigned v) { return __hip_atomic_fetch_add(p, v, __ATOMIC_RELAXED, __HIP_MEMORY_SCOPE_AGENT); }
__device__ __forceinline__ unsigned xb_xcc_id() { return (unsigned)__builtin_amdgcn_s_getreg((3 << 11) | 20) & 0xFu; }
#define XB_SPIN(cond, bar) do { unsigned _sp = 0; while (cond) { __builtin_amdgcn_s_sleep(1); \
    if ((++_sp & 255u) == 0u) { if (xb_ld(&(bar)[XB_TMO])) break; if (_sp > XB_SPIN_CAP) { atomicAdd(&(bar)[XB_TMO], 1u); break; } } } } while (0)
struct XcdBarrier { unsigned* bar; unsigned x; volatile LAS unsigned* st; };
__device__ __forceinline__ XcdBarrier xcd_barrier_post(unsigned* bar, volatile LAS unsigned* st) {
    XcdBarrier b; b.bar = bar; b.x = xb_xcc_id(); b.st = st;
    if (threadIdx.x == 0) (void)xb_add(&bar[XB_XCNT(b.x)], 1u);
    return b;
}
__device__ __forceinline__ void xcd_barrier_complete(unsigned* bar, unsigned x, unsigned& nloc, unsigned& nx) {
    const unsigned G = gridDim.x * gridDim.y * gridDim.z;
    unsigned sum, cnt, mine, sp = 0u;
    for (;;) {
        sum = 0u; cnt = 0u; mine = 0u;
#pragma unroll
        for (unsigned j = 0; j < 16; ++j) { const unsigned c = xb_ld(&bar[XB_XCNT(j)]); sum += c; cnt += (c > 0u) ? 1u : 0u; mine = (j == x) ? c : mine; }
        if (sum == G) break;
        __builtin_amdgcn_s_sleep(1);
        if ((++sp & 255u) == 0u) { if (xb_ld(&bar[XB_TMO])) break; if (sp > XB_SPIN_CAP) { atomicAdd(&bar[XB_TMO], 1u); break; } }
    }
    nloc = mine > 0u ? mine : 1u; nx = cnt > 0u ? cnt : 1u;
}
__device__ __forceinline__ void xcd_barrier(const XcdBarrier& b) {
    asm volatile("s_waitcnt vmcnt(0)" ::: "memory");
    __syncthreads();
    if (threadIdx.x == 0) {
        unsigned* bar = b.bar;
        __builtin_amdgcn_s_waitcnt(0);
        unsigned nloc = b.st[0], nx = b.st[1];
        if (nloc == 0u) { xcd_barrier_complete(bar, b.x, nloc, nx); b.st[0] = nloc; b.st[1] = nx; }
        const unsigned old = xb_add(&bar[XB_XSUB(b.x)], 1u);
        const unsigned gen = old / nloc;
        if (old + 1u == (gen + 1u) * nloc) {
            __builtin_amdgcn_fence(__ATOMIC_RELEASE, "agent");
            asm volatile("s_waitcnt vmcnt(0)" ::: "memory");
            const unsigned og = xb_add(&bar[XB_TOP], 1u);
            const unsigned tg = og / nx;
            if (og + 1u == (tg + 1u) * nx) xb_add(&bar[XB_TOPGEN], 1u);
            else XB_SPIN(xb_ld(&bar[XB_TOPGEN]) == tg, bar);
            __builtin_amdgcn_fence(__ATOMIC_ACQUIRE, "agent");
            xb_add(&bar[XB_XGEN(b.x)], 1u);
            asm volatile("s_waitcnt vmcnt(0)" ::: "memory");
        } else {
            XB_SPIN(xb_ld(&bar[XB_XGEN(b.x)]) == gen, bar);
            __builtin_amdgcn_fence(__ATOMIC_ACQUIRE, "agent");
            asm volatile("s_waitcnt vmcnt(0)" ::: "memory");
        }
    }
    __syncthreads();
}

struct Args { const float* in[21]; float* out; unsigned char* ws; int ph_lo, ph_hi; };
struct Frame {
    LAS unsigned char* lds; volatile LAS unsigned* MISC; gu32* ctl;
    int tid, lane, wave, vcu, G;
};

__device__ __forceinline__ void p0_transpose_item(const float* W, int K, int N, bf16_t* WT, int row_off, LAS float* scr, int item, int lane) {
    const int nblk = N / 32, kb = item / nblk, nb = item % nblk, k0 = 64 * kb, n0 = 32 * nb;
#pragma unroll 8
    for (int i = 0; i < 32; ++i) { const int kk = 2 * i + (lane >> 5); scr[kk * 33 + (lane & 31)] = W[(size_t)(k0 + kk) * N + n0 + (lane & 31)]; }
    LDS_WAIT(); asm volatile("" ::: "memory");
    const int c = lane & 7;
#pragma unroll
    for (int j = 0; j < 4; ++j) { const int n = (lane >> 3) + 8 * j; const LAS float* s = scr + (8 * c) * 33 + n;
        u32x4 o; o.x = pk2(s[0 * 33], s[1 * 33]); o.y = pk2(s[2 * 33], s[3 * 33]); o.z = pk2(s[4 * 33], s[5 * 33]); o.w = pk2(s[6 * 33], s[7 * 33]);
        *(GAS u32x4*)(WT + (size_t)(row_off + n0 + n) * K + k0 + 8 * c) = o; }
    LDS_WAIT(); asm volatile("" ::: "memory");
}
__device__ __forceinline__ void cvt_stream(const float* src, bf16_t* dst, size_t n4, size_t gtid, size_t nthr) {
    for (size_t i = gtid; i < n4; i += nthr) { const f32x4 v = ((const GAS f32x4*)src)[i]; u32x2 o; o.x = pk2(v[0], v[1]); o.y = pk2(v[2], v[3]); ((GAS u32x2*)dst)[i] = o; }
}

__device__ __forceinline__ void phase_prologue(Frame& F, const Args& a) {
    unsigned char* ws = a.ws;
    LAS float* scr = (LAS float*)(F.lds + F.wave * 16384);
    const int gw = F.vcu * NWAVES + F.wave, NGW = F.G * NWAVES;
    const size_t gtid = (size_t)gw * 64 + F.lane, nthr = (size_t)NGW * 64;
    constexpr int I_IN = 16 * (NPROJ / 32), I_SQ = 16 * 32, I_Q = 16 * 64, I_PP = 4 * 32;
    constexpr int NITEMS = I_IN + 3 * I_SQ + I_Q + I_PP;
    for (int it = gw; it < NITEMS; it += NGW) {
        int r = it;
        if (r < I_IN) { p0_transpose_item(a.in[4], 1024, NPROJ, (bf16_t*)(ws + WS_WIN), 0, scr, r, F.lane); continue; } r -= I_IN;
        if (r < I_SQ) { p0_transpose_item(a.in[7], 1024, 1024, (bf16_t*)(ws + WS_WA), 0, scr, r, F.lane); continue; } r -= I_SQ;
        if (r < I_SQ) { p0_transpose_item(a.in[10], 1024, 1024, (bf16_t*)(ws + WS_WOUT), 0, scr, r, F.lane); continue; } r -= I_SQ;
        if (r < I_SQ) { p0_transpose_item(a.in[17], 1024, 1024, (bf16_t*)(ws + WS_WPGQ), 0, scr, r, F.lane); continue; } r -= I_SQ;
        if (r < I_Q) { p0_transpose_item(a.in[13], 1024, 2048, (bf16_t*)(ws + WS_WPGQ), 1024, scr, r, F.lane); continue; } r -= I_Q;
        p0_transpose_item(a.in[18], 256, 1024, (bf16_t*)(ws + WS_WPP), 0, scr, r, F.lane);
    }
    { bf16_t* wp = (bf16_t*)(ws + WS_WPOOL); const float* pw = a.in[8];
      for (size_t i = gtid; i < 1024 * 256; i += nthr) { const int o = (int)(i >> 8), j = (int)(i & 255), g = o >> 8, gsrc = 2 * (g >> 1) + (j >> 7);
          const float v = (gsrc == g) ? pw[((size_t)g * 128 + (j & 127)) * 256 + (o & 255)] : 0.f; wp[i] = (bf16_t)f2bf(v); } }
    { float* oml = (float*)(ws + WS_OML); const float* lb = a.in[5]; for (size_t i = gtid; i < 1024; i += nthr) oml[i] = sigmoidf_(lb[1024 + i] - lb[i]); }
    cvt_stream(a.in[14], (bf16_t*)(ws + WS_SK), (size_t)16 * 128 * 128 / 4, gtid, nthr);
    cvt_stream(a.in[1], (bf16_t*)(ws + WS_PB), (size_t)T * 256 / 4, gtid, nthr);
    for (int row = gw; row < 2 * NEXP; row += NGW) {
        const bool isv = row >= NEXP; const int e = isv ? row - NEXP : row;
        const GAS f32x4* src = (const GAS f32x4*)((isv ? a.in[16] : a.in[15]) + (size_t)e * 1024) + F.lane * 4;
        f32x4 v[4]; float mx = 0.f;
#pragma unroll
        for (int j = 0; j < 4; ++j) { v[j] = src[j];
#pragma unroll
            for (int c = 0; c < 4; ++c) mx = fmaxf(mx, __builtin_fabsf(v[j][c])); }
#pragma unroll
        for (int o = 1; o < 64; o <<= 1) mx = fmaxf(mx, __shfl_xor(mx, o));
        const float sc = mx > 0.f ? mx * (1.0f / 127.0f) : 1.0f, inv = 1.0f / sc;
        u32x4 o4;
#pragma unroll
        for (int j = 0; j < 4; ++j) { unsigned wq = 0u;
#pragma unroll
            for (int c = 0; c < 4; ++c) { int qi = (int)__builtin_rintf(v[j][c] * inv); qi = qi > 127 ? 127 : (qi < -127 ? -127 : qi); wq |= (unsigned)((isv ? qi + 128 : qi) & 0xFF) << (8 * c); }
            o4[j] = wq; }
        *((GAS u32x4*)(ws + (isv ? WS_VT : WS_UT) + (size_t)e * 1024) + F.lane) = o4;
        if (F.lane == 0) ((float*)(ws + (isv ? WS_VS : WS_US)))[e] = sc;
    }
    { const float* x = a.in[0]; const float* g0 = a.in[2]; const float* b0 = a.in[3]; bf16_t* XN = (bf16_t*)(ws + WS_XN); float* st = (float*)(ws + WS_ST0);
      for (int m = gw; m < T; m += NGW) {
          const GAS f32x4* xr = (const GAS f32x4*)(x + (size_t)m * D) + F.lane;
          f32x4 v[4]; float s = 0.f;
#pragma unroll
          for (int j = 0; j < 4; ++j) { v[j] = xr[64 * j]; s += (v[j][0] + v[j][1]) + (v[j][2] + v[j][3]); }
          const float mean = wave_sum(s) * (1.f / D); float s2 = 0.f;
#pragma unroll
          for (int j = 0; j < 4; ++j) { v[j] = v[j] - mean; s2 += (v[j][0] * v[j][0] + v[j][1] * v[j][1]) + (v[j][2] * v[j][2] + v[j][3] * v[j][3]); }
          const float rstd = 1.f / sqrtf(wave_sum(s2) * (1.f / D) + LN_EPS);
          if (F.lane == 0) { st[2 * (size_t)m] = mean; st[2 * (size_t)m + 1] = rstd; }
          GAS u32x2* o8 = (GAS u32x2*)(XN + (size_t)m * D) + F.lane;
#pragma unroll
          for (int j = 0; j < 4; ++j) { const f32x4 gg = ((const GAS f32x4*)g0)[64 * j + F.lane], bb = ((const GAS f32x4*)b0)[64 * j + F.lane];
              const f32x4 h = v[j] * rstd * gg + bb; u32x2 o; o.x = pk2(h[0], h[1]); o.y = pk2(h[2], h[3]); o8[64 * j] = o; }
      } }
}

constexpr int HG_QD = 0, HG_KI = 8704, HG_KET = 17408, HG_VT = 25600, HG_DEC = 33792, HG_SEG = 34304, HG_PART = 38400;
__device__ __forceinline__ int hg_toff(int row, int slot) { return row * 64 + ((slot ^ ((row >> 1) & 7)) << 3); }
__device__ __forceinline__ float xrow16_sum(float x) {
    const auto s_ = __builtin_amdgcn_permlane16_swap(__builtin_bit_cast(unsigned, x), __builtin_bit_cast(unsigned, x), false, false);
    const unsigned s0 = s_[0], s1 = s_[1]; x = __builtin_bit_cast(float, s0) + __builtin_bit_cast(float, s1);
    const auto t_ = __builtin_amdgcn_permlane32_swap(__builtin_bit_cast(unsigned, x), __builtin_bit_cast(unsigned, x), false, false);
    const unsigned t0 = t_[0], t1 = t_[1]; return __builtin_bit_cast(float, t0) + __builtin_bit_cast(float, t1);
}
__device__ __forceinline__ bf16x8 mk_frag(unsigned a, unsigned b, unsigned c, unsigned d) { const u32x4 v = {a, b, c, d}; return __builtin_bit_cast(bf16x8, v); }
__device__ __forceinline__ bf16x8 ld_frag2(const LAS unsigned char* p0, const LAS unsigned char* p1) { const u32x2 a = *(const LAS u32x2*)p0, b = *(const LAS u32x2*)p1; return mk_frag(a.x, a.y, b.x, b.y); }
#define MFMA16(A_, B_, C_) __builtin_amdgcn_mfma_f32_16x16x32_bf16((A_), (B_), (C_), 0, 0, 0)
__device__ __forceinline__ void hgrn_unit(Frame& F, const Args& a, int unit) {
    unsigned char* ws = a.ws;
    const bf16_t* Qs = (const bf16_t*)(ws + WS_QS); const bf16_t* Kk = (const bf16_t*)(ws + WS_KK); const bf16_t* Vi = (const bf16_t*)(ws + WS_VI); const bf16_t* SG = (const bf16_t*)(ws + WS_SG);
    bf16_t* OG = (bf16_t*)(ws + WS_OG);
    const int b = unit >> 3, h = unit & 7, lane = F.lane, w = F.wave, r = lane & 15, q = lane >> 4, cp = lane;
    LAS unsigned char* L = F.lds;
    const f32x4 ngv = *(const GAS f32x4*)(a.in[6] + 16 * w + 4 * q);
    f32x4 S[8];
#pragma unroll
    for (int t = 0; t < 8; ++t) S[t] = (f32x4){0.f, 0.f, 0.f, 0.f};
    f32x4 O[2]; O[0] = O[1] = (f32x4){0.f, 0.f, 0.f, 0.f};
    u32x2 sgc[2], sgn[2]; sgc[0] = sgc[1] = sgn[0] = sgn[1] = (u32x2){0u, 0u};
    unsigned rq[4], rk[4], rv[4];
    const size_t tb = (size_t)b * SEQ;
    {
        const size_t g0 = (tb + 4 * w) * 1024 + h * 128 + 2 * cp;
#pragma unroll
        for (int i = 0; i < 4; ++i) { rq[i] = *(const GAS unsigned*)(Qs + g0 + (size_t)i * 1024); rk[i] = *(const GAS unsigned*)(Kk + g0 + (size_t)i * 1024); rv[i] = *(const GAS unsigned*)(Vi + g0 + (size_t)i * 1024); }
#pragma unroll
        for (int ct = 0; ct < 2; ++ct) sgn[ct] = *(const GAS u32x2*)(SG + (tb + 16 * ct + r) * 1024 + h * 128 + 16 * w + 4 * q);
    }
    for (int n = 0; n <= SEQ / 32; ++n) {
        const bool live = n < SEQ / 32;
        const size_t t0 = tb + (size_t)n * 32;
        float kv[4][2], qv[4][2], vv[4][2], cum[4][2];
        if (live) {
#pragma unroll
            for (int i = 0; i < 4; ++i) { kv[i][0] = bflo(rk[i]); kv[i][1] = bfhi(rk[i]); qv[i][0] = bflo(rq[i]); qv[i][1] = bfhi(rq[i]); vv[i][0] = bflo(rv[i]); vv[i][1] = bfhi(rv[i]); }
#pragma unroll
            for (int e = 0; e < 2; ++e) { float c_ = 0.f;
#pragma unroll
                for (int i = 0; i < 4; ++i) { c_ += __logf(1.0f - kv[i][e]); cum[i][e] = c_; } }
            *(LAS f32x2*)(L + HG_SEG + (w * 128 + 2 * cp) * 4) = (f32x2){cum[3][0], cum[3][1]};
            if (n + 1 < SEQ / 32) {
                const size_t g0 = (t0 + 32 + 4 * w) * 1024 + h * 128 + 2 * cp;
#pragma unroll
                for (int i = 0; i < 4; ++i) { rq[i] = *(const GAS unsigned*)(Qs + g0 + (size_t)i * 1024); rk[i] = *(const GAS unsigned*)(Kk + g0 + (size_t)i * 1024); rv[i] = *(const GAS unsigned*)(Vi + g0 + (size_t)i * 1024); }
            }
        }
        __syncthreads();
        if (n > 0) {
            const size_t tp = t0 - 32;
#pragma unroll
            for (int ct = 0; ct < 2; ++ct) { float tot = 0.f;
#pragma unroll
                for (int ww = 0; ww < 8; ++ww) tot += *(const LAS float*)(L + HG_PART + (ww * 32 + 16 * ct + r) * 4);
                const float rstd = 1.0f / sqrtf(tot * (1.0f / 128.0f) + RMS_EPS);
                const f32x4 sg = {bflo(sgc[ct].x), bfhi(sgc[ct].x), bflo(sgc[ct].y), bfhi(sgc[ct].y)};
                const f32x4 o = O[ct] * rstd * ngv * sg;
                u32x2 pk; pk.x = cvt_pk_bf16(o[0], o[1]); pk.y = cvt_pk_bf16(o[2], o[3]);
                *(GAS u32x2*)(OG + (tp + 16 * ct + r) * 1024 + h * 128 + 16 * w + 4 * q) = pk; }
        }
        if (!live) break;
        sgc[0] = sgn[0]; sgc[1] = sgn[1];
        if (n + 1 < SEQ / 32) {
#pragma unroll
            for (int ct = 0; ct < 2; ++ct) sgn[ct] = *(const GAS u32x2*)(SG + (t0 + 32 + 16 * ct + r) * 1024 + h * 128 + 16 * w + 4 * q);
        }
        {
            float pre[2] = {0.f, 0.f}, tot[2] = {0.f, 0.f};
#pragma unroll
            for (int s_ = 0; s_ < 8; ++s_) { const f32x2 v = *(const LAS f32x2*)(L + HG_SEG + (s_ * 128 + 2 * cp) * 4); tot[0] += v.x; tot[1] += v.y; if (s_ < w) { pre[0] += v.x; pre[1] += v.y; } }
            float dec[2] = {__expf(tot[0]), __expf(tot[1])};
            if (w == 0) *(LAS f32x2*)(L + HG_DEC + 2 * cp * 4) = (f32x2){dec[0], dec[1]};
            float ke[4][2];
#pragma unroll
            for (int i = 0; i < 4; ++i) { float qd[2], ki[2];
#pragma unroll
                for (int e = 0; e < 2; ++e) { const float eb = __expf(pre[e] + cum[i][e]), ieb = __builtin_amdgcn_rcpf(eb); qd[e] = qv[i][e] * eb; ki[e] = kv[i][e] * ieb; ke[i][e] = ki[e] * dec[e]; }
                *(LAS unsigned*)(L + HG_QD + (4 * w + i) * 272 + 4 * cp) = cvt_pk_bf16(qd[0], qd[1]);
                *(LAS unsigned*)(L + HG_KI + (4 * w + i) * 272 + 4 * cp) = cvt_pk_bf16(ki[0], ki[1]); }
#pragma unroll
            for (int e = 0; e < 2; ++e) { const int row = 2 * cp + e;
                *(LAS u32x2*)(L + HG_KET + hg_toff(row, w)) = (u32x2){cvt_pk_bf16(ke[0][e], ke[1][e]), cvt_pk_bf16(ke[2][e], ke[3][e])};
                *(LAS u32x2*)(L + HG_VT + hg_toff(row, w)) = (u32x2){cvt_pk_bf16(vv[0][e], vv[1][e]), cvt_pk_bf16(vv[2][e], vv[3][e])}; }
        }
        __syncthreads();
        {
            f32x4 X00 = {0.f, 0.f, 0.f, 0.f}, X01 = X00, X11 = X00;
#pragma unroll
            for (int kk = 0; kk < 4; ++kk) {
                const bf16x8 ka0 = *(const LAS bf16x8*)(L + HG_KI + r * 272 + 64 * kk + 16 * q), ka1 = *(const LAS bf16x8*)(L + HG_KI + (16 + r) * 272 + 64 * kk + 16 * q);
                const bf16x8 qb0 = *(const LAS bf16x8*)(L + HG_QD + r * 272 + 64 * kk + 16 * q), qb1 = *(const LAS bf16x8*)(L + HG_QD + (16 + r) * 272 + 64 * kk + 16 * q);
                X00 = MFMA16(ka0, qb0, X00); X01 = MFMA16(ka0, qb1, X01); X11 = MFMA16(ka1, qb1, X11);
            }
#pragma unroll
            for (int i = 0; i < 4; ++i) { const bool keep = (4 * q + i) <= r; X00[i] = keep ? X00[i] : 0.f; X11[i] = keep ? X11[i] : 0.f; }
            const bf16x8 xb0 = mk_frag(cvt_pk_bf16(X00[0], X00[1]), cvt_pk_bf16(X00[2], X00[3]), 0u, 0u);
            const bf16x8 xb1 = mk_frag(cvt_pk_bf16(X01[0], X01[1]), cvt_pk_bf16(X01[2], X01[3]), cvt_pk_bf16(X11[0], X11[1]), cvt_pk_bf16(X11[2], X11[3]));
            const int vrow = 16 * w + r;
            const bf16x8 va = ld_frag2(L + HG_VT + hg_toff(vrow, q), L + HG_VT + hg_toff(vrow, 4 + q));
            O[0] = MFMA16(va, xb0, ((f32x4){0.f, 0.f, 0.f, 0.f})); O[1] = MFMA16(va, xb1, ((f32x4){0.f, 0.f, 0.f, 0.f}));
#pragma unroll
            for (int kk = 0; kk < 4; ++kk) {
                const bf16x8 sa = mk_frag(cvt_pk_bf16(S[2 * kk][0], S[2 * kk][1]), cvt_pk_bf16(S[2 * kk][2], S[2 * kk][3]), cvt_pk_bf16(S[2 * kk + 1][0], S[2 * kk + 1][1]), cvt_pk_bf16(S[2 * kk + 1][2], S[2 * kk + 1][3]));
                const bf16x8 qb0 = ld_frag2(L + HG_QD + r * 272 + 64 * kk + 8 * q, L + HG_QD + r * 272 + 64 * kk + 32 + 8 * q);
                const bf16x8 qb1 = ld_frag2(L + HG_QD + (16 + r) * 272 + 64 * kk + 8 * q, L + HG_QD + (16 + r) * 272 + 64 * kk + 32 + 8 * q);
                O[0] = MFMA16(sa, qb0, O[0]); O[1] = MFMA16(sa, qb1, O[1]);
            }
            const bf16x8 vb = ld_frag2(L + HG_VT + hg_toff(vrow, 2 * q), L + HG_VT + hg_toff(vrow, 2 * q + 1));
#pragma unroll
            for (int t = 0; t < 8; ++t) {
                const f32x4 dc = *(const LAS f32x4*)(L + HG_DEC + (16 * t + 4 * q) * 4);
                const int krow = 16 * t + r;
                const bf16x8 ka = ld_frag2(L + HG_KET + hg_toff(krow, 2 * q), L + HG_KET + hg_toff(krow, 2 * q + 1));
                S[t] = MFMA16(ka, vb, S[t] * dc);
            }
#pragma unroll
            for (int ct = 0; ct < 2; ++ct) { const float ss = xrow16_sum((O[ct][0] * O[ct][0] + O[ct][1] * O[ct][1]) + (O[ct][2] * O[ct][2] + O[ct][3] * O[ct][3]));
                if (q == 0) *(LAS float*)(L + HG_PART + (w * 32 + 16 * ct + r) * 4) = ss; }
        }
    }
    __syncthreads();
}
__device__ __forceinline__ void pool_prep(Frame& F, const Args& a, size_t gtid, size_t nthr) {
    const bf16_t* VP = (const bf16_t*)(a.ws + WS_VP); bf16_t* PL = (bf16_t*)(a.ws + WS_PL);
    for (size_t item = gtid; item < (size_t)T * 64; item += nthr) {
        const int t = (int)(item >> 6), c8 = (int)(item & 63) * 8, gi = c8 >> 7, w = 2 << gi, pos = t & (SEQ - 1), cnt = (pos + 1 < w) ? pos + 1 : w;
        f32x4 s0 = {0.f, 0.f, 0.f, 0.f}, s1 = {0.f, 0.f, 0.f, 0.f}, c0, c1;
        for (int j = 0; j < cnt; ++j) { const u32x4 r = *(const GAS u32x4*)(VP + (size_t)(t - j) * 512 + c8); f32x4 a0, a1; pg8::unpack8(r, a0, a1); s0 += a0; s1 += a1; if (j == 0) { c0 = a0; c1 = a1; } }
        const float inv = 1.0f / (float)cnt;
        *(GAS u32x4*)(PL + (size_t)t * 512 + c8) = pg8::pack8(s0 * inv - c0, s1 * inv - c1);
    }
}

__device__ __forceinline__ void phase_ln1(Frame& F, const Args& a) {
    float* R1 = a.out; bf16_t* H1b = (bf16_t*)(a.ws + WS_H1B); const float* g1 = a.in[11]; const float* b1 = a.in[12];
    const int gw = F.vcu * NWAVES + F.wave, NGW = F.G * NWAVES;
    for (int m = gw; m < T; m += NGW) {
        GAS f32x4* xr = (GAS f32x4*)(R1 + (size_t)m * D) + F.lane;
        f32x4 v[4]; float s = 0.f;
#pragma unroll
        for (int j = 0; j < 4; ++j) { v[j] = xr[64 * j]; s += (v[j][0] + v[j][1]) + (v[j][2] + v[j][3]); }
        const float mean = wave_sum(s) * (1.f / D); float s2 = 0.f;
#pragma unroll
        for (int j = 0; j < 4; ++j) { v[j] = v[j] - mean; s2 += (v[j][0] * v[j][0] + v[j][1] * v[j][1]) + (v[j][2] * v[j][2] + v[j][3] * v[j][3]); }
        const float rstd = 1.f / sqrtf(wave_sum(s2) * (1.f / D) + LN_EPS);
        GAS u32x2* o8 = (GAS u32x2*)(H1b + (size_t)m * D) + F.lane;
#pragma unroll
        for (int j = 0; j < 4; ++j) { const f32x4 gg = ((const GAS f32x4*)g1)[64 * j + F.lane], bb = ((const GAS f32x4*)b1)[64 * j + F.lane];
            const f32x4 h = v[j] * rstd * gg + bb; xr[64 * j] = h; u32x2 o; o.x = pk2(h[0], h[1]); o.y = pk2(h[2], h[3]); o8[64 * j] = o; }
    }
}

typedef float f32x16 __attribute__((ext_vector_type(16)));
__device__ __forceinline__ int ordi(float f) { const int b = __builtin_bit_cast(int, f); return b ^ ((b >> 31) & 0x7fffffff); }
__device__ __forceinline__ float unordi(int k) { const int b = k ^ ((k >> 31) & 0x7fffffff); return __builtin_bit_cast(float, b); }
__device__ __forceinline__ int imax_(int a, int b) { return a > b ? a : b; }
__device__ __forceinline__ int imin_(int a, int b) { return a < b ? a : b; }
__device__ __forceinline__ void tk_insert(int (&a)[16], int x) {
#pragma unroll
    for (int s_ = 0; s_ < 16; ++s_) { const int t = imax_(a[s_], x); x = imin_(a[s_], x); a[s_] = t; }
}
__device__ __forceinline__ void tk_bitonic_merge(int (&c)[16]) {
#pragma unroll
    for (int d = 8; d >= 1; d >>= 1)
#pragma unroll
        for (int s_ = 0; s_ < 16; ++s_) if ((s_ & d) == 0) { const int hi = imax_(c[s_], c[s_ + d]), lo = imin_(c[s_], c[s_ + d]); c[s_] = hi; c[s_ + d] = lo; }
}
__device__ __forceinline__ void tk_pair_merge(int (&a)[16]) {
    int pb[16];
#pragma unroll
    for (int s_ = 0; s_ < 16; ++s_) pb[s_] = __shfl_xor(a[s_], 32);
#pragma unroll
    for (int s_ = 0; s_ < 16; ++s_) a[s_] = imax_(a[s_], pb[15 - s_]);
    tk_bitonic_merge(a);
}
__device__ __forceinline__ int tk_lookup(unsigned long long lo, unsigned long long hi, int a) {
    const unsigned long long sel = (a & 8) ? hi : lo;
    return (int)((sel >> ((a & 7) * 8)) & 0xFFull);
}
__device__ __forceinline__ void phase_topk(Frame& F, const Args& a) {
    const bf16_t* SK = (const bf16_t*)(a.ws + WS_SK); const bf16_t* QRY = (const bf16_t*)(a.ws + WS_QRY);
    int* IDX = (int*)(a.ws + WS_IDX); float* GATE = (float*)(a.ws + WS_GATE); float* USG = (float*)(a.ws + WS_USG);
    const GAS float* USr = (const GAS float*)(a.ws + WS_US); const GAS float* VSr = (const GAS float*)(a.ws + WS_VS);
    const int gw = F.vcu * NWAVES + F.wave, NGW = F.G * NWAVES, lane = F.lane, r = lane & 31, hh = lane >> 5;
    constexpr int IMIN = (int)0x80000000;
    for (int task = gw; task < (T / 32) * 2; task += NGW) {
        const int tile = task >> 1, hg = task & 1; const size_t token = (size_t)tile * 32 + r;
#pragma unroll 1
        for (int hi = 0; hi < 4; ++hi) {
            const int h = hg * 4 + hi;
            int L[2][16];
#pragma unroll
            for (int p = 0; p < 2; ++p) {
                bf16x8 qf[8], af[8];
                const bf16_t* qp = QRY + token * 2048 + h * 256 + p * 128 + hh * 8;
#pragma unroll
                for (int ks = 0; ks < 8; ++ks) qf[ks] = *(const GAS bf16x8*)(qp + ks * 16);
                const bf16_t* skp = SK + ((size_t)(h * 2 + p) * 128 + r) * 128 + hh * 8;
#pragma unroll
                for (int ks = 0; ks < 8; ++ks) af[ks] = *(const GAS bf16x8*)(skp + ks * 16);
                int lst[16];
#pragma unroll
                for (int s_ = 0; s_ < 16; ++s_) lst[s_] = IMIN;
#pragma unroll 1
                for (int mt = 0; mt < 4; ++mt) {
                    f32x16 acc;
#pragma unroll
                    for (int i = 0; i < 16; ++i) acc[i] = 0.f;
#pragma unroll
                    for (int ks = 0; ks < 8; ++ks) acc = __builtin_amdgcn_mfma_f32_32x32x16_bf16(af[ks], qf[ks], acc, 0, 0, 0);
                    const int mtn = (mt < 3) ? mt + 1 : 3;
#pragma unroll
                    for (int ks = 0; ks < 8; ++ks) af[ks] = *(const GAS bf16x8*)(skp + (size_t)mtn * 32 * 128 + ks * 16);
                    const int sub = 32 * mt + 4 * hh;
#pragma unroll
                    for (int i = 0; i < 16; ++i) { const int base = 127 - ((i & 3) + 8 * (i >> 2)); const float sc = acc[i]; const int key = ((ordi(sc) & ~0x7F) | base) - sub; tk_insert(lst, key); }
                }
                tk_pair_merge(lst);
#pragma unroll
                for (int s_ = 0; s_ < 16; ++s_) L[p][s_] = lst[s_];
            }
            float fx[16], fy[16];
#pragma unroll
            for (int s_ = 0; s_ < 16; ++s_) { const int X = hh ? L[1][s_] : L[0][s_], Y = hh ? L[0][s_] : L[1][s_]; fx[s_] = unordi(X); fy[s_] = unordi(Y); }
            int cl[16];
#pragma unroll
            for (int s_ = 0; s_ < 16; ++s_) cl[s_] = IMIN;
#pragma unroll
            for (int ap = 0; ap < 4; ++ap)
#pragma unroll
                for (int bp = ap; bp < 16; ++bp) if ((ap + 1) * (bp + 1) <= 16) {
                    const float sum = fx[ap] + fy[bp];
                    const int pos = hh ? (bp * 16 + ap) : (ap * 16 + bp);
                    int key = (ordi(sum) & ~0xFF) | (255 - pos);
                    if (ap == bp) key = hh ? IMIN : key;
                    tk_insert(cl, key);
                }
            tk_pair_merge(cl);
            unsigned long long aLo = 0ull, aHi = 0ull, bLo = 0ull, bHi = 0ull;
#pragma unroll
            for (int j = 0; j < 8; ++j) { aLo |= (unsigned long long)(unsigned)(127 - (L[0][j] & 0x7F)) << (8 * j); aHi |= (unsigned long long)(unsigned)(127 - (L[0][8 + j] & 0x7F)) << (8 * j);
                bLo |= (unsigned long long)(unsigned)(127 - (L[1][j] & 0x7F)) << (8 * j); bHi |= (unsigned long long)(unsigned)(127 - (L[1][8 + j] & 0x7F)) << (8 * j); }
            int ex[16]; float ev[16]; float esum = 0.f; const float vmax = unordi(cl[0]);
#pragma unroll
            for (int s_ = 0; s_ < 16; ++s_) { const int pos = 255 - (cl[s_] & 0xFF); ex[s_] = tk_lookup(aLo, aHi, pos >> 4) * 128 + tk_lookup(bLo, bHi, pos & 15);
                ev[s_] = __expf(unordi(cl[s_]) - vmax); esum += ev[s_]; }
            const float inv = 1.0f / esum;
            if (hh == 0) { GAS u32x4* ip = (GAS u32x4*)(IDX + token * 128 + h * 16); GAS f32x4* up = (GAS f32x4*)(USG + token * 128 + h * 16);
#pragma unroll
                for (int w = 0; w < 4; ++w) { ip[w] = (u32x4){(unsigned)ex[4 * w], (unsigned)ex[4 * w + 1], (unsigned)ex[4 * w + 2], (unsigned)ex[4 * w + 3]};
                    up[w] = (f32x4){USr[ex[4 * w]], USr[ex[4 * w + 1]], USr[ex[4 * w + 2]], USr[ex[4 * w + 3]]}; } }
            else { GAS f32x4* gp = (GAS f32x4*)(GATE + token * 128 + h * 16);
#pragma unroll
                for (int w = 0; w < 4; ++w) gp[w] = (f32x4){ev[4 * w] * inv * VSr[ex[4 * w]], ev[4 * w + 1] * inv * VSr[ex[4 * w + 1]], ev[4 * w + 2] * inv * VSr[ex[4 * w + 2]], ev[4 * w + 3] * inv * VSr[ex[4 * w + 3]]}; }
        }
    }
}

__device__ __forceinline__ float dot2bf(unsigned a, unsigned b, float acc) { return __builtin_amdgcn_fdot2_f32_bf16(__builtin_bit_cast(bf16x2_t, a), __builtin_bit_cast(bf16x2_t, b), acc, false); }
template <int CTRL> __device__ __forceinline__ float dppf(float x) { return __builtin_bit_cast(float, __builtin_amdgcn_mov_dpp(__builtin_bit_cast(int, x), CTRL, 0xf, 0xf, true)); }
__device__ __forceinline__ float gelu1(float v) {
    const float av = __builtin_fabsf(v), t = __builtin_amdgcn_rcpf(av * 0.2316418882f + 1.0f);
    float q = t * 0.5307027145f + (-0.7265760135f); q = q * t + 0.7107068705f; q = q * t + (-0.142248368f); q = q * t + 0.127414796f; q = q * t;
    const float e = __builtin_amdgcn_exp2f((v * v) * (-0.72134752044f));
    const float m = v * (q * e);
    return v < 0.f ? m : v - m;
}
struct GStage { u32x4 u[2], v[2]; };
__device__ __forceinline__ void phase_gather(Frame& F, const Args& a, float* OUTP) {
    const unsigned char* UQ = a.ws + WS_UT; const unsigned char* VQ = a.ws + WS_VT; const bf16_t* PLE = (const bf16_t*)(a.ws + WS_PP);
    const int* IDX = (const int*)(a.ws + WS_IDX); const float* GATE = (const float*)(a.ws + WS_GATE); const float* USG = (const float*)(a.ws + WS_USG);
    const float* H = a.out; const float* g2 = a.in[19]; const float* b2 = a.in[20];
    const int gw = F.vcu * NWAVES + F.wave, NGW = F.G * NWAVES, lane = F.lane;
    for (int t = gw; t < T; t += NGW) {
        const int id0 = IDX[(size_t)t * 128 + lane], id1 = IDX[(size_t)t * 128 + 64 + lane];
        const float gt0 = GATE[(size_t)t * 128 + lane], gt1 = GATE[(size_t)t * 128 + 64 + lane];
        const float us0 = USG[(size_t)t * 128 + lane], us1 = USG[(size_t)t * 128 + 64 + lane];
        const GAS f32x4* hp = (const GAS f32x4*)(H + (size_t)t * D) + lane * 4;
        f32x4 hv[4]; float mx = 0.f;
#pragma unroll
        for (int i = 0; i < 4; ++i) { hv[i] = hp[i];
#pragma unroll
            for (int c = 0; c < 4; ++c) mx = fmaxf(mx, __builtin_fabsf(hv[i][c])); }
#pragma unroll
        for (int o = 1; o < 64; o <<= 1) mx = fmaxf(mx, __shfl_xor(mx, o));
        const float sh = mx > 0.f ? mx * (1.0f / 127.0f) : 1.0f, ish = 1.0f / sh;
        int hq[4];
#pragma unroll
        for (int i = 0; i < 4; ++i) { unsigned wq = 0u;
#pragma unroll
            for (int c = 0; c < 4; ++c) { const int qi = (int)__builtin_rintf(hv[i][c] * ish); wq |= (unsigned)(qi & 0xFF) << (8 * c); }
            hq[i] = (int)wq; }
        float acc[16]; float csum = 0.f;
#pragma unroll
        for (int i = 0; i < 16; ++i) acc[i] = 0.f;
        GStage st[8];
#define G_LOAD(S_, idv, kk) do { _Pragma("unroll") for (int j_ = 0; j_ < 2; ++j_) { const int e_ = __builtin_amdgcn_readlane(idv, (kk) + j_); \
            st[S_].u[j_] = *((const GAS u32x4*)(UQ + (size_t)e_ * 1024) + lane); st[S_].v[j_] = *((const GAS u32x4*)(VQ + (size_t)e_ * 1024) + lane); } } while (0)
#define G_COMP(S_, gtv, usv, kk) do { float d_[2]; _Pragma("unroll") for (int j_ = 0; j_ < 2; ++j_) { int x_ = 0; \
            _Pragma("unroll") for (int c_ = 0; c_ < 4; ++c_) x_ = __builtin_amdgcn_sdot4((int)st[S_].u[j_][c_], hq[c_], x_, false); d_[j_] = (float)x_; } \
            const auto sw_ = __builtin_amdgcn_permlane32_swap(__builtin_bit_cast(unsigned, d_[0]), __builtin_bit_cast(unsigned, d_[1]), false, false); \
            const unsigned sw0_ = sw_[0], sw1_ = sw_[1]; float x_ = __builtin_bit_cast(float, sw0_) + __builtin_bit_cast(float, sw1_); \
            const auto s16_ = __builtin_amdgcn_permlane16_swap(__builtin_bit_cast(unsigned, x_), __builtin_bit_cast(unsigned, x_), false, false); \
            const unsigned s160_ = s16_[0], s161_ = s16_[1]; x_ = __builtin_bit_cast(float, s160_) + __builtin_bit_cast(float, s161_); \
            x_ += dppf<0x128>(x_); x_ += dppf<0x141>(x_); x_ += dppf<0x4E>(x_); x_ += dppf<0xB1>(x_); \
            const float g0_ = __builtin_bit_cast(float, __builtin_amdgcn_readlane(__builtin_bit_cast(int, gtv), (kk))), g1_ = __builtin_bit_cast(float, __builtin_amdgcn_readlane(__builtin_bit_cast(int, gtv), (kk) + 1)); \
            const float u0_ = __builtin_bit_cast(float, __builtin_amdgcn_readlane(__builtin_bit_cast(int, usv), (kk))), u1_ = __builtin_bit_cast(float, __builtin_amdgcn_readlane(__builtin_bit_cast(int, usv), (kk) + 1)); \
            const float act_ = gelu1(x_ * sh * (lane < 32 ? u0_ : u1_)) * (lane < 32 ? g0_ : g1_); \
            const float a0_ = __builtin_bit_cast(float, __builtin_amdgcn_readlane(__builtin_bit_cast(int, act_), 0)), a1_ = __builtin_bit_cast(float, __builtin_amdgcn_readlane(__builtin_bit_cast(int, act_), 32)); \
            csum += a0_ + a1_; \
            _Pragma("unroll") for (int c_ = 0; c_ < 4; ++c_) { const unsigned w0_ = st[S_].v[0][c_], w1_ = st[S_].v[1][c_]; \
                acc[4 * c_ + 0] += a0_ * (float)(w0_ & 0xFFu); acc[4 * c_ + 1] += a0_ * (float)((w0_ >> 8) & 0xFFu); acc[4 * c_ + 2] += a0_ * (float)((w0_ >> 16) & 0xFFu); acc[4 * c_ + 3] += a0_ * (float)(w0_ >> 24); \
                acc[4 * c_ + 0] += a1_ * (float)(w1_ & 0xFFu); acc[4 * c_ + 1] += a1_ * (float)((w1_ >> 8) & 0xFFu); acc[4 * c_ + 2] += a1_ * (float)((w1_ >> 16) & 0xFFu); acc[4 * c_ + 3] += a1_ * (float)(w1_ >> 24); } } while (0)
#pragma unroll
        for (int hh = 0; hh < 2; ++hh) {
            const int idv = hh ? id1 : id0; const float gtv = hh ? gt1 : gt0, usv = hh ? us1 : us0;
            G_LOAD(0, idv, 0); G_LOAD(1, idv, 2); G_LOAD(2, idv, 4); G_LOAD(3, idv, 6); G_LOAD(4, idv, 8); G_LOAD(5, idv, 10); G_LOAD(6, idv, 12);
            for (int k = 0; k < 64; k += 16) {
                G_LOAD(7, idv, k + 14); G_COMP(0, gtv, usv, k);
                if (k + 16 < 64) G_LOAD(0, idv, k + 16);
                G_COMP(1, gtv, usv, k + 2);
                if (k + 16 < 64) G_LOAD(1, idv, k + 18);
                G_COMP(2, gtv, usv, k + 4);
                if (k + 16 < 64) G_LOAD(2, idv, k + 20);
                G_COMP(3, gtv, usv, k + 6);
                if (k + 16 < 64) G_LOAD(3, idv, k + 22);
                G_COMP(4, gtv, usv, k + 8);
                if (k + 16 < 64) G_LOAD(4, idv, k + 24);
                G_COMP(5, gtv, usv, k + 10);
                if (k + 16 < 64) G_LOAD(5, idv, k + 26);
                G_COMP(6, gtv, usv, k + 12);
                if (k + 16 < 64) G_LOAD(6, idv, k + 28);
                G_COMP(7, gtv, usv, k + 14);
            }
        }
#undef G_LOAD
#undef G_COMP
        const GAS u32x4* pp = (const GAS u32x4*)(PLE + (size_t)t * D) + lane * 2;
        const u32x4 pa = pp[0], pb = pp[1];
        f32x4 p[4]; pg8::unpack8(pa, p[0], p[1]); pg8::unpack8(pb, p[2], p[3]);
        const float off = 128.0f * csum;
        f32x4 r[4];
#pragma unroll
        for (int i = 0; i < 4; ++i) r[i] = hv[i] * ALPHA + ((f32x4){acc[4 * i], acc[4 * i + 1], acc[4 * i + 2], acc[4 * i + 3]} - off) + p[i];
        float s = 0.f;
#pragma unroll
        for (int i = 0; i < 4; ++i) s += (r[i][0] + r[i][1]) + (r[i][2] + r[i][3]);
        const float mean = wave_sum(s) * (1.f / D); float s2 = 0.f;
#pragma unroll
        for (int i = 0; i < 4; ++i) { r[i] = r[i] - mean; s2 += (r[i][0] * r[i][0] + r[i][1] * r[i][1]) + (r[i][2] * r[i][2] + r[i][3] * r[i][3]); }
        const float rstd = 1.f / sqrtf(wave_sum(s2) * (1.f / D) + LN_EPS);
        const GAS f32x4* gp = (const GAS f32x4*)g2 + lane * 4; const GAS f32x4* bp = (const GAS f32x4*)b2 + lane * 4;
        GAS f32x4* op = (GAS f32x4*)(OUTP + (size_t)t * D) + lane * 4;
#pragma unroll
        for (int i = 0; i < 4; ++i) op[i] = r[i] * rstd * gp[i] + bp[i];
    }
}

constexpr int NPHASE = 9;
__global__ void __launch_bounds__(NWAVES * 64, 2) mk_fwd(Args args) {
    extern __shared__ __attribute__((aligned(16))) unsigned char lds[];
    Frame F;
    F.lds = (LAS unsigned char*)lds;
    F.MISC = (volatile LAS unsigned*)(F.lds + MISC_OFF);
    F.tid = threadIdx.x; F.lane = F.tid & 63; F.wave = __builtin_amdgcn_readfirstlane(F.tid >> 6);
    F.G = gridDim.x; { const int bx = blockIdx.x; F.vcu = (F.G % 8 == 0) ? (bx % 8) * (F.G / 8) + bx / 8 : bx; }
    unsigned char* ws = args.ws;
    F.ctl = (gu32*)(ws + WS_CTL);
    for (int u = F.tid; u < (LDS_BYTES - LDSCTL_OFF) / 4; u += NWAVES * 64) ((LAS unsigned*)(F.lds + LDSCTL_OFF))[u] = 0u;
    __syncthreads();
    const int lo = args.ph_lo, hi = args.ph_hi;
    const bool one = (hi - lo) > 1;
    XcdBarrier bar; bar.bar = (unsigned*)(F.ctl + CW_BAR); bar.x = 0; bar.st = nullptr;
    if (one) bar = xcd_barrier_post((unsigned*)(F.ctl + CW_BAR), F.MISC + 8);
#ifndef PH_MASK
#define PH_MASK 0xFFFF
#endif
#define IN(k) (((PH_MASK >> (k)) & 1) && lo <= (k) && (k) < hi)
#define SEAM(k) do { if (IN(k) && IN((k) + 1)) xcd_barrier(bar); } while (0)
#ifndef REP_MASK
#define REP_MASK 0
#define REP_N 1
#endif
#define REPS(k) for (int rep_ = (((REP_MASK >> (k)) & 1) ? REP_N : 1); rep_ > 0; --rep_)
    bf16_t* const GA = (bf16_t*)args.out; bf16_t* const GB = (bf16_t*)args.out + (size_t)T * 1024;

    if (IN(0)) REPS(0) { phase_prologue(F, args); SEAM(0); }
    if (IN(1)) REPS(1) {
        pg8::Gemm g{(const bf16_t*)(ws + WS_XN), (const bf16_t*)(ws + WS_WIN), T, NPROJ, 1024, 1024, 1024, 0, 0};
        pg8::StaticOrder S; S.init(T, NPROJ, F.G, (int)blockIdx.x);
        pg8::EpiProj E{(bf16_t*)(ws + WS_QS), (bf16_t*)(ws + WS_KK), (bf16_t*)(ws + WS_VI), (bf16_t*)(ws + WS_SG), (bf16_t*)(ws + WS_VP), GA, GB, (const float*)(ws + WS_OML)};
        pg8::gemm_phase<pg8::EpiProj>(F.lds, g, S, E);
        SEAM(1);
    }
    if (IN(2)) REPS(2) {
        const int nh = F.G > 64 ? 64 : F.G;
        if ((int)blockIdx.x < nh) { for (int u = blockIdx.x; u < 64; u += nh) hgrn_unit(F, args, u); }
        if (F.G <= 64) pool_prep(F, args, (size_t)blockIdx.x * 512 + F.tid, (size_t)F.G * 512);
        else if ((int)blockIdx.x >= 64) pool_prep(F, args, (size_t)(blockIdx.x - 64) * 512 + F.tid, (size_t)(F.G - 64) * 512);
        SEAM(2);
    }
    if (IN(3)) REPS(3) {
        { pg8::Gemm g{(const bf16_t*)(ws + WS_PL), (const bf16_t*)(ws + WS_WPOOL), T, 1024, 256, 512, 256, 1, 256};
          pg8::StaticOrder S; S.init(T, 1024, F.G, (int)blockIdx.x);
          pg8::EpiYB E{(bf16_t*)(ws + WS_YB), GB, args.in[9]};
          pg8::gemm_phase<pg8::EpiYB>(F.lds, g, S, E); }
        { pg8::Gemm g{(const bf16_t*)(ws + WS_OG), (const bf16_t*)(ws + WS_WA), T, 1024, 1024, 1024, 1024, 0, 0};
          pg8::StaticOrder S; S.init(T, 1024, F.G, (int)blockIdx.x);
          pg8::EpiMix E{(bf16_t*)(ws + WS_MIX), GA, (const bf16_t*)(ws + WS_YB)};
          pg8::gemm_phase<pg8::EpiMix>(F.lds, g, S, E); }
        { pg8::Gemm g{(const bf16_t*)(ws + WS_PB), (const bf16_t*)(ws + WS_WPP), T, 1024, 256, 256, 256, 0, 0};
          pg8::StaticOrder S; S.init(T, 1024, F.G, (int)blockIdx.x);
          pg8::EpiPlain E{(bf16_t*)(ws + WS_PP), 1024};
          pg8::gemm_phase<pg8::EpiPlain>(F.lds, g, S, E); }
        SEAM(3);
    }
    if (IN(4)) REPS(4) {
        pg8::Gemm g{(const bf16_t*)(ws + WS_MIX), (const bf16_t*)(ws + WS_WOUT), T, 1024, 1024, 1024, 1024, 0, 0};
        pg8::StaticOrder S; S.init(T, 1024, F.G, (int)blockIdx.x);
        pg8::EpiR1 E{args.out, args.in[0], (const float*)(ws + WS_ST0), args.in[2], args.in[3]};
        pg8::gemm_phase<pg8::EpiR1>(F.lds, g, S, E);
        SEAM(4);
    }
    if (IN(5)) { phase_ln1(F, args); SEAM(5); }
    if (IN(6)) {
        pg8::Gemm g{(const bf16_t*)(ws + WS_H1B), (const bf16_t*)(ws + WS_WPGQ), T, 3072, 1024, 1024, 1024, 0, 0};
        pg8::StaticOrder S; S.init(T, 3072, F.G, (int)blockIdx.x);
        pg8::EpiPgq E{(bf16_t*)(ws + WS_PP), (bf16_t*)(ws + WS_QRY)};
        pg8::gemm_phase<pg8::EpiPgq>(F.lds, g, S, E);
        SEAM(6);
    }
    if (IN(7)) REPS(7) { phase_topk(F, args); SEAM(7); }
    if (IN(8)) REPS(8) { phase_gather(F, args, rep_ > 1 ? (float*)(ws + WS_QS) : args.out); if (rep_ > 1) xcd_barrier(bar); }
#undef IN
#undef SEAM
}

extern "C" void kernel_launch(void* const* d_in, const int* in_sizes, int n_in, void* d_out, int out_size, void* d_ws, size_t ws_size, hipStream_t stream) {
    static int grid = 0;
    if (grid == 0) {
        if (n_in != 21 || out_size != T * D || ws_size < WS_END) { fprintf(stderr, "kernel_launch: unexpected shapes (n_in %d, out %d, ws %zu)\n", n_in, out_size, ws_size); grid = -1; return; }
        int dev = 0, cus = 0, per_cu = 0;
        if (hipGetDevice(&dev) != hipSuccess || hipDeviceGetAttribute(&cus, hipDeviceAttributeMultiprocessorCount, dev) != hipSuccess) { grid = -1; return; }
        if (hipFuncSetAttribute((const void*)mk_fwd, hipFuncAttributeMaxDynamicSharedMemorySize, LDS_BYTES) != hipSuccess) { fprintf(stderr, "kernel_launch: hipFuncSetAttribute failed\n"); grid = -1; return; }
        if (hipOccupancyMaxActiveBlocksPerMultiprocessor(&per_cu, (const void*)mk_fwd, NWAVES * 64, LDS_BYTES) != hipSuccess || per_cu < 1)
            fprintf(stderr, "kernel_launch: occupancy query reports %d\n", per_cu);
        (void)hipGetLastError();
        grid = cus;
    }
    if (grid < 0) return;
    (void)hipMemsetAsync((char*)d_ws + WS_CTL, 0, CTL_ZERO_BYTES, stream);
    Args a{};
    for (int i = 0; i < 21; ++i) a.in[i] = (const float*)d_in[i];
    a.out = (float*)d_out; a.ws = (unsigned char*)d_ws;
#if MK_ONE_LAUNCH
    a.ph_lo = 0; a.ph_hi = NPHASE;
    hipLaunchKernelGGL(mk_fwd, dim3(grid), dim3(NWAVES * 64), LDS_BYTES, stream, a);
#else
    for (int p = 0; p < NPHASE; ++p) { a.ph_lo = p; a.ph_hi = p + 1; hipLaunchKernelGGL(mk_fwd, dim3(grid), dim3(NWAVES * 64), LDS_BYTES, stream, a); }
#endif
}
```

```cpp
#include <hip/hip_runtime.h>
#include <cstdio>
#include <cstdint>

#ifndef MK_ONE_LAUNCH
#define MK_ONE_LAUNCH 1
#endif

#define LAS __attribute__((address_space(3)))
#define GAS __attribute__((address_space(1)))
typedef unsigned short bf16_t;
typedef short bf16x8 __attribute__((ext_vector_type(8)));
typedef float f32x4 __attribute__((ext_vector_type(4)));
typedef float f32x2 __attribute__((ext_vector_type(2)));
typedef unsigned u32x4 __attribute__((ext_vector_type(4)));
typedef unsigned u32x2 __attribute__((ext_vector_type(2)));

constexpr int BATCH = 8, SEQ = 4096, T = BATCH * SEQ, D = 1024;
constexpr int NPROJ = 6656;
constexpr int NEXP = 16384;
constexpr float ALPHA = 1.189207115002721f;
constexpr float LN_EPS = 1e-5f, RMS_EPS = 1e-6f;
constexpr int NWAVES = 8;

constexpr size_t MiB = 1u << 20;
constexpr size_t WS_CTL = 0, CTL_ZERO_BYTES = 1 * MiB;
constexpr size_t WS_OML = 1 * MiB;
constexpr size_t WS_ST0 = 1 * MiB + 65536;
constexpr size_t WS_WIN = 2 * MiB;
constexpr size_t WS_WA = 15 * MiB;
constexpr size_t WS_WOUT = 17 * MiB;
constexpr size_t WS_WPGQ = 19 * MiB;
constexpr size_t WS_WPP = 25 * MiB;
constexpr size_t WS_WPOOL = 25 * MiB + 512 * 1024;
constexpr size_t WS_SK = 26 * MiB;
constexpr size_t WS_PB = 27 * MiB;
constexpr size_t WS_UT = 43 * MiB;
constexpr size_t WS_VT = 59 * MiB;
constexpr size_t WS_US = 75 * MiB, WS_VS = 75 * MiB + 65536;
constexpr size_t WS_LST = 76 * MiB, WS_DLG = 92 * MiB;
constexpr size_t WS_XN = 108 * MiB;
constexpr size_t WS_QS = 172 * MiB, WS_KK = 236 * MiB, WS_VI = 300 * MiB, WS_SG = 364 * MiB;
constexpr size_t WS_VP = 428 * MiB, WS_PL = 460 * MiB;
constexpr size_t WS_END = 492 * MiB;
constexpr size_t WS_OG = WS_XN, WS_YB = WS_QS, WS_MIX = WS_KK, WS_PP = WS_VI, WS_H1B = WS_SG, WS_QRY = WS_QS;
constexpr size_t WS_IDX = WS_VP, WS_GATE = WS_VP + 16 * MiB;
constexpr size_t WS_USG = WS_PL;

constexpr int RING_BYTES = 131072;
constexpr int LDSCTL_OFF = RING_BYTES, MISC_OFF = LDSCTL_OFF + 320;
constexpr int LDS_BYTES = 147456;

__device__ __forceinline__ unsigned f2bf(float f) { unsigned u = __builtin_bit_cast(unsigned, f); return (u + 0x7fffu + ((u >> 16) & 1u)) >> 16; }
__device__ __forceinline__ unsigned pk2(float lo, float hi) { return f2bf(lo) | (f2bf(hi) << 16); }
__device__ __forceinline__ float bflo(unsigned w) { return __builtin_bit_cast(float, w << 16); }
__device__ __forceinline__ float bfhi(unsigned w) { return __builtin_bit_cast(float, w & 0xffff0000u); }
typedef __bf16 bf16x2_t __attribute__((ext_vector_type(2)));
__device__ __forceinline__ unsigned cvt_pk_bf16(float lo, float hi) { bf16x2_t v; v[0] = (__bf16)lo; v[1] = (__bf16)hi; return __builtin_bit_cast(unsigned, v); }
__device__ __forceinline__ float sigmoidf_(float x) { return __builtin_amdgcn_rcpf(1.0f + __expf(-x)); }
__device__ __forceinline__ float wave_sum(float v) {
#pragma unroll
    for (int o = 1; o < 64; o <<= 1) v += __shfl_xor(v, o);
    return v;
}
#define LDS_WAIT() asm volatile("s_waitcnt lgkmcnt(0)" ::: "memory")
#define VM_WAIT() asm volatile("s_waitcnt vmcnt(0)" ::: "memory")

namespace pg8 {
constexpr int BM = 256, BK = 64, HALF = 128, HTB = HALF * BK * 2, STAGE_BYTES = 8 * HTB, NXCD = 8, WGM = 8;
__host__ __device__ __forceinline__ int lds_byte(int r, int c) { const int st = (r >> 4) * 2 + (c >> 5), rr = r & 15, cc = c & 31, ob = rr * 64 + cc * 2; return st * 1024 + (ob ^ (((ob >> 9) & 1) << 5)); }
__host__ __device__ __forceinline__ void stage_rc(int b, int& R, int& C) { const int st = b / 1024, sb = b % 1024, swz = sb ^ (((sb >> 9) & 1) << 5); R = (st >> 1) * 16 + swz / 64; C = (st & 1) * 32 + (swz % 64) / 2; }
__host__ __device__ __forceinline__ int perm32(int rho) { const int n = rho >> 4, i = rho & 15; return 8 * (i >> 2) + 4 * n + (i & 3); }

struct Unit { int pm, pn; };
struct Gemm { const bf16_t* A; const bf16_t* Bt; int M, N, K, lda, ldb, acol_shift, acol_mul; };

struct StaticOrder {
    int nM, nN, nwg, G, c;
    __host__ __device__ void init(int M, int N, int G_, int c_) { nM = M / BM; nN = N / BM; nwg = nM * nN; G = G_; c = c_; }
    __host__ __device__ bool next(int i, Unit& u) const {
        const long L = (long)i * G + c; if (L >= nwg) return false;
        int wgid = (int)L; { const int q = nwg / NXCD, r = nwg % NXCD, xcd = wgid % NXCD, off = wgid / NXCD; wgid = (xcd < r ? xcd * (q + 1) : r * (q + 1) + (xcd - r) * q) + off; }
        const int nig = WGM * nN, gid = wgid / nig, fm = gid * WGM, gsz = (nM - fm) < WGM ? (nM - fm) : WGM;
        u.pm = fm + ((wgid % nig) % gsz); u.pn = (wgid % nig) / gsz; return true;
    }
};


template <class Epi>
__device__ __forceinline__ void gemm_phase(LAS unsigned char* lds, const Gemm g, const StaticOrder& S, const Epi& E) {
    const int tid = threadIdx.x, wid = __builtin_amdgcn_readfirstlane(tid >> 6), lane = tid & 63, wr = wid >> 2, wc = wid & 3, fr = lane & 15, fq = lane >> 4;
    int K_ = g.K; asm volatile("" : "+s"(K_));
    const int K = K_, nt = K / BK;
    unsigned voffA[2], voffB[2];
#pragma unroll
    for (int i = 0; i < 2; ++i) { int R, C; stage_rc(tid * 16 + i * 8192, R, C); const int Rb = Epi::PERM ? ((R & ~31) + perm32(R & 31)) : R;
        voffA[i] = (unsigned)(R * g.lda + C) * 2u; voffB[i] = (unsigned)(Rb * g.ldb + C) * 2u; }
    const size_t kstep = (size_t)(BK * 2);
    const size_t hstepA = (size_t)HALF * g.lda * 2, hstepB = (size_t)HALF * g.ldb * 2;
    const size_t tstepA = 2 * hstepA, tstepB = 2 * hstepB;
    const unsigned ldsw = (unsigned)wid * 1024u;
    const int aoff = lds_byte(wr * 64 + fr, fq * 8), boff = lds_byte(wc * 32 + fr, fq * 8);
#define PG8_SA(b, h) (((b) * 2 + (h)) * HTB)
#define PG8_SB(b, h) ((4 + (b) * 2 + (h)) * HTB)
#define PG8_STAGE(bufoff, gbase, voff) do { _Pragma("unroll") for (int _i = 0; _i < 2; ++_i) \
        __builtin_amdgcn_global_load_lds((const unsigned*)((const char*)(gbase) + (voff)[_i]), (LAS unsigned*)(lds + (bufoff) + ldsw + _i * 8192), 16, 0, 0); } while (0)
#define PG8_LDA(dst, b, h) do { _Pragma("unroll") for (int m = 0; m < 4; ++m) _Pragma("unroll") for (int k = 0; k < 2; ++k) dst[m][k] = *(const LAS bf16x8*)(lds + PG8_SA(b, h) + aoff + m * 2048 + k * 1024); } while (0)
#define PG8_LDB(dst, b, h) do { _Pragma("unroll") for (int n = 0; n < 2; ++n) _Pragma("unroll") for (int k = 0; k < 2; ++k) dst[n][k] = *(const LAS bf16x8*)(lds + PG8_SB(b, h) + boff + n * 2048 + k * 1024); } while (0)
#define PG8_MMA(ai, bj, At, Bt) do { __builtin_amdgcn_s_setprio(1); _Pragma("unroll") for (int m = 0; m < 4; ++m) _Pragma("unroll") for (int n = 0; n < 2; ++n) _Pragma("unroll") for (int k = 0; k < 2; ++k) \
        acc[ai][bj][m][n] = __builtin_amdgcn_mfma_f32_16x16x32_bf16(Bt[n][k], At[m][k], acc[ai][bj][m][n], 0, 0, 0); __builtin_amdgcn_s_setprio(0); } while (0)
#define PG8_WAIT_V(n) asm volatile("s_waitcnt vmcnt(" #n ")" ::: "memory")
#define PG8_WAIT_L(n) asm volatile("s_waitcnt lgkmcnt(" #n ")" ::: "memory")
#define PG8_BAR __builtin_amdgcn_s_barrier()
#define PG8_SCHED __builtin_amdgcn_sched_barrier(0)
    Unit cur, nxt; int ui = 0;
    if (!S.next(0, cur)) return;
    f32x4 acc[2][2][4][2];
#pragma unroll
    for (int a = 0; a < 2; ++a)
#pragma unroll
        for (int b = 0; b < 2; ++b)
#pragma unroll
            for (int m = 0; m < 4; ++m)
#pragma unroll
                for (int n = 0; n < 2; ++n) acc[a][b][m][n] = (f32x4){0.f, 0.f, 0.f, 0.f};
    bf16x8 At[4][2], B0[2][2], B1[2][2];
    const char* cA = (const char*)g.A + (size_t)cur.pm * tstepA + (size_t)((cur.pn >> g.acol_shift) * g.acol_mul) * 2; const char* cB = (const char*)g.Bt + (size_t)cur.pn * tstepB;
    PG8_STAGE(PG8_SB(0, 0), cB, voffB); PG8_STAGE(PG8_SB(0, 1), cB + hstepB, voffB); PG8_STAGE(PG8_SA(0, 0), cA, voffA); PG8_STAGE(PG8_SA(0, 1), cA + hstepA, voffA);
    if (wr == 1) PG8_BAR;
    PG8_WAIT_V(2); PG8_BAR;
    PG8_STAGE(PG8_SB(1, 0), cB + kstep, voffB); PG8_STAGE(PG8_SA(1, 0), cA + kstep, voffA); PG8_STAGE(PG8_SB(1, 1), cB + hstepB + kstep, voffB);
    PG8_WAIT_V(6); PG8_BAR;
    for (;;) {
        const bool has_next = S.next(ui + 1, nxt);
        const char* nA = has_next ? (const char*)g.A + (size_t)nxt.pm * tstepA + (size_t)((nxt.pn >> g.acol_shift) * g.acol_mul) * 2 : cA;
        const char* nB = has_next ? (const char*)g.Bt + (size_t)nxt.pn * tstepB : cB;
        for (int t = 0; t < nt; t += 2) {
            const bool last = (t == nt - 2);
            const char* a1 = cA + (size_t)(t + 1) * kstep;
            const char* a2 = last ? nA : cA + (size_t)(t + 2) * kstep; const char* b2 = last ? nB : cB + (size_t)(t + 2) * kstep;
            const char* a3 = a2 + kstep; const char* b3 = b2 + kstep;
            PG8_LDB(B0, 0, 0); PG8_LDB(B1, 0, 1); PG8_SCHED; PG8_LDA(At, 0, 0); PG8_STAGE(PG8_SA(1, 1), a1 + hstepA, voffA);
            PG8_WAIT_V(8); PG8_WAIT_L(0); PG8_BAR; PG8_MMA(0, 0, At, B0); PG8_MMA(0, 1, At, B1); PG8_BAR; PG8_SCHED;
            PG8_LDA(At, 0, 1); PG8_STAGE(PG8_SB(0, 0), b2, voffB); PG8_STAGE(PG8_SB(0, 1), b2 + hstepB, voffB); PG8_STAGE(PG8_SA(0, 0), a2, voffA);
            PG8_WAIT_V(8); PG8_WAIT_L(0); PG8_BAR; PG8_MMA(1, 0, At, B0); PG8_MMA(1, 1, At, B1); PG8_BAR; PG8_SCHED;
            PG8_LDB(B0, 1, 0); PG8_LDB(B1, 1, 1); PG8_SCHED; PG8_LDA(At, 1, 0); PG8_STAGE(PG8_SA(0, 1), a2 + hstepA, voffA);
            PG8_WAIT_V(8); PG8_WAIT_L(0); PG8_BAR; PG8_MMA(0, 0, At, B0); PG8_MMA(0, 1, At, B1); PG8_BAR; PG8_SCHED;
            PG8_LDA(At, 1, 1); PG8_STAGE(PG8_SB(1, 0), b3, voffB); PG8_STAGE(PG8_SB(1, 1), b3 + hstepB, voffB); PG8_STAGE(PG8_SA(1, 0), a3, voffA);
            PG8_WAIT_V(8); PG8_WAIT_L(0); PG8_BAR; PG8_MMA(1, 0, At, B0); PG8_MMA(1, 1, At, B1); PG8_BAR; PG8_SCHED;
        }
        if (wr == 0) PG8_BAR;
        E(acc, cur, wr, wc, fr, fq);
        if (!has_next) break;
#pragma unroll
        for (int a = 0; a < 2; ++a)
#pragma unroll
            for (int b = 0; b < 2; ++b)
#pragma unroll
                for (int m = 0; m < 4; ++m)
#pragma unroll
                    for (int n = 0; n < 2; ++n) acc[a][b][m][n] = (f32x4){0.f, 0.f, 0.f, 0.f};
        cur = nxt; cA = nA; cB = nB; ++ui;
        if (wr == 1) PG8_BAR;
    }
    PG8_WAIT_V(0);
    PG8_BAR;
#undef PG8_SA
#undef PG8_SB
#undef PG8_STAGE
#undef PG8_LDA
#undef PG8_LDB
#undef PG8_MMA
#undef PG8_WAIT_V
#undef PG8_WAIT_L
#undef PG8_BAR
#undef PG8_SCHED
}

#define EPI_FENCE() asm volatile("" ::: "memory")
__device__ __forceinline__ u32x4 pack8(const f32x4& v0, const f32x4& v1) { u32x4 w; w.x = cvt_pk_bf16(v0[0], v0[1]); w.y = cvt_pk_bf16(v0[2], v0[3]); w.z = cvt_pk_bf16(v1[0], v1[1]); w.w = cvt_pk_bf16(v1[2], v1[3]); return w; }
__device__ __forceinline__ void unpack8(const u32x4& w, f32x4& v0, f32x4& v1) { v0 = (f32x4){bflo(w.x), bfhi(w.x), bflo(w.y), bfhi(w.y)}; v1 = (f32x4){bflo(w.z), bfhi(w.z), bflo(w.w), bfhi(w.w)}; }

struct EpiProj {
    static constexpr bool PERM = true;
    bf16_t *Qs, *Kk, *Vi, *SG, *VP, *GA, *GB; const float* oml;
    __device__ __forceinline__ void operator()(const f32x4 (&acc)[2][2][4][2], const Unit& u, int wr, int wc, int fr, int fq) const {
        const int pn = u.pn; bf16_t* base; int ldc = 1024, ct, mode;
        if (pn < 4) { base = Qs; ct = pn; mode = 0; } else if (pn < 8) { base = Kk; ct = pn - 4; mode = 1; } else if (pn < 12) { base = Vi; ct = pn - 8; mode = 2; }
        else if (pn < 16) { base = SG; ct = pn - 12; mode = 3; } else if (pn < 18) { base = VP; ct = pn - 16; mode = 2; ldc = 512; }
        else if (pn < 22) { base = GA; ct = pn - 18; mode = 4; } else { base = GB; ct = pn - 22; mode = 4; }
        const int row0 = u.pm * BM + wr * 64 + fr, col0 = ct * 256 + wc * 32 + 8 * fq;
        f32x4 om[2][2];
#pragma unroll
        for (int bj = 0; bj < 2; ++bj)
#pragma unroll
            for (int n = 0; n < 2; ++n) om[bj][n] = (mode == 1) ? *(const f32x4*)(oml + col0 + bj * HALF + 4 * n) : (f32x4){1.f, 1.f, 1.f, 1.f};
#pragma unroll
        for (int ai = 0; ai < 2; ++ai)
#pragma unroll
            for (int m = 0; m < 4; ++m) { bf16_t* rowp = base + (size_t)(row0 + ai * HALF + m * 16) * ldc + col0;
#pragma unroll
                for (int bj = 0; bj < 2; ++bj) { f32x4 v[2] = {acc[ai][bj][m][0], acc[ai][bj][m][1]};
#pragma unroll
                    for (int n = 0; n < 2; ++n)
#pragma unroll
                        for (int e = 0; e < 4; ++e) { const float x = v[n][e]; float y;
                            if (mode == 0) y = x * sigmoidf_(x) * 0.08838834764831845f;
                            else if (mode == 1) y = om[bj][n][e] * sigmoidf_(-x);
                            else if (mode == 2) y = x;
                            else if (mode == 3) y = x * sigmoidf_(x);
                            else y = sigmoidf_(x);
                            v[n][e] = y; }
                    *(u32x4*)(rowp + bj * HALF) = pack8(v[0], v[1]); } }
    }
};
struct EpiPlain {
    static constexpr bool PERM = true;
    bf16_t* O; int ldc;
    __device__ __forceinline__ void operator()(const f32x4 (&acc)[2][2][4][2], const Unit& u, int wr, int wc, int fr, int fq) const {
        const int row0 = u.pm * BM + wr * 64 + fr, col0 = u.pn * BM + wc * 32 + 8 * fq;
#pragma unroll
        for (int ai = 0; ai < 2; ++ai)
#pragma unroll
            for (int m = 0; m < 4; ++m) { bf16_t* rowp = O + (size_t)(row0 + ai * HALF + m * 16) * ldc + col0;
#pragma unroll
                for (int bj = 0; bj < 2; ++bj) *(u32x4*)(rowp + bj * HALF) = pack8(acc[ai][bj][m][0], acc[ai][bj][m][1]); }
    }
};
struct EpiYB {
    static constexpr bool PERM = true;
    bf16_t* YB; const bf16_t* GB; const float* scale;
    __device__ __forceinline__ void operator()(const f32x4 (&acc)[2][2][4][2], const Unit& u, int wr, int wc, int fr, int fq) const {
        const int row0 = u.pm * BM + wr * 64 + fr, col0 = u.pn * BM + wc * 32 + 8 * fq;
        f32x4 sc[2][2];
#pragma unroll
        for (int bj = 0; bj < 2; ++bj)
#pragma unroll
            for (int n = 0; n < 2; ++n) sc[bj][n] = *(const f32x4*)(scale + col0 + bj * HALF + 4 * n);
#pragma unroll
        for (int ai = 0; ai < 2; ++ai)
#pragma unroll
            for (int m = 0; m < 4; ++m) { const size_t off = (size_t)(row0 + ai * HALF + m * 16) * 1024 + col0;
#pragma unroll
                for (int bj = 0; bj < 2; ++bj) { const u32x4 gw = *(const u32x4*)(GB + off + bj * HALF); f32x4 g0, g1; unpack8(gw, g0, g1);
                    const f32x4 v0 = acc[ai][bj][m][0] * sc[bj][0] * g0, v1 = acc[ai][bj][m][1] * sc[bj][1] * g1;
                    *(u32x4*)(YB + off + bj * HALF) = pack8(v0, v1); }
                EPI_FENCE(); }
    }
};
struct EpiMix {
    static constexpr bool PERM = true;
    bf16_t* MIX; const bf16_t* GA; const bf16_t* YB;
    __device__ __forceinline__ void operator()(const f32x4 (&acc)[2][2][4][2], const Unit& u, int wr, int wc, int fr, int fq) const {
        const int row0 = u.pm * BM + wr * 64 + fr, col0 = u.pn * BM + wc * 32 + 8 * fq;
#pragma unroll
        for (int ai = 0; ai < 2; ++ai)
#pragma unroll
            for (int m = 0; m < 4; ++m) { const size_t off = (size_t)(row0 + ai * HALF + m * 16) * 1024 + col0;
#pragma unroll
                for (int bj = 0; bj < 2; ++bj) { const u32x4 gw = *(const u32x4*)(GA + off + bj * HALF), yw = *(const u32x4*)(YB + off + bj * HALF);
                    f32x4 g0, g1, y0, y1; unpack8(gw, g0, g1); unpack8(yw, y0, y1);
                    const f32x4 v0 = acc[ai][bj][m][0] * g0 + y0, v1 = acc[ai][bj][m][1] * g1 + y1;
                    *(u32x4*)(MIX + off + bj * HALF) = pack8(v0, v1); }
                EPI_FENCE(); }
    }
};
struct EpiR1 {
    static constexpr bool PERM = false;
    float* R1; const float* x; const float* st0; const float* g0; const float* b0;
    __device__ __forceinline__ void operator()(const f32x4 (&acc)[2][2][4][2], const Unit& u, int wr, int wc, int fr, int fq) const {
        const int row0 = u.pm * BM + wr * 64 + fr, col0 = u.pn * BM + wc * 32 + 4 * fq;
        f32x4 gg[2][2], bb[2][2];
#pragma unroll
        for (int bj = 0; bj < 2; ++bj)
#pragma unroll
            for (int n = 0; n < 2; ++n) { gg[bj][n] = *(const f32x4*)(g0 + col0 + bj * HALF + 16 * n); bb[bj][n] = *(const f32x4*)(b0 + col0 + bj * HALF + 16 * n); }
#pragma unroll
        for (int ai = 0; ai < 2; ++ai)
#pragma unroll
            for (int m = 0; m < 4; ++m) { const int r = row0 + ai * HALF + m * 16; const size_t off = (size_t)r * 1024 + col0; const f32x2 ms = *(const f32x2*)(st0 + 2 * (size_t)r);
#pragma unroll
                for (int bj = 0; bj < 2; ++bj)
#pragma unroll
                    for (int n = 0; n < 2; ++n) { const f32x4 xv = *(const f32x4*)(x + off + bj * HALF + 16 * n);
                        const f32x4 h = (xv - ms.x) * ms.y * gg[bj][n] + bb[bj][n];
                        *(f32x4*)(R1 + off + bj * HALF + 16 * n) = h * ALPHA + acc[ai][bj][m][n]; }
                EPI_FENCE(); }
    }
};
struct EpiPgq {
    static constexpr bool PERM = true;
    bf16_t* PP; bf16_t* QRY;
    __device__ __forceinline__ void operator()(const f32x4 (&acc)[2][2][4][2], const Unit& u, int wr, int wc, int fr, int fq) const {
        const int row0 = u.pm * BM + wr * 64 + fr;
        if (u.pn < 4) {
            const int col0 = u.pn * BM + wc * 32 + 8 * fq;
#pragma unroll
            for (int ai = 0; ai < 2; ++ai)
#pragma unroll
                for (int m = 0; m < 4; ++m) { const size_t off = (size_t)(row0 + ai * HALF + m * 16) * 1024 + col0;
#pragma unroll
                    for (int bj = 0; bj < 2; ++bj) { const u32x4 pw = *(const u32x4*)(PP + off + bj * HALF); f32x4 p0, p1; unpack8(pw, p0, p1); f32x4 v0, v1;
#pragma unroll
                        for (int e = 0; e < 4; ++e) { v0[e] = sigmoidf_(acc[ai][bj][m][0][e]) * p0[e]; v1[e] = sigmoidf_(acc[ai][bj][m][1][e]) * p1[e]; }
                        *(u32x4*)(PP + off + bj * HALF) = pack8(v0, v1); }
                    EPI_FENCE(); }
        } else {
            const int col0 = (u.pn - 4) * BM + wc * 32 + 8 * fq;
#pragma unroll
            for (int ai = 0; ai < 2; ++ai)
#pragma unroll
                for (int m = 0; m < 4; ++m) { bf16_t* rowp = QRY + (size_t)(row0 + ai * HALF + m * 16) * 2048 + col0;
#pragma unroll
                    for (int bj = 0; bj < 2; ++bj) *(u32x4*)(rowp + bj * HALF) = pack8(acc[ai][bj][m][0], acc[ai][bj][m][1]); }
        }
    }
};
}

typedef GAS unsigned gu32;
#define RLX_AGENT __ATOMIC_RELAXED, __HIP_MEMORY_SCOPE_AGENT
#define XB_TMO      128
#define XB_XCNT(j)  (256  + 64 * (j))
#define XB_XSUB(j)  (1280 + 64 * (j))
#define XB_XGEN(j)  (2304 + 64 * (j))
#define XB_TOP      3328
#define XB_TOPGEN   3392
#define XCD_BAR_WORDS 3456
#define XB_SPIN_CAP (1u << 22)
constexpr int CW_BAR = 4096;
__device__ __forceinline__ unsigned xb_ld(unsigned* p)              { return __hip_atomic_load(p, __ATOMIC_RELAXED, __HIP_MEMORY_SCOPE_AGENT); }
__device__ __forceinline__ unsigned xb_add(unsigned* p, unsigned v) { return __hip_atomic_fetch_add(p, v, __ATOMIC_RELAXED, __HIP_MEMORY_SCOPE_AGENT); }
__device__ __forceinline__ unsigned xb_xcc_id() { return (unsigned)__builtin_amdgcn_s_getreg((3 << 11) | 20) & 0xFu; }
#define XB_SPIN(cond, bar) do { unsigned _sp = 0; while (cond) { __builtin_amdgcn_s_sleep(1); \
    if ((++_sp & 255u) == 0u) { if (xb_ld(&(bar)[XB_TMO])) break; if (_sp > XB_SPIN_CAP) { atomicAdd(&(bar)[XB_TMO], 1u); break; } } } } while (0)
struct XcdBarrier { unsigned* bar; unsigned x; volatile LAS unsigned* st; };
__device__ __forceinline__ XcdBarrier xcd_barrier_post(unsigned* bar, volatile LAS unsigned* st) {
    XcdBarrier b; b.bar = bar; b.x = xb_xcc_id(); b.st = st;
    if (threadIdx.x == 0) (void)xb_add(&bar[XB_XCNT(b.x)], 1u);
    return b;
}
__device__ __forceinline__ void xcd_barrier_complete(unsigned* bar, unsigned x, unsigned& nloc, unsigned& nx) {
    const unsigned G = gridDim.x * gridDim.y * gridDim.z;
    unsigned sum, cnt, mine, sp = 0u;
    for (;;) {
        sum = 0u; cnt = 0u; mine = 0u;
#pragma unroll
        for (unsigned j = 0; j < 16; ++j) { const unsigned c = xb_ld(&bar[XB_XCNT(j)]); sum += c; cnt += (c > 0u) ? 1u : 0u; mine = (j == x) ? c : mine; }
        if (sum == G) break;
        __builtin_amdgcn_s_sleep(1);
        if ((++sp & 255u) == 0u) { if (xb_ld(&bar[XB_TMO])) break; if (sp > XB_SPIN_CAP) { atomicAdd(&bar[XB_TMO], 1u); break; } }
    }
    nloc = mine > 0u ? mine : 1u; nx = cnt > 0u ? cnt : 1u;
}
__device__ __forceinline__ void xcd_barrier(const XcdBarrier& b) {
    asm volatile("s_waitcnt vmcnt(0)" ::: "memory");
    __syncthreads();
    if (threadIdx.x == 0) {
        unsigned* bar = b.bar;
        __builtin_amdgcn_s_waitcnt(0);
        unsigned nloc = b.st[0], nx = b.st[1];
        if (nloc == 0u) { xcd_barrier_complete(bar, b.x, nloc, nx); b.st[0] = nloc; b.st[1] = nx; }
        const unsigned old = xb_add(&bar[XB_XSUB(b.x)], 1u);
        const unsigned gen = old / nloc;
        if (old + 1u == (gen + 1u) * nloc) {
            __builtin_amdgcn_fence(__ATOMIC_RELEASE, "agent");
            asm volatile("s_waitcnt vmcnt(0)" ::: "memory");
            const unsigned og = xb_add(&bar[XB_TOP], 1u);
            const unsigned tg = og / nx;
            if (og + 1u == (tg + 1u) * nx) xb_add(&bar[XB_TOPGEN], 1u);
            else XB_SPIN(xb_ld(&bar[XB_TOPGEN]) == tg, bar);
            __builtin_amdgcn_fence(__ATOMIC_ACQUIRE, "agent");
            xb_add(&bar[XB_XGEN(b.x)], 1u);
            asm volatile("s_waitcnt vmcnt(0)" ::: "memory");
        } else {
            XB_SPIN(xb_ld(&bar[XB_XGEN(b.x)]) == gen, bar);
            __builtin_amdgcn_fence(__ATOMIC_ACQUIRE, "agent");
            asm volatile("s_waitcnt vmcnt(0)" ::: "memory");
        }
    }
    __syncthreads();
}

struct Args { const float* in[21]; float* out; unsigned char* ws; int ph_lo, ph_hi; };
struct Frame {
    LAS unsigned char* lds; volatile LAS unsigned* MISC; gu32* ctl;
    int tid, lane, wave, vcu, G;
};

__device__ __forceinline__ void p0_transpose_item(const float* W, int K, int N, bf16_t* WT, int row_off, LAS float* scr, int item, int lane) {
    const int nblk = N / 32, kb = item / nblk, nb = item % nblk, k0 = 64 * kb, n0 = 32 * nb;
#pragma unroll 8
    for (int i = 0; i < 32; ++i) { const int kk = 2 * i + (lane >> 5); scr[kk * 33 + (lane & 31)] = W[(size_t)(k0 + kk) * N + n0 + (lane & 31)]; }
    LDS_WAIT(); asm volatile("" ::: "memory");
    const int c = lane & 7;
#pragma unroll
    for (int j = 0; j < 4; ++j) { const int n = (lane >> 3) + 8 * j; const LAS float* s = scr + (8 * c) * 33 + n;
        u32x4 o; o.x = pk2(s[0 * 33], s[1 * 33]); o.y = pk2(s[2 * 33], s[3 * 33]); o.z = pk2(s[4 * 33], s[5 * 33]); o.w = pk2(s[6 * 33], s[7 * 33]);
        *(GAS u32x4*)(WT + (size_t)(row_off + n0 + n) * K + k0 + 8 * c) = o; }
    LDS_WAIT(); asm volatile("" ::: "memory");
}
__device__ __forceinline__ void cvt_stream(const float* src, bf16_t* dst, size_t n4, size_t gtid, size_t nthr) {
    for (size_t i = gtid; i < n4; i += nthr) { const f32x4 v = ((const GAS f32x4*)src)[i]; u32x2 o; o.x = pk2(v[0], v[1]); o.y = pk2(v[2], v[3]); ((GAS u32x2*)dst)[i] = o; }
}

__device__ __forceinline__ void phase_prologue(Frame& F, const Args& a) {
    unsigned char* ws = a.ws;
    LAS float* scr = (LAS float*)(F.lds + F.wave * 16384);
    const int gw = F.vcu * NWAVES + F.wave, NGW = F.G * NWAVES;
    const size_t gtid = (size_t)gw * 64 + F.lane, nthr = (size_t)NGW * 64;
    constexpr int I_IN = 16 * (NPROJ / 32), I_SQ = 16 * 32, I_Q = 16 * 64, I_PP = 4 * 32;
    constexpr int NITEMS = I_IN + 3 * I_SQ + I_Q + I_PP;
    for (int it = gw; it < NITEMS; it += NGW) {
        int r = it;
        if (r < I_IN) { p0_transpose_item(a.in[4], 1024, NPROJ, (bf16_t*)(ws + WS_WIN), 0, scr, r, F.lane); continue; } r -= I_IN;
        if (r < I_SQ) { p0_transpose_item(a.in[7], 1024, 1024, (bf16_t*)(ws + WS_WA), 0, scr, r, F.lane); continue; } r -= I_SQ;
        if (r < I_SQ) { p0_transpose_item(a.in[10], 1024, 1024, (bf16_t*)(ws + WS_WOUT), 0, scr, r, F.lane); continue; } r -= I_SQ;
        if (r < I_SQ) { p0_transpose_item(a.in[17], 1024, 1024, (bf16_t*)(ws + WS_WPGQ), 0, scr, r, F.lane); continue; } r -= I_SQ;
        if (r < I_Q) { p0_transpose_item(a.in[13], 1024, 2048, (bf16_t*)(ws + WS_WPGQ), 1024, scr, r, F.lane); continue; } r -= I_Q;
        p0_transpose_item(a.in[18], 256, 1024, (bf16_t*)(ws + WS_WPP), 0, scr, r, F.lane);
    }
    { bf16_t* wp = (bf16_t*)(ws + WS_WPOOL); const float* pw = a.in[8];
      for (size_t i = gtid; i < 1024 * 256; i += nthr) { const int o = (int)(i >> 8), j = (int)(i & 255), g = o >> 8, gsrc = 2 * (g >> 1) + (j >> 7);
          const float v = (gsrc == g) ? pw[((size_t)g * 128 + (j & 127)) * 256 + (o & 255)] : 0.f; wp[i] = (bf16_t)f2bf(v); } }
    { float* oml = (float*)(ws + WS_OML); const float* lb = a.in[5]; for (size_t i = gtid; i < 1024; i += nthr) oml[i] = sigmoidf_(lb[1024 + i] - lb[i]); }
    cvt_stream(a.in[14], (bf16_t*)(ws + WS_SK), (size_t)16 * 128 * 128 / 4, gtid, nthr);
    cvt_stream(a.in[1], (bf16_t*)(ws + WS_PB), (size_t)T * 256 / 4, gtid, nthr);
    for (int row = gw; row < 2 * NEXP; row += NGW) {
        const bool isv = row >= NEXP; const int e = isv ? row - NEXP : row;
        const GAS f32x4* src = (const GAS f32x4*)((isv ? a.in[16] : a.in[15]) + (size_t)e * 1024) + F.lane * 4;
        f32x4 v[4]; float mx = 0.f;
#pragma unroll
        for (int j = 0; j < 4; ++j) { v[j] = src[j];
#pragma unroll
            for (int c = 0; c < 4; ++c) mx = fmaxf(mx, __builtin_fabsf(v[j][c])); }
#pragma unroll
        for (int o = 1; o < 64; o <<= 1) mx = fmaxf(mx, __shfl_xor(mx, o));
        const float sc = mx > 0.f ? mx * (1.0f / 127.0f) : 1.0f, inv = 1.0f / sc;
        u32x4 o4;
#pragma unroll
        for (int j = 0; j < 4; ++j) { unsigned wq = 0u;
#pragma unroll
            for (int c = 0; c < 4; ++c) { int qi = (int)__builtin_rintf(v[j][c] * inv); qi = qi > 127 ? 127 : (qi < -127 ? -127 : qi); wq |= (unsigned)((isv ? qi + 128 : qi) & 0xFF) << (8 * c); }
            o4[j] = wq; }
        *((GAS u32x4*)(ws + (isv ? WS_VT : WS_UT) + (size_t)e * 1024) + F.lane) = o4;
        if (F.lane == 0) ((float*)(ws + (isv ? WS_VS : WS_US)))[e] = sc;
    }
    { const float* x = a.in[0]; const float* g0 = a.in[2]; const float* b0 = a.in[3]; bf16_t* XN = (bf16_t*)(ws + WS_XN); float* st = (float*)(ws + WS_ST0);
      for (int m = gw; m < T; m += NGW) {
          const GAS f32x4* xr = (const GAS f32x4*)(x + (size_t)m * D) + F.lane;
          f32x4 v[4]; float s = 0.f;
#pragma unroll
          for (int j = 0; j < 4; ++j) { v[j] = xr[64 * j]; s += (v[j][0] + v[j][1]) + (v[j][2] + v[j][3]); }
          const float mean = wave_sum(s) * (1.f / D); float s2 = 0.f;
#pragma unroll
          for (int j = 0; j < 4; ++j) { v[j] = v[j] - mean; s2 += (v[j][0] * v[j][0] + v[j][1] * v[j][1]) + (v[j][2] * v[j][2] + v[j][3] * v[j][3]); }
          const float rstd = 1.f / sqrtf(wave_sum(s2) * (1.f / D) + LN_EPS);
          if (F.lane == 0) { st[2 * (size_t)m] = mean; st[2 * (size_t)m + 1] = rstd; }
          GAS u32x2* o8 = (GAS u32x2*)(XN + (size_t)m * D) + F.lane;
#pragma unroll
          for (int j = 0; j < 4; ++j) { const f32x4 gg = ((const GAS f32x4*)g0)[64 * j + F.lane], bb = ((const GAS f32x4*)b0)[64 * j + F.lane];
              const f32x4 h = v[j] * rstd * gg + bb; u32x2 o; o.x = pk2(h[0], h[1]); o.y = pk2(h[2], h[3]); o8[64 * j] = o; }
      } }
}

constexpr int HG_QD = 0, HG_KI = 8704, HG_KET = 17408, HG_VT = 25600, HG_DEC = 33792, HG_SEG = 34304, HG_PART = 38400;
__device__ __forceinline__ int hg_toff(int row, int slot) { return row * 64 + ((slot ^ ((row >> 1) & 7)) << 3); }
__device__ __forceinline__ float xrow16_sum(float x) {
    const auto s_ = __builtin_amdgcn_permlane16_swap(__builtin_bit_cast(unsigned, x), __builtin_bit_cast(unsigned, x), false, false);
    const unsigned s0 = s_[0], s1 = s_[1]; x = __builtin_bit_cast(float, s0) + __builtin_bit_cast(float, s1);
    const auto t_ = __builtin_amdgcn_permlane32_swap(__builtin_bit_cast(unsigned, x), __builtin_bit_cast(unsigned, x), false, false);
    const unsigned t0 = t_[0], t1 = t_[1]; return __builtin_bit_cast(float, t0) + __builtin_bit_cast(float, t1);
}
__device__ __forceinline__ bf16x8 mk_frag(unsigned a, unsigned b, unsigned c, unsigned d) { const u32x4 v = {a, b, c, d}; return __builtin_bit_cast(bf16x8, v); }
__device__ __forceinline__ bf16x8 ld_frag2(const LAS unsigned char* p0, const LAS unsigned char* p1) { const u32x2 a = *(const LAS u32x2*)p0, b = *(const LAS u32x2*)p1; return mk_frag(a.x, a.y, b.x, b.y); }
#define MFMA16(A_, B_, C_) __builtin_amdgcn_mfma_f32_16x16x32_bf16((A_), (B_), (C_), 0, 0, 0)
#define HG_BAR() do { asm volatile("s_waitcnt lgkmcnt(0)" ::: "memory"); __builtin_amdgcn_s_barrier(); asm volatile("" ::: "memory"); } while (0)
constexpr int HG_SEGS = 4, HG_NCH = SEQ / 32 / HG_SEGS;
template <bool FULL>
__device__ __forceinline__ void hgrn_unit(Frame& F, const Args& a, int unit, int seg) {
    unsigned char* ws = a.ws;
    const bf16_t* Qs = (const bf16_t*)(ws + WS_QS); const bf16_t* Kk = (const bf16_t*)(ws + WS_KK); const bf16_t* Vi = (const bf16_t*)(ws + WS_VI); const bf16_t* SG = (const bf16_t*)(ws + WS_SG);
    bf16_t* OG = (bf16_t*)(ws + WS_OG); float* LST = (float*)(ws + WS_LST); float* DLG = (float*)(ws + WS_DLG);
    const int b = unit >> 3, h = unit & 7, lane = F.lane, w = F.wave, r = lane & 15, q = lane >> 4, cp = lane;
    LAS unsigned char* L = F.lds;
    const f32x4 ngv = *(const GAS f32x4*)(a.in[6] + 16 * w + 4 * q);
    f32x4 S[8];
#pragma unroll
    for (int t = 0; t < 8; ++t) S[t] = (f32x4){0.f, 0.f, 0.f, 0.f};
    if (FULL) {
        for (int j = 0; j < seg; ++j) { const float* Lj = LST + ((size_t)(unit * HG_SEGS + j) * 8 + w) * 2048; const float* Dj = DLG + (size_t)(unit * HG_SEGS + j) * 128;
#pragma unroll
            for (int t = 0; t < 8; ++t) { const f32x4 dl = *(const GAS f32x4*)(Dj + 16 * t + 4 * q);
#pragma unroll
                for (int i = 0; i < 4; ++i) S[t][i] = __expf(dl[i]) * S[t][i] + Lj[(t * 4 + i) * 64 + lane]; } }
    }
    f32x4 O[2]; O[0] = O[1] = (f32x4){0.f, 0.f, 0.f, 0.f};
    u32x2 sgc[2]; sgc[0] = sgc[1] = (u32x2){0u, 0u};
    float dlog[2] = {0.f, 0.f};
    unsigned rq[4], rk[4], rv[4];
    const size_t tb = (size_t)b * SEQ + (size_t)seg * HG_NCH * 32;
    {
        const size_t g0 = (tb + 4 * w) * 1024 + h * 128 + 2 * cp;
#pragma unroll
        for (int i = 0; i < 4; ++i) { rq[i] = FULL ? *(const GAS unsigned*)(Qs + g0 + (size_t)i * 1024) : 0u; rk[i] = *(const GAS unsigned*)(Kk + g0 + (size_t)i * 1024); rv[i] = *(const GAS unsigned*)(Vi + g0 + (size_t)i * 1024); }
    }
    for (int n = 0; n <= HG_NCH; ++n) {
        const bool live = n < HG_NCH;
        const size_t t0 = tb + (size_t)n * 32;
        float kv[4][2], qv[4][2], vv[4][2], cum[4][2];
        if (live) {
#pragma unroll
            for (int i = 0; i < 4; ++i) { kv[i][0] = bflo(rk[i]); kv[i][1] = bfhi(rk[i]); qv[i][0] = bflo(rq[i]); qv[i][1] = bfhi(rq[i]); vv[i][0] = bflo(rv[i]); vv[i][1] = bfhi(rv[i]); }
#pragma unroll
            for (int e = 0; e < 2; ++e) { float c_ = 0.f;
#pragma unroll
                for (int i = 0; i < 4; ++i) { c_ += __logf(1.0f - kv[i][e]); cum[i][e] = c_; } }
            *(LAS f32x2*)(L + HG_SEG + (w * 128 + 2 * cp) * 4) = (f32x2){cum[3][0], cum[3][1]};
            if (n + 1 < HG_NCH) {
                const size_t g0 = (t0 + 32 + 4 * w) * 1024 + h * 128 + 2 * cp;
#pragma unroll
                for (int i = 0; i < 4; ++i) { if (FULL) rq[i] = *(const GAS unsigned*)(Qs + g0 + (size_t)i * 1024); rk[i] = *(const GAS unsigned*)(Kk + g0 + (size_t)i * 1024); rv[i] = *(const GAS unsigned*)(Vi + g0 + (size_t)i * 1024); }
            }
        }
        HG_BAR();
        if (FULL && n > 0) {
            const size_t tp = t0 - 32;
#pragma unroll
            for (int ct = 0; ct < 2; ++ct) { float tot = 0.f;
#pragma unroll
                for (int ww = 0; ww < 8; ++ww) tot += *(const LAS float*)(L + HG_PART + (ww * 32 + 16 * ct + r) * 4);
                const float rstd = 1.0f / sqrtf(tot * (1.0f / 128.0f) + RMS_EPS);
                const f32x4 sg = {bflo(sgc[ct].x), bfhi(sgc[ct].x), bflo(sgc[ct].y), bfhi(sgc[ct].y)};
                const f32x4 o = O[ct] * rstd * ngv * sg;
                u32x2 pk; pk.x = cvt_pk_bf16(o[0], o[1]); pk.y = cvt_pk_bf16(o[2], o[3]);
                *(GAS u32x2*)(OG + (tp + 16 * ct + r) * 1024 + h * 128 + 16 * w + 4 * q) = pk; }
        }
        if (!live) break;
        if (FULL) {
#pragma unroll
            for (int ct = 0; ct < 2; ++ct) sgc[ct] = *(const GAS u32x2*)(SG + (t0 + 16 * ct + r) * 1024 + h * 128 + 16 * w + 4 * q);
        }
        {
            float pre[2] = {0.f, 0.f}, tot[2] = {0.f, 0.f};
#pragma unroll
            for (int s_ = 0; s_ < 8; ++s_) { const f32x2 v = *(const LAS f32x2*)(L + HG_SEG + (s_ * 128 + 2 * cp) * 4); tot[0] += v.x; tot[1] += v.y; if (s_ < w) { pre[0] += v.x; pre[1] += v.y; } }
            dlog[0] += tot[0]; dlog[1] += tot[1];
            float dec[2] = {__expf(tot[0]), __expf(tot[1])};
            if (w == 0) *(LAS f32x2*)(L + HG_DEC + 2 * cp * 4) = (f32x2){dec[0], dec[1]};
            float ke[4][2];
#pragma unroll
            for (int i = 0; i < 4; ++i) { float qd[2], ki[2];
#pragma unroll
                for (int e = 0; e < 2; ++e) { const float eb = __expf(pre[e] + cum[i][e]), ieb = __builtin_amdgcn_rcpf(eb); qd[e] = qv[i][e] * eb; ki[e] = kv[i][e] * ieb; ke[i][e] = ki[e] * dec[e]; }
                if (FULL) { *(LAS unsigned*)(L + HG_QD + (4 * w + i) * 272 + 4 * cp) = cvt_pk_bf16(qd[0], qd[1]);
                            *(LAS unsigned*)(L + HG_KI + (4 * w + i) * 272 + 4 * cp) = cvt_pk_bf16(ki[0], ki[1]); } }
#pragma unroll
            for (int e = 0; e < 2; ++e) { const int row = 2 * cp + e;
                *(LAS u32x2*)(L + HG_KET + hg_toff(row, w)) = (u32x2){cvt_pk_bf16(ke[0][e], ke[1][e]), cvt_pk_bf16(ke[2][e], ke[3][e])};
                *(LAS u32x2*)(L + HG_VT + hg_toff(row, w)) = (u32x2){cvt_pk_bf16(vv[0][e], vv[1][e]), cvt_pk_bf16(vv[2][e], vv[3][e])}; }
        }
        HG_BAR();
        {
            const int vrow = 16 * w + r;
            if (FULL) {
                f32x4 X00 = {0.f, 0.f, 0.f, 0.f}, X01 = X00, X11 = X00;
#pragma unroll
                for (int kk = 0; kk < 4; ++kk) {
                    const bf16x8 ka0 = *(const LAS bf16x8*)(L + HG_KI + r * 272 + 64 * kk + 16 * q), ka1 = *(const LAS bf16x8*)(L + HG_KI + (16 + r) * 272 + 64 * kk + 16 * q);
                    const bf16x8 qb0 = *(const LAS bf16x8*)(L + HG_QD + r * 272 + 64 * kk + 16 * q), qb1 = *(const LAS bf16x8*)(L + HG_QD + (16 + r) * 272 + 64 * kk + 16 * q);
                    X00 = MFMA16(ka0, qb0, X00); X01 = MFMA16(ka0, qb1, X01); X11 = MFMA16(ka1, qb1, X11);
                }
#pragma unroll
                for (int i = 0; i < 4; ++i) { const bool keep = (4 * q + i) <= r; X00[i] = keep ? X00[i] : 0.f; X11[i] = keep ? X11[i] : 0.f; }
                const bf16x8 xb0 = mk_frag(cvt_pk_bf16(X00[0], X00[1]), cvt_pk_bf16(X00[2], X00[3]), 0u, 0u);
                const bf16x8 xb1 = mk_frag(cvt_pk_bf16(X01[0], X01[1]), cvt_pk_bf16(X01[2], X01[3]), cvt_pk_bf16(X11[0], X11[1]), cvt_pk_bf16(X11[2], X11[3]));
                const bf16x8 va = ld_frag2(L + HG_VT + hg_toff(vrow, q), L + HG_VT + hg_toff(vrow, 4 + q));
                O[0] = MFMA16(va, xb0, ((f32x4){0.f, 0.f, 0.f, 0.f})); O[1] = MFMA16(va, xb1, ((f32x4){0.f, 0.f, 0.f, 0.f}));
#pragma unroll
                for (int kk = 0; kk < 4; ++kk) {
                    const bf16x8 sa = mk_frag(cvt_pk_bf16(S[2 * kk][0], S[2 * kk][1]), cvt_pk_bf16(S[2 * kk][2], S[2 * kk][3]), cvt_pk_bf16(S[2 * kk + 1][0], S[2 * kk + 1][1]), cvt_pk_bf16(S[2 * kk + 1][2], S[2 * kk + 1][3]));
                    const bf16x8 qb0 = ld_frag2(L + HG_QD + r * 272 + 64 * kk + 8 * q, L + HG_QD + r * 272 + 64 * kk + 32 + 8 * q);
                    const bf16x8 qb1 = ld_frag2(L + HG_QD + (16 + r) * 272 + 64 * kk + 8 * q, L + HG_QD + (16 + r) * 272 + 64 * kk + 32 + 8 * q);
                    O[0] = MFMA16(sa, qb0, O[0]); O[1] = MFMA16(sa, qb1, O[1]);
                }
            }
            const bf16x8 vb = ld_frag2(L + HG_VT + hg_toff(vrow, 2 * q), L + HG_VT + hg_toff(vrow, 2 * q + 1));
#pragma unroll
            for (int t = 0; t < 8; ++t) {
                const f32x4 dc = *(const LAS f32x4*)(L + HG_DEC + (16 * t + 4 * q) * 4);
                const int krow = 16 * t + r;
                const bf16x8 ka = ld_frag2(L + HG_KET + hg_toff(krow, 2 * q), L + HG_KET + hg_toff(krow, 2 * q + 1));
                S[t] = MFMA16(ka, vb, S[t] * dc);
            }
            if (FULL) {
#pragma unroll
                for (int ct = 0; ct < 2; ++ct) { const float ss = xrow16_sum((O[ct][0] * O[ct][0] + O[ct][1] * O[ct][1]) + (O[ct][2] * O[ct][2] + O[ct][3] * O[ct][3]));
                    if (q == 0) *(LAS float*)(L + HG_PART + (w * 32 + 16 * ct + r) * 4) = ss; }
            }
        }
    }
    if (!FULL) {
        float* Lj = LST + ((size_t)(unit * HG_SEGS + seg) * 8 + w) * 2048;
#pragma unroll
        for (int t = 0; t < 8; ++t)
#pragma unroll
            for (int i = 0; i < 4; ++i) Lj[(t * 4 + i) * 64 + lane] = S[t][i];
        if (w == 0) *(GAS f32x2*)(DLG + (size_t)(unit * HG_SEGS + seg) * 128 + 2 * cp) = (f32x2){dlog[0], dlog[1]};
    }
    __syncthreads();
}
template <int W>
__device__ __forceinline__ void pool_item(const bf16_t* VP, bf16_t* PL, int t, int c8) {
    const int pos = t & (SEQ - 1), cnt = (pos + 1 < W) ? pos + 1 : W;
    u32x4 raw[W];
#pragma unroll
    for (int j = 0; j < W; ++j) raw[j] = *(const GAS u32x4*)(VP + (size_t)(t - (j < cnt ? j : 0)) * 512 + c8);
    f32x4 s0 = {0.f, 0.f, 0.f, 0.f}, s1 = s0, c0, c1;
#pragma unroll
    for (int j = 0; j < W; ++j) { f32x4 a0, a1; pg8::unpack8(raw[j], a0, a1); if (j == 0) { c0 = a0; c1 = a1; } if (j < cnt) { s0 += a0; s1 += a1; } }
    const float inv = 1.0f / (float)cnt;
    *(GAS u32x4*)(PL + (size_t)t * 512 + c8) = pg8::pack8(s0 * inv - c0, s1 * inv - c1);
}
__device__ __forceinline__ void pool_prep(Frame& F, const Args& a, size_t gtid, size_t nthr) {
    const bf16_t* VP = (const bf16_t*)(a.ws + WS_VP); bf16_t* PL = (bf16_t*)(a.ws + WS_PL);
    for (size_t item = gtid; item < (size_t)T * 16; item += nthr) {
        const int t = (int)(item >> 4), c = (int)(item & 15) * 8;
        pool_item<2>(VP, PL, t, c); pool_item<4>(VP, PL, t, 128 + c); pool_item<8>(VP, PL, t, 256 + c); pool_item<16>(VP, PL, t, 384 + c);
    }
}

__device__ __forceinline__ void phase_ln1(Frame& F, const Args& a) {
    float* R1 = a.out; bf16_t* H1b = (bf16_t*)(a.ws + WS_H1B); const float* g1 = a.in[11]; const float* b1 = a.in[12];
    const int gw = F.vcu * NWAVES + F.wave, NGW = F.G * NWAVES;
    for (int m = gw; m < T; m += NGW) {
        GAS f32x4* xr = (GAS f32x4*)(R1 + (size_t)m * D) + F.lane;
        f32x4 v[4]; float s = 0.f;
#pragma unroll
        for (int j = 0; j < 4; ++j) { v[j] = xr[64 * j]; s += (v[j][0] + v[j][1]) + (v[j][2] + v[j][3]); }
        const float mean = wave_sum(s) * (1.f / D); float s2 = 0.f;
#pragma unroll
        for (int j = 0; j < 4; ++j) { v[j] = v[j] - mean; s2 += (v[j][0] * v[j][0] + v[j][1] * v[j][1]) + (v[j][2] * v[j][2] + v[j][3] * v[j][3]); }
        const float rstd = 1.f / sqrtf(wave_sum(s2) * (1.f / D) + LN_EPS);
        GAS u32x2* o8 = (GAS u32x2*)(H1b + (size_t)m * D) + F.lane;
#pragma unroll
        for (int j = 0; j < 4; ++j) { const f32x4 gg = ((const GAS f32x4*)g1)[64 * j + F.lane], bb = ((const GAS f32x4*)b1)[64 * j + F.lane];
            const f32x4 h = v[j] * rstd * gg + bb; xr[64 * j] = h; u32x2 o; o.x = pk2(h[0], h[1]); o.y = pk2(h[2], h[3]); o8[64 * j] = o; }
    }
}

typedef float f32x16 __attribute__((ext_vector_type(16)));
__device__ __forceinline__ int ordi(float f) { const int b = __builtin_bit_cast(int, f); return b ^ ((b >> 31) & 0x7fffffff); }
__device__ __forceinline__ float unordi(int k) { const int b = k ^ ((k >> 31) & 0x7fffffff); return __builtin_bit_cast(float, b); }
__device__ __forceinline__ int imax_(int a, int b) { return a > b ? a : b; }
__device__ __forceinline__ int imin_(int a, int b) { return a < b ? a : b; }
__device__ __forceinline__ void tk_insert(int (&a)[16], int x) {
#pragma unroll
    for (int s_ = 0; s_ < 16; ++s_) { const int t = imax_(a[s_], x); x = imin_(a[s_], x); a[s_] = t; }
}
__device__ __forceinline__ void tk_bitonic_merge(int (&c)[16]) {
#pragma unroll
    for (int d = 8; d >= 1; d >>= 1)
#pragma unroll
        for (int s_ = 0; s_ < 16; ++s_) if ((s_ & d) == 0) { const int hi = imax_(c[s_], c[s_ + d]), lo = imin_(c[s_], c[s_ + d]); c[s_] = hi; c[s_ + d] = lo; }
}
__device__ __forceinline__ void tk_pair_merge(int (&a)[16]) {
    int pb[16];
#pragma unroll
    for (int s_ = 0; s_ < 16; ++s_) pb[s_] = __shfl_xor(a[s_], 32);
#pragma unroll
    for (int s_ = 0; s_ < 16; ++s_) a[s_] = imax_(a[s_], pb[15 - s_]);
    tk_bitonic_merge(a);
}
__device__ __forceinline__ int tk_lookup(unsigned long long lo, unsigned long long hi, int a) {
    const unsigned long long sel = (a & 8) ? hi : lo;
    return (int)((sel >> ((a & 7) * 8)) & 0xFFull);
}
__device__ __forceinline__ void phase_topk(Frame& F, const Args& a) {
    const bf16_t* SK = (const bf16_t*)(a.ws + WS_SK); const bf16_t* QRY = (const bf16_t*)(a.ws + WS_QRY);
    int* IDX = (int*)(a.ws + WS_IDX); float* GATE = (float*)(a.ws + WS_GATE); float* USG = (float*)(a.ws + WS_USG);
    const GAS float* USr = (const GAS float*)(a.ws + WS_US); const GAS float* VSr = (const GAS float*)(a.ws + WS_VS);
    const int gw = F.vcu * NWAVES + F.wave, NGW = F.G * NWAVES, lane = F.lane, r = lane & 31, hh = lane >> 5;
    constexpr int IMIN = (int)0x80000000;
    for (int task = gw; task < (T / 32) * 2; task += NGW) {
        const int tile = task >> 1, hg = task & 1; const size_t token = (size_t)tile * 32 + r;
#pragma unroll 1
        for (int hi = 0; hi < 4; ++hi) {
            const int h = hg * 4 + hi;
            int L[2][16];
#pragma unroll
            for (int p = 0; p < 2; ++p) {
                bf16x8 qf[8], af[8];
                const bf16_t* qp = QRY + token * 2048 + h * 256 + p * 128 + hh * 8;
#pragma unroll
                for (int ks = 0; ks < 8; ++ks) qf[ks] = *(const GAS bf16x8*)(qp + ks * 16);
                const bf16_t* skp = SK + ((size_t)(h * 2 + p) * 128 + r) * 128 + hh * 8;
#pragma unroll
                for (int ks = 0; ks < 8; ++ks) af[ks] = *(const GAS bf16x8*)(skp + ks * 16);
                int lst[16];
#pragma unroll
                for (int s_ = 0; s_ < 16; ++s_) lst[s_] = IMIN;
#pragma unroll 1
                for (int mt = 0; mt < 4; ++mt) {
                    f32x16 acc;
#pragma unroll
                    for (int i = 0; i < 16; ++i) acc[i] = 0.f;
#pragma unroll
                    for (int ks = 0; ks < 8; ++ks) acc = __builtin_amdgcn_mfma_f32_32x32x16_bf16(af[ks], qf[ks], acc, 0, 0, 0);
                    const int mtn = (mt < 3) ? mt + 1 : 3;
#pragma unroll
                    for (int ks = 0; ks < 8; ++ks) af[ks] = *(const GAS bf16x8*)(skp + (size_t)mtn * 32 * 128 + ks * 16);
                    const int sub = 32 * mt + 4 * hh;
#pragma unroll
                    for (int i = 0; i < 16; ++i) { const int base = 127 - ((i & 3) + 8 * (i >> 2)); const float sc = acc[i]; const int key = ((ordi(sc) & ~0x7F) | base) - sub; tk_insert(lst, key); }
                }
                tk_pair_merge(lst);
#pragma unroll
                for (int s_ = 0; s_ < 16; ++s_) L[p][s_] = lst[s_];
            }
            float fx[16], fy[16];
#pragma unroll
            for (int s_ = 0; s_ < 16; ++s_) { const int X = hh ? L[1][s_] : L[0][s_], Y = hh ? L[0][s_] : L[1][s_]; fx[s_] = unordi(X); fy[s_] = unordi(Y); }
            int cl[16];
#pragma unroll
            for (int s_ = 0; s_ < 16; ++s_) cl[s_] = IMIN;
#pragma unroll
            for (int ap = 0; ap < 4; ++ap)
#pragma unroll
                for (int bp = ap; bp < 16; ++bp) if ((ap + 1) * (bp + 1) <= 16) {
                    const float sum = fx[ap] + fy[bp];
                    const int pos = hh ? (bp * 16 + ap) : (ap * 16 + bp);
                    int key = (ordi(sum) & ~0xFF) | (255 - pos);
                    if (ap == bp) key = hh ? IMIN : key;
                    tk_insert(cl, key);
                }
            tk_pair_merge(cl);
            unsigned long long aLo = 0ull, aHi = 0ull, bLo = 0ull, bHi = 0ull;
#pragma unroll
            for (int j = 0; j < 8; ++j) { aLo |= (unsigned long long)(unsigned)(127 - (L[0][j] & 0x7F)) << (8 * j); aHi |= (unsigned long long)(unsigned)(127 - (L[0][8 + j] & 0x7F)) << (8 * j);
                bLo |= (unsigned long long)(unsigned)(127 - (L[1][j] & 0x7F)) << (8 * j); bHi |= (unsigned long long)(unsigned)(127 - (L[1][8 + j] & 0x7F)) << (8 * j); }
            int ex[16]; float ev[16]; float esum = 0.f; const float vmax = unordi(cl[0]);
#pragma unroll
            for (int s_ = 0; s_ < 16; ++s_) { const int pos = 255 - (cl[s_] & 0xFF); ex[s_] = tk_lookup(aLo, aHi, pos >> 4) * 128 + tk_lookup(bLo, bHi, pos & 15);
                ev[s_] = __expf(unordi(cl[s_]) - vmax); esum += ev[s_]; }
            const float inv = 1.0f / esum;
            if (hh == 0) { GAS u32x4* ip = (GAS u32x4*)(IDX + token * 128 + h * 16); GAS f32x4* up = (GAS f32x4*)(USG + token * 128 + h * 16);
#pragma unroll
                for (int w = 0; w < 4; ++w) { ip[w] = (u32x4){(unsigned)ex[4 * w], (unsigned)ex[4 * w + 1], (unsigned)ex[4 * w + 2], (unsigned)ex[4 * w + 3]};
                    up[w] = (f32x4){USr[ex[4 * w]], USr[ex[4 * w + 1]], USr[ex[4 * w + 2]], USr[ex[4 * w + 3]]}; } }
            else { GAS f32x4* gp = (GAS f32x4*)(GATE + token * 128 + h * 16);
#pragma unroll
                for (int w = 0; w < 4; ++w) gp[w] = (f32x4){ev[4 * w] * inv * VSr[ex[4 * w]], ev[4 * w + 1] * inv * VSr[ex[4 * w + 1]], ev[4 * w + 2] * inv * VSr[ex[4 * w + 2]], ev[4 * w + 3] * inv * VSr[ex[4 * w + 3]]}; }
        }
    }
}

__device__ __forceinline__ float dot2bf(unsigned a, unsigned b, float acc) { return __builtin_amdgcn_fdot2_f32_bf16(__builtin_bit_cast(bf16x2_t, a), __builtin_bit_cast(bf16x2_t, b), acc, false); }
template <int CTRL> __device__ __forceinline__ float dppf(float x) { return __builtin_bit_cast(float, __builtin_amdgcn_mov_dpp(__builtin_bit_cast(int, x), CTRL, 0xf, 0xf, true)); }
__device__ __forceinline__ float gelu1(float v) {
    const float av = __builtin_fabsf(v), t = __builtin_amdgcn_rcpf(av * 0.2316418882f + 1.0f);
    float q = t * 0.5307027145f + (-0.7265760135f); q = q * t + 0.7107068705f; q = q * t + (-0.142248368f); q = q * t + 0.127414796f; q = q * t;
    const float e = __builtin_amdgcn_exp2f((v * v) * (-0.72134752044f));
    const float m = v * (q * e);
    return v < 0.f ? m : v - m;
}
struct GStage { u32x4 u[2], v[2]; };
__device__ __forceinline__ void phase_gather(Frame& F, const Args& a, float* OUTP) {
    const unsigned char* UQ = a.ws + WS_UT; const unsigned char* VQ = a.ws + WS_VT; const bf16_t* PLE = (const bf16_t*)(a.ws + WS_PP);
    const int* IDX = (const int*)(a.ws + WS_IDX); const float* GATE = (const float*)(a.ws + WS_GATE); const float* USG = (const float*)(a.ws + WS_USG);
    const float* H = a.out; const float* g2 = a.in[19]; const float* b2 = a.in[20];
    const int gw = F.vcu * NWAVES + F.wave, NGW = F.G * NWAVES, lane = F.lane;
    for (int t = gw; t < T; t += NGW) {
        const int id0 = IDX[(size_t)t * 128 + lane], id1 = IDX[(size_t)t * 128 + 64 + lane];
        const float gt0 = GATE[(size_t)t * 128 + lane], gt1 = GATE[(size_t)t * 128 + 64 + lane];
        const float us0 = USG[(size_t)t * 128 + lane], us1 = USG[(size_t)t * 128 + 64 + lane];
        const GAS f32x4* hp = (const GAS f32x4*)(H + (size_t)t * D) + lane * 4;
        f32x4 hv[4]; float mx = 0.f;
#pragma unroll
        for (int i = 0; i < 4; ++i) { hv[i] = hp[i];
#pragma unroll
            for (int c = 0; c < 4; ++c) mx = fmaxf(mx, __builtin_fabsf(hv[i][c])); }
#pragma unroll
        for (int o = 1; o < 64; o <<= 1) mx = fmaxf(mx, __shfl_xor(mx, o));
        const float sh = mx > 0.f ? mx * (1.0f / 127.0f) : 1.0f, ish = 1.0f / sh;
        int hq[4];
#pragma unroll
        for (int i = 0; i < 4; ++i) { unsigned wq = 0u;
#pragma unroll
            for (int c = 0; c < 4; ++c) { const int qi = (int)__builtin_rintf(hv[i][c] * ish); wq |= (unsigned)(qi & 0xFF) << (8 * c); }
            hq[i] = (int)wq; }
        float acc[16]; float csum = 0.f;
#pragma unroll
        for (int i = 0; i < 16; ++i) acc[i] = 0.f;
        GStage st[4];
#define G_LOAD(S_, idv, kk) do { _Pragma("unroll") for (int j_ = 0; j_ < 2; ++j_) { const int e_ = __builtin_amdgcn_readlane(idv, (kk) + j_); \
            st[S_].u[j_] = *((const GAS u32x4*)(UQ + (size_t)e_ * 1024) + lane); st[S_].v[j_] = *((const GAS u32x4*)(VQ + (size_t)e_ * 1024) + lane); } } while (0)
#define G_COMP(S_, gtv, usv, kk) do { float d_[2]; _Pragma("unroll") for (int j_ = 0; j_ < 2; ++j_) { int x_ = 0; \
            _Pragma("unroll") for (int c_ = 0; c_ < 4; ++c_) x_ = __builtin_amdgcn_sdot4((int)st[S_].u[j_][c_], hq[c_], x_, false); d_[j_] = (float)x_; } \
            const auto sw_ = __builtin_amdgcn_permlane32_swap(__builtin_bit_cast(unsigned, d_[0]), __builtin_bit_cast(unsigned, d_[1]), false, false); \
            const unsigned sw0_ = sw_[0], sw1_ = sw_[1]; float x_ = __builtin_bit_cast(float, sw0_) + __builtin_bit_cast(float, sw1_); \
            const auto s16_ = __builtin_amdgcn_permlane16_swap(__builtin_bit_cast(unsigned, x_), __builtin_bit_cast(unsigned, x_), false, false); \
            const unsigned s160_ = s16_[0], s161_ = s16_[1]; x_ = __builtin_bit_cast(float, s160_) + __builtin_bit_cast(float, s161_); \
            x_ += dppf<0x128>(x_); x_ += dppf<0x141>(x_); x_ += dppf<0x4E>(x_); x_ += dppf<0xB1>(x_); \
            const float g0_ = __builtin_bit_cast(float, __builtin_amdgcn_readlane(__builtin_bit_cast(int, gtv), (kk))), g1_ = __builtin_bit_cast(float, __builtin_amdgcn_readlane(__builtin_bit_cast(int, gtv), (kk) + 1)); \
            const float u0_ = __builtin_bit_cast(float, __builtin_amdgcn_readlane(__builtin_bit_cast(int, usv), (kk))), u1_ = __builtin_bit_cast(float, __builtin_amdgcn_readlane(__builtin_bit_cast(int, usv), (kk) + 1)); \
            const float act_ = gelu1(x_ * sh * (lane < 32 ? u0_ : u1_)) * (lane < 32 ? g0_ : g1_); \
            const float a0_ = __builtin_bit_cast(float, __builtin_amdgcn_readlane(__builtin_bit_cast(int, act_), 0)), a1_ = __builtin_bit_cast(float, __builtin_amdgcn_readlane(__builtin_bit_cast(int, act_), 32)); \
            csum += a0_ + a1_; \
            _Pragma("unroll") for (int c_ = 0; c_ < 4; ++c_) { const unsigned w0_ = st[S_].v[0][c_], w1_ = st[S_].v[1][c_]; \
                acc[4 * c_ + 0] += a0_ * (float)(w0_ & 0xFFu); acc[4 * c_ + 1] += a0_ * (float)((w0_ >> 8) & 0xFFu); acc[4 * c_ + 2] += a0_ * (float)((w0_ >> 16) & 0xFFu); acc[4 * c_ + 3] += a0_ * (float)(w0_ >> 24); \
                acc[4 * c_ + 0] += a1_ * (float)(w1_ & 0xFFu); acc[4 * c_ + 1] += a1_ * (float)((w1_ >> 8) & 0xFFu); acc[4 * c_ + 2] += a1_ * (float)((w1_ >> 16) & 0xFFu); acc[4 * c_ + 3] += a1_ * (float)(w1_ >> 24); } } while (0)
#pragma unroll
        for (int hh = 0; hh < 2; ++hh) {
            const int idv = hh ? id1 : id0; const float gtv = hh ? gt1 : gt0, usv = hh ? us1 : us0;
            G_LOAD(0, idv, 0); G_LOAD(1, idv, 2); G_LOAD(2, idv, 4);
            for (int k = 0; k < 64; k += 8) {
                G_LOAD(3, idv, k + 6); G_COMP(0, gtv, usv, k);
                if (k + 8 < 64) G_LOAD(0, idv, k + 8);
                G_COMP(1, gtv, usv, k + 2);
                if (k + 8 < 64) G_LOAD(1, idv, k + 10);
                G_COMP(2, gtv, usv, k + 4);
                if (k + 8 < 64) G_LOAD(2, idv, k + 12);
                G_COMP(3, gtv, usv, k + 6);
            }
        }
#undef G_LOAD
#undef G_COMP
        const GAS u32x4* pp = (const GAS u32x4*)(PLE + (size_t)t * D) + lane * 2;
        const u32x4 pa = pp[0], pb = pp[1];
        f32x4 p[4]; pg8::unpack8(pa, p[0], p[1]); pg8::unpack8(pb, p[2], p[3]);
        const float off = 128.0f * csum;
        f32x4 r[4];
#pragma unroll
        for (int i = 0; i < 4; ++i) r[i] = hv[i] * ALPHA + ((f32x4){acc[4 * i], acc[4 * i + 1], acc[4 * i + 2], acc[4 * i + 3]} - off) + p[i];
        float s = 0.f;
#pragma unroll
        for (int i = 0; i < 4; ++i) s += (r[i][0] + r[i][1]) + (r[i][2] + r[i][3]);
        const float mean = wave_sum(s) * (1.f / D); float s2 = 0.f;
#pragma unroll
        for (int i = 0; i < 4; ++i) { r[i] = r[i] - mean; s2 += (r[i][0] * r[i][0] + r[i][1] * r[i][1]) + (r[i][2] * r[i][2] + r[i][3] * r[i][3]); }
        const float rstd = 1.f / sqrtf(wave_sum(s2) * (1.f / D) + LN_EPS);
        const GAS f32x4* gp = (const GAS f32x4*)g2 + lane * 4; const GAS f32x4* bp = (const GAS f32x4*)b2 + lane * 4;
        GAS f32x4* op = (GAS f32x4*)(OUTP + (size_t)t * D) + lane * 4;
#pragma unroll
        for (int i = 0; i < 4; ++i) op[i] = r[i] * rstd * gp[i] + bp[i];
    }
}

constexpr int NPHASE = 9;
__global__ void __launch_bounds__(NWAVES * 64, 2) mk_fwd(Args args) {
    extern __shared__ __attribute__((aligned(16))) unsigned char lds[];
    Frame F;
    F.lds = (LAS unsigned char*)lds;
    F.MISC = (volatile LAS unsigned*)(F.lds + MISC_OFF);
    F.tid = threadIdx.x; F.lane = F.tid & 63; F.wave = __builtin_amdgcn_readfirstlane(F.tid >> 6);
    F.G = gridDim.x; { const int bx = blockIdx.x; F.vcu = (F.G % 8 == 0) ? (bx % 8) * (F.G / 8) + bx / 8 : bx; }
    unsigned char* ws = args.ws;
    F.ctl = (gu32*)(ws + WS_CTL);
    for (int u = F.tid; u < (LDS_BYTES - LDSCTL_OFF) / 4; u += NWAVES * 64) ((LAS unsigned*)(F.lds + LDSCTL_OFF))[u] = 0u;
    __syncthreads();
    const int lo = args.ph_lo, hi = args.ph_hi;
    const bool one = (hi - lo) > 1;
    XcdBarrier bar; bar.bar = (unsigned*)(F.ctl + CW_BAR); bar.x = 0; bar.st = nullptr;
    if (one) bar = xcd_barrier_post((unsigned*)(F.ctl + CW_BAR), F.MISC + 8);
#ifndef PH_MASK
#define PH_MASK 0xFFFF
#endif
#define IN(k) (((PH_MASK >> (k)) & 1) && lo <= (k) && (k) < hi)
#define SEAM(k) do { if (IN(k) && IN((k) + 1)) xcd_barrier(bar); } while (0)
#ifndef REP_MASK
#define REP_MASK 0
#define REP_N 1
#endif
#define REPS(k) for (int rep_ = (((REP_MASK >> (k)) & 1) ? REP_N : 1); rep_ > 0; --rep_)
    bf16_t* const GA = (bf16_t*)args.out; bf16_t* const GB = (bf16_t*)args.out + (size_t)T * 1024;

    if (IN(0)) REPS(0) { phase_prologue(F, args); SEAM(0); }
    if (IN(1)) REPS(1) {
        pg8::Gemm g{(const bf16_t*)(ws + WS_XN), (const bf16_t*)(ws + WS_WIN), T, NPROJ, 1024, 1024, 1024, 0, 0};
        pg8::StaticOrder S; S.init(T, NPROJ, F.G, (int)blockIdx.x);
        pg8::EpiProj E{(bf16_t*)(ws + WS_QS), (bf16_t*)(ws + WS_KK), (bf16_t*)(ws + WS_VI), (bf16_t*)(ws + WS_SG), (bf16_t*)(ws + WS_VP), GA, GB, (const float*)(ws + WS_OML)};
        pg8::gemm_phase<pg8::EpiProj>(F.lds, g, S, E);
        SEAM(1);
    }
    if (IN(2)) REPS(2) {
        for (int u = blockIdx.x; u < 256; u += F.G) { const int unit = u >> 2, seg = u & 3;
            if (seg < 3) hgrn_unit<false>(F, args, unit, seg); }
        { const int np = F.G >> 2; if ((blockIdx.x & 3) == 3 && np > 0) pool_prep(F, args, (size_t)(blockIdx.x >> 2) * 512 + F.tid, (size_t)np * 512); }
        xcd_barrier(bar);
        for (int u = blockIdx.x; u < 256; u += F.G) hgrn_unit<true>(F, args, u >> 2, u & 3);
        SEAM(2);
    }
    if (IN(3)) REPS(3) {
        { pg8::Gemm g{(const bf16_t*)(ws + WS_PL), (const bf16_t*)(ws + WS_WPOOL), T, 1024, 256, 512, 256, 1, 256};
          pg8::StaticOrder S; S.init(T, 1024, F.G, (int)blockIdx.x);
          pg8::EpiYB E{(bf16_t*)(ws + WS_YB), GB, args.in[9]};
          pg8::gemm_phase<pg8::EpiYB>(F.lds, g, S, E); }
        { pg8::Gemm g{(const bf16_t*)(ws + WS_OG), (const bf16_t*)(ws + WS_WA), T, 1024, 1024, 1024, 1024, 0, 0};
          pg8::StaticOrder S; S.init(T, 1024, F.G, (int)blockIdx.x);
          pg8::EpiMix E{(bf16_t*)(ws + WS_MIX), GA, (const bf16_t*)(ws + WS_YB)};
          pg8::gemm_phase<pg8::EpiMix>(F.lds, g, S, E); }
        { pg8::Gemm g{(const bf16_t*)(ws + WS_PB), (const bf16_t*)(ws + WS_WPP), T, 1024, 256, 256, 256, 0, 0};
          pg8::StaticOrder S; S.init(T, 1024, F.G, (int)blockIdx.x);
          pg8::EpiPlain E{(bf16_t*)(ws + WS_PP), 1024};
          pg8::gemm_phase<pg8::EpiPlain>(F.lds, g, S, E); }
        SEAM(3);
    }
    if (IN(4)) REPS(4) {
        pg8::Gemm g{(const bf16_t*)(ws + WS_MIX), (const bf16_t*)(ws + WS_WOUT), T, 1024, 1024, 1024, 1024, 0, 0};
        pg8::StaticOrder S; S.init(T, 1024, F.G, (int)blockIdx.x);
        pg8::EpiR1 E{args.out, args.in[0], (const float*)(ws + WS_ST0), args.in[2], args.in[3]};
        pg8::gemm_phase<pg8::EpiR1>(F.lds, g, S, E);
        SEAM(4);
    }
    if (IN(5)) { phase_ln1(F, args); SEAM(5); }
    if (IN(6)) {
        pg8::Gemm g{(const bf16_t*)(ws + WS_H1B), (const bf16_t*)(ws + WS_WPGQ), T, 3072, 1024, 1024, 1024, 0, 0};
        pg8::StaticOrder S; S.init(T, 3072, F.G, (int)blockIdx.x);
        pg8::EpiPgq E{(bf16_t*)(ws + WS_PP), (bf16_t*)(ws + WS_QRY)};
        pg8::gemm_phase<pg8::EpiPgq>(F.lds, g, S, E);
        SEAM(6);
    }
    if (IN(7)) REPS(7) { phase_topk(F, args); SEAM(7); }
    if (IN(8)) REPS(8) { phase_gather(F, args, rep_ > 1 ? (float*)(ws + WS_QS) : args.out); if (rep_ > 1) xcd_barrier(bar); }
#undef IN
#undef SEAM
}

extern "C" void kernel_launch(void* const* d_in, const int* in_sizes, int n_in, void* d_out, int out_size, void* d_ws, size_t ws_size, hipStream_t stream) {
    static int grid = 0;
    if (grid == 0) {
        if (n_in != 21 || out_size != T * D || ws_size < WS_END) { fprintf(stderr, "kernel_launch: unexpected shapes (n_in %d, out %d, ws %zu)\n", n_in, out_size, ws_size); grid = -1; return; }
        int dev = 0, cus = 0, per_cu = 0;
        if (hipGetDevice(&dev) != hipSuccess || hipDeviceGetAttribute(&cus, hipDeviceAttributeMultiprocessorCount, dev) != hipSuccess) { grid = -1; return; }
        if (hipFuncSetAttribute((const void*)mk_fwd, hipFuncAttributeMaxDynamicSharedMemorySize, LDS_BYTES) != hipSuccess) { fprintf(stderr, "kernel_launch: hipFuncSetAttribute failed\n"); grid = -1; return; }
        if (hipOccupancyMaxActiveBlocksPerMultiprocessor(&per_cu, (const void*)mk_fwd, NWAVES * 64, LDS_BYTES) != hipSuccess || per_cu < 1)
            fprintf(stderr, "kernel_launch: occupancy query reports %d\n", per_cu);
        (void)hipGetLastError();
        grid = cus;
    }
    if (grid < 0) return;
    (void)hipMemsetAsync((char*)d_ws + WS_CTL, 0, CTL_ZERO_BYTES, stream);
    Args a{};
    for (int i = 0; i < 21; ++i) a.in[i] = (const float*)d_in[i];
    a.out = (float*)d_out; a.ws = (unsigned char*)d_ws;
#if MK_ONE_LAUNCH
    a.ph_lo = 0; a.ph_hi = NPHASE;
    hipLaunchKernelGGL(mk_fwd, dim3(grid), dim3(NWAVES * 64), LDS_BYTES, stream, a);
#else
    for (int p = 0; p < NPHASE; ++p) { a.ph_lo = p; a.ph_hi = p + 1; hipLaunchKernelGGL(mk_fwd, dim3(grid), dim3(NWAVES * 64), LDS_BYTES, stream, a); }
#endif
}
```

```cpp
#include <hip/hip_runtime.h>
#include <cstdio>
#include <cstdint>

#ifndef MK_ONE_LAUNCH
#define MK_ONE_LAUNCH 1
#endif

#define LAS __attribute__((address_space(3)))
#define GAS __attribute__((address_space(1)))
typedef unsigned short bf16_t;
typedef short bf16x8 __attribute__((ext_vector_type(8)));
typedef float f32x4 __attribute__((ext_vector_type(4)));
typedef float f32x2 __attribute__((ext_vector_type(2)));
typedef unsigned u32x4 __attribute__((ext_vector_type(4)));
typedef unsigned u32x2 __attribute__((ext_vector_type(2)));

constexpr int BATCH = 8, SEQ = 4096, T = BATCH * SEQ, D = 1024;
constexpr int NPROJ = 6656;
constexpr int NEXP = 16384;
constexpr float ALPHA = 1.189207115002721f;
constexpr float LN_EPS = 1e-5f, RMS_EPS = 1e-6f;
constexpr int NWAVES = 8;

constexpr size_t MiB = 1u << 20;
constexpr size_t WS_CTL = 0, CTL_ZERO_BYTES = 1 * MiB;
constexpr size_t WS_OML = 1 * MiB;
constexpr size_t WS_ST0 = 1 * MiB + 65536;
constexpr size_t WS_WIN = 2 * MiB;
constexpr size_t WS_WA = 15 * MiB;
constexpr size_t WS_WOUT = 17 * MiB;
constexpr size_t WS_WPGQ = 19 * MiB;
constexpr size_t WS_WPP = 25 * MiB;
constexpr size_t WS_WPOOL = 25 * MiB + 512 * 1024;
constexpr size_t WS_SK = 26 * MiB;
constexpr size_t WS_PB = 27 * MiB;
constexpr size_t WS_UT = 43 * MiB;
constexpr size_t WS_VT = 59 * MiB;
constexpr size_t WS_US = 75 * MiB, WS_VS = 75 * MiB + 65536;
constexpr size_t WS_LST = 76 * MiB, WS_DLG = 92 * MiB;
constexpr size_t WS_XN = 108 * MiB;
constexpr size_t WS_QS = 172 * MiB, WS_KK = 236 * MiB, WS_VI = 300 * MiB, WS_SG = 364 * MiB;
constexpr size_t WS_VP = 428 * MiB, WS_PL = 460 * MiB;
constexpr size_t WS_END = 492 * MiB;
constexpr size_t WS_OG = WS_XN, WS_YB = WS_QS, WS_MIX = WS_KK, WS_PP = WS_VI, WS_H1B = WS_SG, WS_QRY = WS_QS;
constexpr size_t WS_IDX = WS_VP, WS_GATE = WS_VP + 16 * MiB;
constexpr size_t WS_USG = WS_PL;

constexpr int RING_BYTES = 131072;
constexpr int LDSCTL_OFF = RING_BYTES, MISC_OFF = LDSCTL_OFF + 320;
constexpr int LDS_BYTES = 147456;

__device__ __forceinline__ unsigned f2bf(float f) { unsigned u = __builtin_bit_cast(unsigned, f); return (u + 0x7fffu + ((u >> 16) & 1u)) >> 16; }
__device__ __forceinline__ unsigned pk2(float lo, float hi) { return f2bf(lo) | (f2bf(hi) << 16); }
__device__ __forceinline__ float bflo(unsigned w) { return __builtin_bit_cast(float, w << 16); }
__device__ __forceinline__ float bfhi(unsigned w) { return __builtin_bit_cast(float, w & 0xffff0000u); }
typedef __bf16 bf16x2_t __attribute__((ext_vector_type(2)));
__device__ __forceinline__ unsigned cvt_pk_bf16(float lo, float hi) { bf16x2_t v; v[0] = (__bf16)lo; v[1] = (__bf16)hi; return __builtin_bit_cast(unsigned, v); }
__device__ __forceinline__ float sigmoidf_(float x) { return __builtin_amdgcn_rcpf(1.0f + __expf(-x)); }
__device__ __forceinline__ float wave_sum(float v) {
#pragma unroll
    for (int o = 1; o < 64; o <<= 1) v += __shfl_xor(v, o);
    return v;
}
#define LDS_WAIT() asm volatile("s_waitcnt lgkmcnt(0)" ::: "memory")
#define VM_WAIT() asm volatile("s_waitcnt vmcnt(0)" ::: "memory")

namespace pg8 {
constexpr int BM = 256, BK = 64, HALF = 128, HTB = HALF * BK * 2, STAGE_BYTES = 8 * HTB, NXCD = 8, WGM = 8;
__host__ __device__ __forceinline__ int lds_byte(int r, int c) { const int st = (r >> 4) * 2 + (c >> 5), rr = r & 15, cc = c & 31, ob = rr * 64 + cc * 2; return st * 1024 + (ob ^ (((ob >> 9) & 1) << 5)); }
__host__ __device__ __forceinline__ void stage_rc(int b, int& R, int& C) { const int st = b / 1024, sb = b % 1024, swz = sb ^ (((sb >> 9) & 1) << 5); R = (st >> 1) * 16 + swz / 64; C = (st & 1) * 32 + (swz % 64) / 2; }
__host__ __device__ __forceinline__ int perm32(int rho) { const int n = rho >> 4, i = rho & 15; return 8 * (i >> 2) + 4 * n + (i & 3); }

struct Unit { int pm, pn; };
struct Gemm { const bf16_t* A; const bf16_t* Bt; int M, N, K, lda, ldb, acol_shift, acol_mul; };

struct StaticOrder {
    int nM, nN, nwg, G, c;
    __host__ __device__ void init(int M, int N, int G_, int c_) { nM = M / BM; nN = N / BM; nwg = nM * nN; G = G_; c = c_; }
    __host__ __device__ bool next(int i, Unit& u) const {
        const long L = (long)i * G + c; if (L >= nwg) return false;
        int wgid = (int)L; { const int q = nwg / NXCD, r = nwg % NXCD, xcd = wgid % NXCD, off = wgid / NXCD; wgid = (xcd < r ? xcd * (q + 1) : r * (q + 1) + (xcd - r) * q) + off; }
        const int nig = WGM * nN, gid = wgid / nig, fm = gid * WGM, gsz = (nM - fm) < WGM ? (nM - fm) : WGM;
        u.pm = fm + ((wgid % nig) % gsz); u.pn = (wgid % nig) / gsz; return true;
    }
};


template <class Epi>
__device__ __forceinline__ void gemm_phase(LAS unsigned char* lds, const Gemm g, const StaticOrder& S, const Epi& E) {
    const int tid = threadIdx.x, wid = __builtin_amdgcn_readfirstlane(tid >> 6), lane = tid & 63, wr = wid >> 2, wc = wid & 3, fr = lane & 15, fq = lane >> 4;
    int K_ = g.K; asm volatile("" : "+s"(K_));
    const int K = K_, nt = K / BK;
    unsigned voffA[2], voffB[2];
#pragma unroll
    for (int i = 0; i < 2; ++i) { int R, C; stage_rc(tid * 16 + i * 8192, R, C); const int Rb = Epi::PERM ? ((R & ~31) + perm32(R & 31)) : R;
        voffA[i] = (unsigned)(R * g.lda + C) * 2u; voffB[i] = (unsigned)(Rb * g.ldb + C) * 2u; }
    const size_t kstep = (size_t)(BK * 2);
    const size_t hstepA = (size_t)HALF * g.lda * 2, hstepB = (size_t)HALF * g.ldb * 2;
    const size_t tstepA = 2 * hstepA, tstepB = 2 * hstepB;
    const unsigned ldsw = (unsigned)wid * 1024u;
    const int aoff = lds_byte(wr * 64 + fr, fq * 8), boff = lds_byte(wc * 32 + fr, fq * 8);
#define PG8_SA(b, h) (((b) * 2 + (h)) * HTB)
#define PG8_SB(b, h) ((4 + (b) * 2 + (h)) * HTB)
#define PG8_STAGE(bufoff, gbase, voff) do { _Pragma("unroll") for (int _i = 0; _i < 2; ++_i) \
        __builtin_amdgcn_global_load_lds((const unsigned*)((const char*)(gbase) + (voff)[_i]), (LAS unsigned*)(lds + (bufoff) + ldsw + _i * 8192), 16, 0, 0); } while (0)
#define PG8_LDA(dst, b, h) do { _Pragma("unroll") for (int m = 0; m < 4; ++m) _Pragma("unroll") for (int k = 0; k < 2; ++k) dst[m][k] = *(const LAS bf16x8*)(lds + PG8_SA(b, h) + aoff + m * 2048 + k * 1024); } while (0)
#define PG8_LDB(dst, b, h) do { _Pragma("unroll") for (int n = 0; n < 2; ++n) _Pragma("unroll") for (int k = 0; k < 2; ++k) dst[n][k] = *(const LAS bf16x8*)(lds + PG8_SB(b, h) + boff + n * 2048 + k * 1024); } while (0)
#define PG8_MMA(ai, bj, At, Bt) do { __builtin_amdgcn_s_setprio(1); _Pragma("unroll") for (int m = 0; m < 4; ++m) _Pragma("unroll") for (int n = 0; n < 2; ++n) _Pragma("unroll") for (int k = 0; k < 2; ++k) \
        acc[ai][bj][m][n] = __builtin_amdgcn_mfma_f32_16x16x32_bf16(Bt[n][k], At[m][k], acc[ai][bj][m][n], 0, 0, 0); __builtin_amdgcn_s_setprio(0); } while (0)
#define PG8_WAIT_V(n) asm volatile("s_waitcnt vmcnt(" #n ")" ::: "memory")
#define PG8_WAIT_L(n) asm volatile("s_waitcnt lgkmcnt(" #n ")" ::: "memory")
#define PG8_BAR __builtin_amdgcn_s_barrier()
#define PG8_SCHED __builtin_amdgcn_sched_barrier(0)
    Unit cur, nxt; int ui = 0;
    if (!S.next(0, cur)) return;
    f32x4 acc[2][2][4][2];
#pragma unroll
    for (int a = 0; a < 2; ++a)
#pragma unroll
        for (int b = 0; b < 2; ++b)
#pragma unroll
            for (int m = 0; m < 4; ++m)
#pragma unroll
                for (int n = 0; n < 2; ++n) acc[a][b][m][n] = (f32x4){0.f, 0.f, 0.f, 0.f};
    bf16x8 At[4][2], B0[2][2], B1[2][2];
    const char* cA = (const char*)g.A + (size_t)cur.pm * tstepA + (size_t)((cur.pn >> g.acol_shift) * g.acol_mul) * 2; const char* cB = (const char*)g.Bt + (size_t)cur.pn * tstepB;
    PG8_STAGE(PG8_SB(0, 0), cB, voffB); PG8_STAGE(PG8_SB(0, 1), cB + hstepB, voffB); PG8_STAGE(PG8_SA(0, 0), cA, voffA); PG8_STAGE(PG8_SA(0, 1), cA + hstepA, voffA);
    if (wr == 1) PG8_BAR;
    PG8_WAIT_V(2); PG8_BAR;
    PG8_STAGE(PG8_SB(1, 0), cB + kstep, voffB); PG8_STAGE(PG8_SA(1, 0), cA + kstep, voffA); PG8_STAGE(PG8_SB(1, 1), cB + hstepB + kstep, voffB);
    PG8_WAIT_V(6); PG8_BAR;
    for (;;) {
        const bool has_next = S.next(ui + 1, nxt);
        const char* nA = has_next ? (const char*)g.A + (size_t)nxt.pm * tstepA + (size_t)((nxt.pn >> g.acol_shift) * g.acol_mul) * 2 : cA;
        const char* nB = has_next ? (const char*)g.Bt + (size_t)nxt.pn * tstepB : cB;
        for (int t = 0; t < nt; t += 2) {
            const bool last = (t == nt - 2);
            const char* a1 = cA + (size_t)(t + 1) * kstep;
            const char* a2 = last ? nA : cA + (size_t)(t + 2) * kstep; const char* b2 = last ? nB : cB + (size_t)(t + 2) * kstep;
            const char* a3 = a2 + kstep; const char* b3 = b2 + kstep;
            PG8_LDB(B0, 0, 0); PG8_LDB(B1, 0, 1); PG8_SCHED; PG8_LDA(At, 0, 0); PG8_STAGE(PG8_SA(1, 1), a1 + hstepA, voffA);
            PG8_WAIT_V(8); PG8_WAIT_L(0); PG8_BAR; PG8_MMA(0, 0, At, B0); PG8_MMA(0, 1, At, B1); PG8_BAR; PG8_SCHED;
            PG8_LDA(At, 0, 1); PG8_STAGE(PG8_SB(0, 0), b2, voffB); PG8_STAGE(PG8_SB(0, 1), b2 + hstepB, voffB); PG8_STAGE(PG8_SA(0, 0), a2, voffA);
            PG8_WAIT_V(8); PG8_WAIT_L(0); PG8_BAR; PG8_MMA(1, 0, At, B0); PG8_MMA(1, 1, At, B1); PG8_BAR; PG8_SCHED;
            PG8_LDB(B0, 1, 0); PG8_LDB(B1, 1, 1); PG8_SCHED; PG8_LDA(At, 1, 0); PG8_STAGE(PG8_SA(0, 1), a2 + hstepA, voffA);
            PG8_WAIT_V(8); PG8_WAIT_L(0); PG8_BAR; PG8_MMA(0, 0, At, B0); PG8_MMA(0, 1, At, B1); PG8_BAR; PG8_SCHED;
            PG8_LDA(At, 1, 1); PG8_STAGE(PG8_SB(1, 0), b3, voffB); PG8_STAGE(PG8_SB(1, 1), b3 + hstepB, voffB); PG8_STAGE(PG8_SA(1, 0), a3, voffA);
            PG8_WAIT_V(8); PG8_WAIT_L(0); PG8_BAR; PG8_MMA(1, 0, At, B0); PG8_MMA(1, 1, At, B1); PG8_BAR; PG8_SCHED;
        }
        if (wr == 0) PG8_BAR;
        E(acc, cur, wr, wc, fr, fq);
        if (!has_next) break;
#pragma unroll
        for (int a = 0; a < 2; ++a)
#pragma unroll
            for (int b = 0; b < 2; ++b)
#pragma unroll
                for (int m = 0; m < 4; ++m)
#pragma unroll
                    for (int n = 0; n < 2; ++n) acc[a][b][m][n] = (f32x4){0.f, 0.f, 0.f, 0.f};
        cur = nxt; cA = nA; cB = nB; ++ui;
        if (wr == 1) PG8_BAR;
    }
    PG8_WAIT_V(0);
    PG8_BAR;
#undef PG8_SA
#undef PG8_SB
#undef PG8_STAGE
#undef PG8_LDA
#undef PG8_LDB
#undef PG8_MMA
#undef PG8_WAIT_V
#undef PG8_WAIT_L
#undef PG8_BAR
#undef PG8_SCHED
}

#define EPI_FENCE() asm volatile("" ::: "memory")
__device__ __forceinline__ u32x4 pack8(const f32x4& v0, const f32x4& v1) { u32x4 w; w.x = cvt_pk_bf16(v0[0], v0[1]); w.y = cvt_pk_bf16(v0[2], v0[3]); w.z = cvt_pk_bf16(v1[0], v1[1]); w.w = cvt_pk_bf16(v1[2], v1[3]); return w; }
__device__ __forceinline__ void unpack8(const u32x4& w, f32x4& v0, f32x4& v1) { v0 = (f32x4){bflo(w.x), bfhi(w.x), bflo(w.y), bfhi(w.y)}; v1 = (f32x4){bflo(w.z), bfhi(w.z), bflo(w.w), bfhi(w.w)}; }

struct EpiProj {
    static constexpr bool PERM = true;
    bf16_t *Qs, *Kk, *Vi, *SG, *VP, *GA, *GB; const float* oml;
    template <int MODE> __device__ __forceinline__ void body(const f32x4 (&acc)[2][2][4][2], bf16_t* base, int ldc, int row0, int col0) const {
        f32x4 om[2][2];
#pragma unroll
        for (int bj = 0; bj < 2; ++bj)
#pragma unroll
            for (int n = 0; n < 2; ++n) om[bj][n] = (MODE == 1) ? *(const f32x4*)(oml + col0 + bj * HALF + 4 * n) : (f32x4){1.f, 1.f, 1.f, 1.f};
#pragma unroll
        for (int ai = 0; ai < 2; ++ai)
#pragma unroll
            for (int m = 0; m < 4; ++m) { bf16_t* rowp = base + (size_t)(row0 + ai * HALF + m * 16) * ldc + col0;
#pragma unroll
                for (int bj = 0; bj < 2; ++bj) { f32x4 v[2] = {acc[ai][bj][m][0], acc[ai][bj][m][1]};
#pragma unroll
                    for (int n = 0; n < 2; ++n)
#pragma unroll
                        for (int e = 0; e < 4; ++e) { const float x = v[n][e]; float y;
                            if (MODE == 0) y = x * sigmoidf_(x) * 0.08838834764831845f;
                            else if (MODE == 1) y = om[bj][n][e] * sigmoidf_(-x);
                            else if (MODE == 2) y = x;
                            else if (MODE == 3) y = x * sigmoidf_(x);
                            else y = sigmoidf_(x);
                            v[n][e] = y; }
                    *(u32x4*)(rowp + bj * HALF) = pack8(v[0], v[1]); } }
    }
    __device__ __forceinline__ void operator()(const f32x4 (&acc)[2][2][4][2], const Unit& u, int wr, int wc, int fr, int fq) const {
        const int pn = u.pn, row0 = u.pm * BM + wr * 64 + fr, cw = wc * 32 + 8 * fq;
        if (pn < 4) body<0>(acc, Qs, 1024, row0, pn * 256 + cw);
        else if (pn < 8) body<1>(acc, Kk, 1024, row0, (pn - 4) * 256 + cw);
        else if (pn < 12) body<2>(acc, Vi, 1024, row0, (pn - 8) * 256 + cw);
        else if (pn < 16) body<3>(acc, SG, 1024, row0, (pn - 12) * 256 + cw);
        else if (pn < 18) body<2>(acc, VP, 512, row0, (pn - 16) * 256 + cw);
        else if (pn < 22) body<4>(acc, GA, 1024, row0, (pn - 18) * 256 + cw);
        else body<4>(acc, GB, 1024, row0, (pn - 22) * 256 + cw);
    }
};
struct EpiPlain {
    static constexpr bool PERM = true;
    bf16_t* O; int ldc;
    __device__ __forceinline__ void operator()(const f32x4 (&acc)[2][2][4][2], const Unit& u, int wr, int wc, int fr, int fq) const {
        const int row0 = u.pm * BM + wr * 64 + fr, col0 = u.pn * BM + wc * 32 + 8 * fq;
#pragma unroll
        for (int ai = 0; ai < 2; ++ai)
#pragma unroll
            for (int m = 0; m < 4; ++m) { bf16_t* rowp = O + (size_t)(row0 + ai * HALF + m * 16) * ldc + col0;
#pragma unroll
                for (int bj = 0; bj < 2; ++bj) *(u32x4*)(rowp + bj * HALF) = pack8(acc[ai][bj][m][0], acc[ai][bj][m][1]); }
    }
};
struct EpiYB {
    static constexpr bool PERM = true;
    bf16_t* YB; const bf16_t* GB; const float* scale;
    __device__ __forceinline__ void operator()(const f32x4 (&acc)[2][2][4][2], const Unit& u, int wr, int wc, int fr, int fq) const {
        const int row0 = u.pm * BM + wr * 64 + fr, col0 = u.pn * BM + wc * 32 + 8 * fq;
        f32x4 sc[2][2];
#pragma unroll
        for (int bj = 0; bj < 2; ++bj)
#pragma unroll
            for (int n = 0; n < 2; ++n) sc[bj][n] = *(const f32x4*)(scale + col0 + bj * HALF + 4 * n);
#pragma unroll
        for (int ai = 0; ai < 2; ++ai)
#pragma unroll
            for (int m = 0; m < 4; ++m) { const size_t off = (size_t)(row0 + ai * HALF + m * 16) * 1024 + col0;
#pragma unroll
                for (int bj = 0; bj < 2; ++bj) { const u32x4 gw = *(const u32x4*)(GB + off + bj * HALF); f32x4 g0, g1; unpack8(gw, g0, g1);
                    const f32x4 v0 = acc[ai][bj][m][0] * sc[bj][0] * g0, v1 = acc[ai][bj][m][1] * sc[bj][1] * g1;
                    *(u32x4*)(YB + off + bj * HALF) = pack8(v0, v1); }
                EPI_FENCE(); }
    }
};
struct EpiMix {
    static constexpr bool PERM = true;
    bf16_t* MIX; const bf16_t* GA; const bf16_t* YB;
    __device__ __forceinline__ void operator()(const f32x4 (&acc)[2][2][4][2], const Unit& u, int wr, int wc, int fr, int fq) const {
        const int row0 = u.pm * BM + wr * 64 + fr, col0 = u.pn * BM + wc * 32 + 8 * fq;
#pragma unroll
        for (int ai = 0; ai < 2; ++ai)
#pragma unroll
            for (int m = 0; m < 4; ++m) { const size_t off = (size_t)(row0 + ai * HALF + m * 16) * 1024 + col0;
#pragma unroll
                for (int bj = 0; bj < 2; ++bj) { const u32x4 gw = *(const u32x4*)(GA + off + bj * HALF), yw = *(const u32x4*)(YB + off + bj * HALF);
                    f32x4 g0, g1, y0, y1; unpack8(gw, g0, g1); unpack8(yw, y0, y1);
                    const f32x4 v0 = acc[ai][bj][m][0] * g0 + y0, v1 = acc[ai][bj][m][1] * g1 + y1;
                    *(u32x4*)(MIX + off + bj * HALF) = pack8(v0, v1); }
                EPI_FENCE(); }
    }
};
struct EpiR1 {
    static constexpr bool PERM = false;
    float* R1; const float* x; const float* st0; const float* g0; const float* b0;
    __device__ __forceinline__ void operator()(const f32x4 (&acc)[2][2][4][2], const Unit& u, int wr, int wc, int fr, int fq) const {
        const int row0 = u.pm * BM + wr * 64 + fr, col0 = u.pn * BM + wc * 32 + 4 * fq;
        f32x4 gg[2][2], bb[2][2];
#pragma unroll
        for (int bj = 0; bj < 2; ++bj)
#pragma unroll
            for (int n = 0; n < 2; ++n) { gg[bj][n] = *(const f32x4*)(g0 + col0 + bj * HALF + 16 * n); bb[bj][n] = *(const f32x4*)(b0 + col0 + bj * HALF + 16 * n); }
#pragma unroll
        for (int ai = 0; ai < 2; ++ai)
#pragma unroll
            for (int m = 0; m < 4; ++m) { const int r = row0 + ai * HALF + m * 16; const size_t off = (size_t)r * 1024 + col0; const f32x2 ms = *(const f32x2*)(st0 + 2 * (size_t)r);
#pragma unroll
                for (int bj = 0; bj < 2; ++bj)
#pragma unroll
                    for (int n = 0; n < 2; ++n) { const f32x4 xv = *(const f32x4*)(x + off + bj * HALF + 16 * n);
                        const f32x4 h = (xv - ms.x) * ms.y * gg[bj][n] + bb[bj][n];
                        *(f32x4*)(R1 + off + bj * HALF + 16 * n) = h * ALPHA + acc[ai][bj][m][n]; }
                EPI_FENCE(); }
    }
};
struct EpiPgq {
    static constexpr bool PERM = true;
    bf16_t* PP; bf16_t* QRY;
    __device__ __forceinline__ void operator()(const f32x4 (&acc)[2][2][4][2], const Unit& u, int wr, int wc, int fr, int fq) const {
        const int row0 = u.pm * BM + wr * 64 + fr;
        if (u.pn < 4) {
            const int col0 = u.pn * BM + wc * 32 + 8 * fq;
#pragma unroll
            for (int ai = 0; ai < 2; ++ai)
#pragma unroll
                for (int m = 0; m < 4; ++m) { const size_t off = (size_t)(row0 + ai * HALF + m * 16) * 1024 + col0;
#pragma unroll
                    for (int bj = 0; bj < 2; ++bj) { const u32x4 pw = *(const u32x4*)(PP + off + bj * HALF); f32x4 p0, p1; unpack8(pw, p0, p1); f32x4 v0, v1;
#pragma unroll
                        for (int e = 0; e < 4; ++e) { v0[e] = sigmoidf_(acc[ai][bj][m][0][e]) * p0[e]; v1[e] = sigmoidf_(acc[ai][bj][m][1][e]) * p1[e]; }
                        *(u32x4*)(PP + off + bj * HALF) = pack8(v0, v1); }
                    EPI_FENCE(); }
        } else {
            const int col0 = (u.pn - 4) * BM + wc * 32 + 8 * fq;
#pragma unroll
            for (int ai = 0; ai < 2; ++ai)
#pragma unroll
                for (int m = 0; m < 4; ++m) { bf16_t* rowp = QRY + (size_t)(row0 + ai * HALF + m * 16) * 2048 + col0;
#pragma unroll
                    for (int bj = 0; bj < 2; ++bj) *(u32x4*)(rowp + bj * HALF) = pack8(acc[ai][bj][m][0], acc[ai][bj][m][1]); }
        }
    }
};
}

typedef GAS unsigned gu32;
#define RLX_AGENT __ATOMIC_RELAXED, __HIP_MEMORY_SCOPE_AGENT
#define XB_TMO      128
#define XB_XCNT(j)  (256  + 64 * (j))
#define XB_XSUB(j)  (1280 + 64 * (j))
#define XB_XGEN(j)  (2304 + 64 * (j))
#define XB_TOP      3328
#define XB_TOPGEN   3392
#define XCD_BAR_WORDS 3456
#define XB_SPIN_CAP (1u << 22)
constexpr int CW_BAR = 4096;
__device__ __forceinline__ unsigned xb_ld(unsigned* p)              { return __hip_atomic_load(p, __ATOMIC_RELAXED, __HIP_MEMORY_SCOPE_AGENT); }
__device__ __forceinline__ unsigned xb_add(unsigned* p, unsigned v) { return __hip_atomic_fetch_add(p, v, __ATOMIC_RELAXED, __HIP_MEMORY_SCOPE_AGENT); }
__device__ __forceinline__ unsigned xb_xcc_id() { return (unsigned)__builtin_amdgcn_s_getreg((3 << 11) | 20) & 0xFu; }
#define XB_SPIN(cond, bar) do { unsigned _sp = 0; while (cond) { __builtin_amdgcn_s_sleep(1); \
    if ((++_sp & 255u) == 0u) { if (xb_ld(&(bar)[XB_TMO])) break; if (_sp > XB_SPIN_CAP) { atomicAdd(&(bar)[XB_TMO], 1u); break; } } } } while (0)
struct XcdBarrier { unsigned* bar; unsigned x; volatile LAS unsigned* st; };
__device__ __forceinline__ XcdBarrier xcd_barrier_post(unsigned* bar, volatile LAS unsigned* st) {
    XcdBarrier b; b.bar = bar; b.x = xb_xcc_id(); b.st = st;
    if (threadIdx.x == 0) (void)xb_add(&bar[XB_XCNT(b.x)], 1u);
    return b;
}
__device__ __forceinline__ void xcd_barrier_complete(unsigned* bar, unsigned x, unsigned& nloc, unsigned& nx) {
    const unsigned G = gridDim.x * gridDim.y * gridDim.z;
    unsigned sum, cnt, mine, sp = 0u;
    for (;;) {
        sum = 0u; cnt = 0u; mine = 0u;
#pragma unroll
        for (unsigned j = 0; j < 16; ++j) { const unsigned c = xb_ld(&bar[XB_XCNT(j)]); sum += c; cnt += (c > 0u) ? 1u : 0u; mine = (j == x) ? c : mine; }
        if (sum == G) break;
        __builtin_amdgcn_s_sleep(1);
        if ((++sp & 255u) == 0u) { if (xb_ld(&bar[XB_TMO])) break; if (sp > XB_SPIN_CAP) { atomicAdd(&bar[XB_TMO], 1u); break; } }
    }
    nloc = mine > 0u ? mine : 1u; nx = cnt > 0u ? cnt : 1u;
}
__device__ __forceinline__ void xcd_barrier(const XcdBarrier& b) {
    asm volatile("s_waitcnt vmcnt(0)" ::: "memory");
    __syncthreads();
    if (threadIdx.x == 0) {
        unsigned* bar = b.bar;
        __builtin_amdgcn_s_waitcnt(0);
        unsigned nloc = b.st[0], nx = b.st[1];
        if (nloc == 0u) { xcd_barrier_complete(bar, b.x, nloc, nx); b.st[0] = nloc; b.st[1] = nx; }
        const unsigned old = xb_add(&bar[XB_XSUB(b.x)], 1u);
        const unsigned gen = old / nloc;
        if (old + 1u == (gen + 1u) * nloc) {
            __builtin_amdgcn_fence(__ATOMIC_RELEASE, "agent");
            asm volatile("s_waitcnt vmcnt(0)" ::: "memory");
            const unsigned og = xb_add(&bar[XB_TOP], 1u);
            const unsigned tg = og / nx;
            if (og + 1u == (tg + 1u) * nx) xb_add(&bar[XB_TOPGEN], 1u);
            else XB_SPIN(xb_ld(&bar[XB_TOPGEN]) == tg, bar);
            __builtin_amdgcn_fence(__ATOMIC_ACQUIRE, "agent");
            xb_add(&bar[XB_XGEN(b.x)], 1u);
            asm volatile("s_waitcnt vmcnt(0)" ::: "memory");
        } else {
            XB_SPIN(xb_ld(&bar[XB_XGEN(b.x)]) == gen, bar);
            __builtin_amdgcn_fence(__ATOMIC_ACQUIRE, "agent");
            asm volatile("s_waitcnt vmcnt(0)" ::: "memory");
        }
    }
    __syncthreads();
}

struct Args { const float* in[21]; float* out; unsigned char* ws; int ph_lo, ph_hi; };
struct Frame {
    LAS unsigned char* lds; volatile LAS unsigned* MISC; gu32* ctl;
    int tid, lane, wave, vcu, G;
};

__device__ __forceinline__ void p0_transpose_item(const float* W, int K, int N, bf16_t* WT, int row_off, LAS float* scr, int item, int lane) {
    const int nblk = N / 32, kb = item / nblk, nb = item % nblk, k0 = 64 * kb, n0 = 32 * nb;
#pragma unroll 8
    for (int i = 0; i < 32; ++i) { const int kk = 2 * i + (lane >> 5); scr[kk * 33 + (lane & 31)] = W[(size_t)(k0 + kk) * N + n0 + (lane & 31)]; }
    LDS_WAIT(); asm volatile("" ::: "memory");
    const int c = lane & 7;
#pragma unroll
    for (int j = 0; j < 4; ++j) { const int n = (lane >> 3) + 8 * j; const LAS float* s = scr + (8 * c) * 33 + n;
        u32x4 o; o.x = pk2(s[0 * 33], s[1 * 33]); o.y = pk2(s[2 * 33], s[3 * 33]); o.z = pk2(s[4 * 33], s[5 * 33]); o.w = pk2(s[6 * 33], s[7 * 33]);
        *(GAS u32x4*)(WT + (size_t)(row_off + n0 + n) * K + k0 + 8 * c) = o; }
    LDS_WAIT(); asm volatile("" ::: "memory");
}
__device__ __forceinline__ void cvt_stream(const float* src, bf16_t* dst, size_t n4, size_t gtid, size_t nthr) {
    for (size_t i = gtid; i < n4; i += nthr) { const f32x4 v = ((const GAS f32x4*)src)[i]; u32x2 o; o.x = pk2(v[0], v[1]); o.y = pk2(v[2], v[3]); ((GAS u32x2*)dst)[i] = o; }
}

__device__ __forceinline__ void phase_prologue(Frame& F, const Args& a) {
    unsigned char* ws = a.ws;
    LAS float* scr = (LAS float*)(F.lds + F.wave * 16384);
    const int gw = F.vcu * NWAVES + F.wave, NGW = F.G * NWAVES;
    const size_t gtid = (size_t)gw * 64 + F.lane, nthr = (size_t)NGW * 64;
    constexpr int I_IN = 16 * (NPROJ / 32), I_SQ = 16 * 32, I_Q = 16 * 64, I_PP = 4 * 32;
    constexpr int NITEMS = I_IN + 3 * I_SQ + I_Q + I_PP;
    for (int it = gw; it < NITEMS; it += NGW) {
        int r = it;
        if (r < I_IN) { p0_transpose_item(a.in[4], 1024, NPROJ, (bf16_t*)(ws + WS_WIN), 0, scr, r, F.lane); continue; } r -= I_IN;
        if (r < I_SQ) { p0_transpose_item(a.in[7], 1024, 1024, (bf16_t*)(ws + WS_WA), 0, scr, r, F.lane); continue; } r -= I_SQ;
        if (r < I_SQ) { p0_transpose_item(a.in[10], 1024, 1024, (bf16_t*)(ws + WS_WOUT), 0, scr, r, F.lane); continue; } r -= I_SQ;
        if (r < I_SQ) { p0_transpose_item(a.in[17], 1024, 1024, (bf16_t*)(ws + WS_WPGQ), 0, scr, r, F.lane); continue; } r -= I_SQ;
        if (r < I_Q) { p0_transpose_item(a.in[13], 1024, 2048, (bf16_t*)(ws + WS_WPGQ), 1024, scr, r, F.lane); continue; } r -= I_Q;
        p0_transpose_item(a.in[18], 256, 1024, (bf16_t*)(ws + WS_WPP), 0, scr, r, F.lane);
    }
    { bf16_t* wp = (bf16_t*)(ws + WS_WPOOL); const float* pw = a.in[8];
      for (size_t i = gtid; i < 1024 * 256; i += nthr) { const int o = (int)(i >> 8), j = (int)(i & 255), g = o >> 8, gsrc = 2 * (g >> 1) + (j >> 7);
          const float v = (gsrc == g) ? pw[((size_t)g * 128 + (j & 127)) * 256 + (o & 255)] : 0.f; wp[i] = (bf16_t)f2bf(v); } }
    { float* oml = (float*)(ws + WS_OML); const float* lb = a.in[5]; for (size_t i = gtid; i < 1024; i += nthr) oml[i] = sigmoidf_(lb[1024 + i] - lb[i]); }
    cvt_stream(a.in[14], (bf16_t*)(ws + WS_SK), (size_t)16 * 128 * 128 / 4, gtid, nthr);
    cvt_stream(a.in[1], (bf16_t*)(ws + WS_PB), (size_t)T * 256 / 4, gtid, nthr);
    for (int row = gw; row < 2 * NEXP; row += NGW) {
        const bool isv = row >= NEXP; const int e = isv ? row - NEXP : row;
        const GAS f32x4* src = (const GAS f32x4*)((isv ? a.in[16] : a.in[15]) + (size_t)e * 1024) + F.lane * 4;
        f32x4 v[4]; float mx = 0.f;
#pragma unroll
        for (int j = 0; j < 4; ++j) { v[j] = src[j];
#pragma unroll
            for (int c = 0; c < 4; ++c) mx = fmaxf(mx, __builtin_fabsf(v[j][c])); }
#pragma unroll
        for (int o = 1; o < 64; o <<= 1) mx = fmaxf(mx, __shfl_xor(mx, o));
        const float sc = mx > 0.f ? mx * (1.0f / 127.0f) : 1.0f, inv = 1.0f / sc;
        u32x4 o4;
#pragma unroll
        for (int j = 0; j < 4; ++j) { unsigned wq = 0u;
#pragma unroll
            for (int c = 0; c < 4; ++c) { int qi = (int)__builtin_rintf(v[j][c] * inv); qi = qi > 127 ? 127 : (qi < -127 ? -127 : qi); wq |= (unsigned)((isv ? qi + 128 : qi) & 0xFF) << (8 * c); }
            o4[j] = wq; }
        *((GAS u32x4*)(ws + (isv ? WS_VT : WS_UT) + (size_t)e * 1024) + F.lane) = o4;
        if (F.lane == 0) ((float*)(ws + (isv ? WS_VS : WS_US)))[e] = sc;
    }
    { const float* x = a.in[0]; const float* g0 = a.in[2]; const float* b0 = a.in[3]; bf16_t* XN = (bf16_t*)(ws + WS_XN); float* st = (float*)(ws + WS_ST0);
      for (int m = gw; m < T; m += NGW) {
          const GAS f32x4* xr = (const GAS f32x4*)(x + (size_t)m * D) + F.lane;
          f32x4 v[4]; float s = 0.f;
#pragma unroll
          for (int j = 0; j < 4; ++j) { v[j] = xr[64 * j]; s += (v[j][0] + v[j][1]) + (v[j][2] + v[j][3]); }
          const float mean = wave_sum(s) * (1.f / D); float s2 = 0.f;
#pragma unroll
          for (int j = 0; j < 4; ++j) { v[j] = v[j] - mean; s2 += (v[j][0] * v[j][0] + v[j][1] * v[j][1]) + (v[j][2] * v[j][2] + v[j][3] * v[j][3]); }
          const float rstd = 1.f / sqrtf(wave_sum(s2) * (1.f / D) + LN_EPS);
          if (F.lane == 0) { st[2 * (size_t)m] = mean; st[2 * (size_t)m + 1] = rstd; }
          GAS u32x2* o8 = (GAS u32x2*)(XN + (size_t)m * D) + F.lane;
#pragma unroll
          for (int j = 0; j < 4; ++j) { const f32x4 gg = ((const GAS f32x4*)g0)[64 * j + F.lane], bb = ((const GAS f32x4*)b0)[64 * j + F.lane];
              const f32x4 h = v[j] * rstd * gg + bb; u32x2 o; o.x = pk2(h[0], h[1]); o.y = pk2(h[2], h[3]); o8[64 * j] = o; }
      } }
}

constexpr int HG_QD = 0, HG_KI = 8704, HG_KET = 17408, HG_VT = 25600, HG_DEC = 33792, HG_SEG = 34304, HG_PART = 38400;
__device__ __forceinline__ int hg_toff(int row, int slot) { return row * 64 + ((slot ^ ((row >> 1) & 7)) << 3); }
__device__ __forceinline__ float xrow16_sum(float x) {
    const auto s_ = __builtin_amdgcn_permlane16_swap(__builtin_bit_cast(unsigned, x), __builtin_bit_cast(unsigned, x), false, false);
    const unsigned s0 = s_[0], s1 = s_[1]; x = __builtin_bit_cast(float, s0) + __builtin_bit_cast(float, s1);
    const auto t_ = __builtin_amdgcn_permlane32_swap(__builtin_bit_cast(unsigned, x), __builtin_bit_cast(unsigned, x), false, false);
    const unsigned t0 = t_[0], t1 = t_[1]; return __builtin_bit_cast(float, t0) + __builtin_bit_cast(float, t1);
}
__device__ __forceinline__ bf16x8 mk_frag(unsigned a, unsigned b, unsigned c, unsigned d) { const u32x4 v = {a, b, c, d}; return __builtin_bit_cast(bf16x8, v); }
__device__ __forceinline__ bf16x8 ld_frag2(const LAS unsigned char* p0, const LAS unsigned char* p1) { const u32x2 a = *(const LAS u32x2*)p0, b = *(const LAS u32x2*)p1; return mk_frag(a.x, a.y, b.x, b.y); }
#define MFMA16(A_, B_, C_) __builtin_amdgcn_mfma_f32_16x16x32_bf16((A_), (B_), (C_), 0, 0, 0)
#define HG_BAR() do { asm volatile("s_waitcnt lgkmcnt(0)" ::: "memory"); __builtin_amdgcn_s_barrier(); asm volatile("" ::: "memory"); } while (0)
constexpr int HG_SEGS = 4, HG_NCH = SEQ / 32 / HG_SEGS;
template <bool FULL>
__device__ __forceinline__ void hgrn_unit(Frame& F, const Args& a, int unit, int seg) {
    unsigned char* ws = a.ws;
    const bf16_t* Qs = (const bf16_t*)(ws + WS_QS); const bf16_t* Kk = (const bf16_t*)(ws + WS_KK); const bf16_t* Vi = (const bf16_t*)(ws + WS_VI); const bf16_t* SG = (const bf16_t*)(ws + WS_SG);
    bf16_t* OG = (bf16_t*)(ws + WS_OG); float* LST = (float*)(ws + WS_LST); float* DLG = (float*)(ws + WS_DLG);
    const int b = unit >> 3, h = unit & 7, lane = F.lane, w = F.wave, r = lane & 15, q = lane >> 4, cp = lane;
    LAS unsigned char* L = F.lds;
    const f32x4 ngv = *(const GAS f32x4*)(a.in[6] + 16 * w + 4 * q);
    f32x4 S[8];
#pragma unroll
    for (int t = 0; t < 8; ++t) S[t] = (f32x4){0.f, 0.f, 0.f, 0.f};
    if (FULL) {
        for (int j = 0; j < seg; ++j) { const float* Lj = LST + ((size_t)(unit * HG_SEGS + j) * 8 + w) * 2048; const float* Dj = DLG + (size_t)(unit * HG_SEGS + j) * 128;
#pragma unroll
            for (int t = 0; t < 8; ++t) { const f32x4 dl = *(const GAS f32x4*)(Dj + 16 * t + 4 * q);
#pragma unroll
                for (int i = 0; i < 4; ++i) S[t][i] = __expf(dl[i]) * S[t][i] + Lj[(t * 4 + i) * 64 + lane]; } }
    }
    f32x4 O[2]; O[0] = O[1] = (f32x4){0.f, 0.f, 0.f, 0.f};
    u32x2 sgc[2]; sgc[0] = sgc[1] = (u32x2){0u, 0u};
    float dlog[2] = {0.f, 0.f};
    unsigned rq[4], rk[4], rv[4];
    const size_t tb = (size_t)b * SEQ + (size_t)seg * HG_NCH * 32;
    {
        const size_t g0 = (tb + 4 * w) * 1024 + h * 128 + 2 * cp;
#pragma unroll
        for (int i = 0; i < 4; ++i) { rq[i] = FULL ? *(const GAS unsigned*)(Qs + g0 + (size_t)i * 1024) : 0u; rk[i] = *(const GAS unsigned*)(Kk + g0 + (size_t)i * 1024); rv[i] = *(const GAS unsigned*)(Vi + g0 + (size_t)i * 1024); }
    }
    for (int n = 0; n <= HG_NCH; ++n) {
        const bool live = n < HG_NCH;
        const size_t t0 = tb + (size_t)n * 32;
        float kv[4][2], qv[4][2], vv[4][2], cum[4][2];
        if (live) {
#pragma unroll
            for (int i = 0; i < 4; ++i) { kv[i][0] = bflo(rk[i]); kv[i][1] = bfhi(rk[i]); qv[i][0] = bflo(rq[i]); qv[i][1] = bfhi(rq[i]); vv[i][0] = bflo(rv[i]); vv[i][1] = bfhi(rv[i]); }
#pragma unroll
            for (int e = 0; e < 2; ++e) { float c_ = 0.f;
#pragma unroll
                for (int i = 0; i < 4; ++i) { c_ += __logf(1.0f - kv[i][e]); cum[i][e] = c_; } }
            *(LAS f32x2*)(L + HG_SEG + (w * 128 + 2 * cp) * 4) = (f32x2){cum[3][0], cum[3][1]};
            if (n + 1 < HG_NCH) {
                const size_t g0 = (t0 + 32 + 4 * w) * 1024 + h * 128 + 2 * cp;
#pragma unroll
                for (int i = 0; i < 4; ++i) { if (FULL) rq[i] = *(const GAS unsigned*)(Qs + g0 + (size_t)i * 1024); rk[i] = *(const GAS unsigned*)(Kk + g0 + (size_t)i * 1024); rv[i] = *(const GAS unsigned*)(Vi + g0 + (size_t)i * 1024); }
            }
        }
        HG_BAR();
        if (FULL && n > 0) {
            const size_t tp = t0 - 32;
#pragma unroll
            for (int ct = 0; ct < 2; ++ct) { float tot = 0.f;
#pragma unroll
                for (int ww = 0; ww < 8; ++ww) tot += *(const LAS float*)(L + HG_PART + (ww * 32 + 16 * ct + r) * 4);
                const float rstd = 1.0f / sqrtf(tot * (1.0f / 128.0f) + RMS_EPS);
                const f32x4 sg = {bflo(sgc[ct].x), bfhi(sgc[ct].x), bflo(sgc[ct].y), bfhi(sgc[ct].y)};
                const f32x4 o = O[ct] * rstd * ngv * sg;
                u32x2 pk; pk.x = cvt_pk_bf16(o[0], o[1]); pk.y = cvt_pk_bf16(o[2], o[3]);
                *(GAS u32x2*)(OG + (tp + 16 * ct + r) * 1024 + h * 128 + 16 * w + 4 * q) = pk; }
        }
        if (!live) break;
        if (FULL) {
#pragma unroll
            for (int ct = 0; ct < 2; ++ct) sgc[ct] = *(const GAS u32x2*)(SG + (t0 + 16 * ct + r) * 1024 + h * 128 + 16 * w + 4 * q);
        }
        {
            float pre[2] = {0.f, 0.f}, tot[2] = {0.f, 0.f};
#pragma unroll
            for (int s_ = 0; s_ < 8; ++s_) { const f32x2 v = *(const LAS f32x2*)(L + HG_SEG + (s_ * 128 + 2 * cp) * 4); tot[0] += v.x; tot[1] += v.y; if (s_ < w) { pre[0] += v.x; pre[1] += v.y; } }
            dlog[0] += tot[0]; dlog[1] += tot[1];
            float dec[2] = {__expf(tot[0]), __expf(tot[1])};
            if (w == 0) *(LAS f32x2*)(L + HG_DEC + 2 * cp * 4) = (f32x2){dec[0], dec[1]};
            float ke[4][2];
#pragma unroll
            for (int i = 0; i < 4; ++i) { float qd[2], ki[2];
#pragma unroll
                for (int e = 0; e < 2; ++e) { const float eb = __expf(pre[e] + cum[i][e]), ieb = __builtin_amdgcn_rcpf(eb); qd[e] = qv[i][e] * eb; ki[e] = kv[i][e] * ieb; ke[i][e] = ki[e] * dec[e]; }
                if (FULL) { *(LAS unsigned*)(L + HG_QD + (4 * w + i) * 272 + 4 * cp) = cvt_pk_bf16(qd[0], qd[1]);
                            *(LAS unsigned*)(L + HG_KI + (4 * w + i) * 272 + 4 * cp) = cvt_pk_bf16(ki[0], ki[1]); } }
#pragma unroll
            for (int e = 0; e < 2; ++e) { const int row = 2 * cp + e;
                *(LAS u32x2*)(L + HG_KET + hg_toff(row, w)) = (u32x2){cvt_pk_bf16(ke[0][e], ke[1][e]), cvt_pk_bf16(ke[2][e], ke[3][e])};
                *(LAS u32x2*)(L + HG_VT + hg_toff(row, w)) = (u32x2){cvt_pk_bf16(vv[0][e], vv[1][e]), cvt_pk_bf16(vv[2][e], vv[3][e])}; }
        }
        HG_BAR();
        {
            const int vrow = 16 * w + r;
            if (FULL) {
                f32x4 X00 = {0.f, 0.f, 0.f, 0.f}, X01 = X00, X11 = X00;
#pragma unroll
                for (int kk = 0; kk < 4; ++kk) {
                    const bf16x8 ka0 = *(const LAS bf16x8*)(L + HG_KI + r * 272 + 64 * kk + 16 * q), ka1 = *(const LAS bf16x8*)(L + HG_KI + (16 + r) * 272 + 64 * kk + 16 * q);
                    const bf16x8 qb0 = *(const LAS bf16x8*)(L + HG_QD + r * 272 + 64 * kk + 16 * q), qb1 = *(const LAS bf16x8*)(L + HG_QD + (16 + r) * 272 + 64 * kk + 16 * q);
                    X00 = MFMA16(ka0, qb0, X00); X01 = MFMA16(ka0, qb1, X01); X11 = MFMA16(ka1, qb1, X11);
                }
#pragma unroll
                for (int i = 0; i < 4; ++i) { const bool keep = (4 * q + i) <= r; X00[i] = keep ? X00[i] : 0.f; X11[i] = keep ? X11[i] : 0.f; }
                const bf16x8 xb0 = mk_frag(cvt_pk_bf16(X00[0], X00[1]), cvt_pk_bf16(X00[2], X00[3]), 0u, 0u);
                const bf16x8 xb1 = mk_frag(cvt_pk_bf16(X01[0], X01[1]), cvt_pk_bf16(X01[2], X01[3]), cvt_pk_bf16(X11[0], X11[1]), cvt_pk_bf16(X11[2], X11[3]));
                const bf16x8 va = ld_frag2(L + HG_VT + hg_toff(vrow, q), L + HG_VT + hg_toff(vrow, 4 + q));
                O[0] = MFMA16(va, xb0, ((f32x4){0.f, 0.f, 0.f, 0.f})); O[1] = MFMA16(va, xb1, ((f32x4){0.f, 0.f, 0.f, 0.f}));
#pragma unroll
                for (int kk = 0; kk < 4; ++kk) {
                    const bf16x8 sa = mk_frag(cvt_pk_bf16(S[2 * kk][0], S[2 * kk][1]), cvt_pk_bf16(S[2 * kk][2], S[2 * kk][3]), cvt_pk_bf16(S[2 * kk + 1][0], S[2 * kk + 1][1]), cvt_pk_bf16(S[2 * kk + 1][2], S[2 * kk + 1][3]));
                    const bf16x8 qb0 = ld_frag2(L + HG_QD + r * 272 + 64 * kk + 8 * q, L + HG_QD + r * 272 + 64 * kk + 32 + 8 * q);
                    const bf16x8 qb1 = ld_frag2(L + HG_QD + (16 + r) * 272 + 64 * kk + 8 * q, L + HG_QD + (16 + r) * 272 + 64 * kk + 32 + 8 * q);
                    O[0] = MFMA16(sa, qb0, O[0]); O[1] = MFMA16(sa, qb1, O[1]);
                }
            }
            const bf16x8 vb = ld_frag2(L + HG_VT + hg_toff(vrow, 2 * q), L + HG_VT + hg_toff(vrow, 2 * q + 1));
#pragma unroll
            for (int t = 0; t < 8; ++t) {
                const f32x4 dc = *(const LAS f32x4*)(L + HG_DEC + (16 * t + 4 * q) * 4);
                const int krow = 16 * t + r;
                const bf16x8 ka = ld_frag2(L + HG_KET + hg_toff(krow, 2 * q), L + HG_KET + hg_toff(krow, 2 * q + 1));
                S[t] = MFMA16(ka, vb, S[t] * dc);
            }
            if (FULL) {
#pragma unroll
                for (int ct = 0; ct < 2; ++ct) { const float ss = xrow16_sum((O[ct][0] * O[ct][0] + O[ct][1] * O[ct][1]) + (O[ct][2] * O[ct][2] + O[ct][3] * O[ct][3]));
                    if (q == 0) *(LAS float*)(L + HG_PART + (w * 32 + 16 * ct + r) * 4) = ss; }
            }
        }
    }
    if (!FULL) {
        float* Lj = LST + ((size_t)(unit * HG_SEGS + seg) * 8 + w) * 2048;
#pragma unroll
        for (int t = 0; t < 8; ++t)
#pragma unroll
            for (int i = 0; i < 4; ++i) Lj[(t * 4 + i) * 64 + lane] = S[t][i];
        if (w == 0) *(GAS f32x2*)(DLG + (size_t)(unit * HG_SEGS + seg) * 128 + 2 * cp) = (f32x2){dlog[0], dlog[1]};
    }
    __syncthreads();
}
template <int W>
__device__ __forceinline__ void pool_item(const bf16_t* VP, bf16_t* PL, int t, int c8) {
    const int pos = t & (SEQ - 1), cnt = (pos + 1 < W) ? pos + 1 : W;
    u32x4 raw[W];
#pragma unroll
    for (int j = 0; j < W; ++j) raw[j] = *(const GAS u32x4*)(VP + (size_t)(t - (j < cnt ? j : 0)) * 512 + c8);
    f32x4 s0 = {0.f, 0.f, 0.f, 0.f}, s1 = s0, c0, c1;
#pragma unroll
    for (int j = 0; j < W; ++j) { f32x4 a0, a1; pg8::unpack8(raw[j], a0, a1); if (j == 0) { c0 = a0; c1 = a1; } if (j < cnt) { s0 += a0; s1 += a1; } }
    const float inv = 1.0f / (float)cnt;
    *(GAS u32x4*)(PL + (size_t)t * 512 + c8) = pg8::pack8(s0 * inv - c0, s1 * inv - c1);
}
__device__ __forceinline__ void pool_prep(Frame& F, const Args& a, size_t gtid, size_t nthr) {
    const bf16_t* VP = (const bf16_t*)(a.ws + WS_VP); bf16_t* PL = (bf16_t*)(a.ws + WS_PL);
    for (size_t item = gtid; item < (size_t)T * 16; item += nthr) {
        const int t = (int)(item >> 4), c = (int)(item & 15) * 8;
        pool_item<2>(VP, PL, t, c); pool_item<4>(VP, PL, t, 128 + c); pool_item<8>(VP, PL, t, 256 + c); pool_item<16>(VP, PL, t, 384 + c);
    }
}

__device__ __forceinline__ void phase_ln1(Frame& F, const Args& a) {
    float* R1 = a.out; bf16_t* H1b = (bf16_t*)(a.ws + WS_H1B); const float* g1 = a.in[11]; const float* b1 = a.in[12];
    const int gw = F.vcu * NWAVES + F.wave, NGW = F.G * NWAVES;
    for (int m = gw; m < T; m += NGW) {
        GAS f32x4* xr = (GAS f32x4*)(R1 + (size_t)m * D) + F.lane;
        f32x4 v[4]; float s = 0.f;
#pragma unroll
        for (int j = 0; j < 4; ++j) { v[j] = xr[64 * j]; s += (v[j][0] + v[j][1]) + (v[j][2] + v[j][3]); }
        const float mean = wave_sum(s) * (1.f / D); float s2 = 0.f;
#pragma unroll
        for (int j = 0; j < 4; ++j) { v[j] = v[j] - mean; s2 += (v[j][0] * v[j][0] + v[j][1] * v[j][1]) + (v[j][2] * v[j][2] + v[j][3] * v[j][3]); }
        const float rstd = 1.f / sqrtf(wave_sum(s2) * (1.f / D) + LN_EPS);
        GAS u32x2* o8 = (GAS u32x2*)(H1b + (size_t)m * D) + F.lane;
#pragma unroll
        for (int j = 0; j < 4; ++j) { const f32x4 gg = ((const GAS f32x4*)g1)[64 * j + F.lane], bb = ((const GAS f32x4*)b1)[64 * j + F.lane];
            const f32x4 h = v[j] * rstd * gg + bb; xr[64 * j] = h; u32x2 o; o.x = pk2(h[0], h[1]); o.y = pk2(h[2], h[3]); o8[64 * j] = o; }
    }
}

typedef float f32x16 __attribute__((ext_vector_type(16)));
__device__ __forceinline__ int ordi(float f) { const int b = __builtin_bit_cast(int, f); return b ^ ((b >> 31) & 0x7fffffff); }
__device__ __forceinline__ float unordi(int k) { const int b = k ^ ((k >> 31) & 0x7fffffff); return __builtin_bit_cast(float, b); }
__device__ __forceinline__ int imax_(int a, int b) { return a > b ? a : b; }
__device__ __forceinline__ int imin_(int a, int b) { return a < b ? a : b; }
__device__ __forceinline__ void tk_insert(int (&a)[16], int x) {
#pragma unroll
    for (int s_ = 0; s_ < 16; ++s_) { const int t = imax_(a[s_], x); x = imin_(a[s_], x); a[s_] = t; }
}
__device__ __forceinline__ void tk_bitonic_merge(int (&c)[16]) {
#pragma unroll
    for (int d = 8; d >= 1; d >>= 1)
#pragma unroll
        for (int s_ = 0; s_ < 16; ++s_) if ((s_ & d) == 0) { const int hi = imax_(c[s_], c[s_ + d]), lo = imin_(c[s_], c[s_ + d]); c[s_] = hi; c[s_ + d] = lo; }
}
__device__ __forceinline__ void tk_pair_merge(int (&a)[16]) {
    int pb[16];
#pragma unroll
    for (int s_ = 0; s_ < 16; ++s_) pb[s_] = __shfl_xor(a[s_], 32);
#pragma unroll
    for (int s_ = 0; s_ < 16; ++s_) a[s_] = imax_(a[s_], pb[15 - s_]);
    tk_bitonic_merge(a);
}
__device__ __forceinline__ int tk_lookup(unsigned long long lo, unsigned long long hi, int a) {
    const unsigned long long sel = (a & 8) ? hi : lo;
    return (int)((sel >> ((a & 7) * 8)) & 0xFFull);
}
__device__ __forceinline__ void phase_topk(Frame& F, const Args& a) {
    const bf16_t* SK = (const bf16_t*)(a.ws + WS_SK); const bf16_t* QRY = (const bf16_t*)(a.ws + WS_QRY);
    int* IDX = (int*)(a.ws + WS_IDX); float* GATE = (float*)(a.ws + WS_GATE); float* USG = (float*)(a.ws + WS_USG);
    const GAS float* USr = (const GAS float*)(a.ws + WS_US); const GAS float* VSr = (const GAS float*)(a.ws + WS_VS);
    const int gw = F.vcu * NWAVES + F.wave, NGW = F.G * NWAVES, lane = F.lane, r = lane & 31, hh = lane >> 5;
    constexpr int IMIN = (int)0x80000000;
    for (int task = gw; task < (T / 32) * 2; task += NGW) {
        const int tile = task >> 1, hg = task & 1; const size_t token = (size_t)tile * 32 + r;
#pragma unroll 1
        for (int hi = 0; hi < 4; ++hi) {
            const int h = hg * 4 + hi;
            int L[2][16];
#pragma unroll
            for (int p = 0; p < 2; ++p) {
                bf16x8 qf[8], af[8];
                const bf16_t* qp = QRY + token * 2048 + h * 256 + p * 128 + hh * 8;
#pragma unroll
                for (int ks = 0; ks < 8; ++ks) qf[ks] = *(const GAS bf16x8*)(qp + ks * 16);
                const bf16_t* skp = SK + ((size_t)(h * 2 + p) * 128 + r) * 128 + hh * 8;
#pragma unroll
                for (int ks = 0; ks < 8; ++ks) af[ks] = *(const GAS bf16x8*)(skp + ks * 16);
                int lst[16];
#pragma unroll
                for (int s_ = 0; s_ < 16; ++s_) lst[s_] = IMIN;
#pragma unroll 1
                for (int mt = 0; mt < 4; ++mt) {
                    f32x16 acc;
#pragma unroll
                    for (int i = 0; i < 16; ++i) acc[i] = 0.f;
#pragma unroll
                    for (int ks = 0; ks < 8; ++ks) acc = __builtin_amdgcn_mfma_f32_32x32x16_bf16(af[ks], qf[ks], acc, 0, 0, 0);
                    const int mtn = (mt < 3) ? mt + 1 : 3;
#pragma unroll
                    for (int ks = 0; ks < 8; ++ks) af[ks] = *(const GAS bf16x8*)(skp + (size_t)mtn * 32 * 128 + ks * 16);
                    const int sub = 32 * mt + 4 * hh;
#pragma unroll
                    for (int i = 0; i < 16; ++i) { const int base = 127 - ((i & 3) + 8 * (i >> 2)); const float sc = acc[i]; const int key = ((ordi(sc) & ~0x7F) | base) - sub; tk_insert(lst, key); }
                }
                tk_pair_merge(lst);
#pragma unroll
                for (int s_ = 0; s_ < 16; ++s_) L[p][s_] = lst[s_];
            }
            float fx[16], fy[16];
#pragma unroll
            for (int s_ = 0; s_ < 16; ++s_) { const int X = hh ? L[1][s_] : L[0][s_], Y = hh ? L[0][s_] : L[1][s_]; fx[s_] = unordi(X); fy[s_] = unordi(Y); }
            int cl[16];
#pragma unroll
            for (int s_ = 0; s_ < 16; ++s_) cl[s_] = IMIN;
#pragma unroll
            for (int ap = 0; ap < 4; ++ap)
#pragma unroll
                for (int bp = ap; bp < 16; ++bp) if ((ap + 1) * (bp + 1) <= 16) {
                    const float sum = fx[ap] + fy[bp];
                    const int pos = hh ? (bp * 16 + ap) : (ap * 16 + bp);
                    int key = (ordi(sum) & ~0xFF) | (255 - pos);
                    if (ap == bp) key = hh ? IMIN : key;
                    tk_insert(cl, key);
                }
            tk_pair_merge(cl);
            unsigned long long aLo = 0ull, aHi = 0ull, bLo = 0ull, bHi = 0ull;
#pragma unroll
            for (int j = 0; j < 8; ++j) { aLo |= (unsigned long long)(unsigned)(127 - (L[0][j] & 0x7F)) << (8 * j); aHi |= (unsigned long long)(unsigned)(127 - (L[0][8 + j] & 0x7F)) << (8 * j);
                bLo |= (unsigned long long)(unsigned)(127 - (L[1][j] & 0x7F)) << (8 * j); bHi |= (unsigned long long)(unsigned)(127 - (L[1][8 + j] & 0x7F)) << (8 * j); }
            int ex[16]; float ev[16]; float esum = 0.f; const float vmax = unordi(cl[0]);
#pragma unroll
            for (int s_ = 0; s_ < 16; ++s_) { const int pos = 255 - (cl[s_] & 0xFF); ex[s_] = tk_lookup(aLo, aHi, pos >> 4) * 128 + tk_lookup(bLo, bHi, pos & 15);
                ev[s_] = __expf(unordi(cl[s_]) - vmax); esum += ev[s_]; }
            const float inv = 1.0f / esum;
            if (hh == 0) { GAS u32x4* ip = (GAS u32x4*)(IDX + token * 128 + h * 16); GAS f32x4* up = (GAS f32x4*)(USG + token * 128 + h * 16);
#pragma unroll
                for (int w = 0; w < 4; ++w) { ip[w] = (u32x4){(unsigned)ex[4 * w], (unsigned)ex[4 * w + 1], (unsigned)ex[4 * w + 2], (unsigned)ex[4 * w + 3]};
                    up[w] = (f32x4){USr[ex[4 * w]], USr[ex[4 * w + 1]], USr[ex[4 * w + 2]], USr[ex[4 * w + 3]]}; } }
            else { GAS f32x4* gp = (GAS f32x4*)(GATE + token * 128 + h * 16);
#pragma unroll
                for (int w = 0; w < 4; ++w) gp[w] = (f32x4){ev[4 * w] * inv * VSr[ex[4 * w]], ev[4 * w + 1] * inv * VSr[ex[4 * w + 1]], ev[4 * w + 2] * inv * VSr[ex[4 * w + 2]], ev[4 * w + 3] * inv * VSr[ex[4 * w + 3]]}; }
        }
    }
}

__device__ __forceinline__ float dot2bf(unsigned a, unsigned b, float acc) { return __builtin_amdgcn_fdot2_f32_bf16(__builtin_bit_cast(bf16x2_t, a), __builtin_bit_cast(bf16x2_t, b), acc, false); }
template <int CTRL> __device__ __forceinline__ float dppf(float x) { return __builtin_bit_cast(float, __builtin_amdgcn_mov_dpp(__builtin_bit_cast(int, x), CTRL, 0xf, 0xf, true)); }
__device__ __forceinline__ float gelu1(float v) {
    const float av = __builtin_fabsf(v), t = __builtin_amdgcn_rcpf(av * 0.2316418882f + 1.0f);
    float q = t * 0.5307027145f + (-0.7265760135f); q = q * t + 0.7107068705f; q = q * t + (-0.142248368f); q = q * t + 0.127414796f; q = q * t;
    const float e = __builtin_amdgcn_exp2f((v * v) * (-0.72134752044f));
    const float m = v * (q * e);
    return v < 0.f ? m : v - m;
}
struct GStage { u32x4 u[2], v[2]; };
__device__ __forceinline__ void phase_gather(Frame& F, const Args& a, float* OUTP) {
    const unsigned char* UQ = a.ws + WS_UT; const unsigned char* VQ = a.ws + WS_VT; const bf16_t* PLE = (const bf16_t*)(a.ws + WS_PP);
    const int* IDX = (const int*)(a.ws + WS_IDX); const float* GATE = (const float*)(a.ws + WS_GATE); const float* USG = (const float*)(a.ws + WS_USG);
    const float* H = a.out; const float* g2 = a.in[19]; const float* b2 = a.in[20];
    const int gw = F.vcu * NWAVES + F.wave, NGW = F.G * NWAVES, lane = F.lane;
    for (int t = gw; t < T; t += NGW) {
        const int id0 = IDX[(size_t)t * 128 + lane], id1 = IDX[(size_t)t * 128 + 64 + lane];
        const float gt0 = GATE[(size_t)t * 128 + lane], gt1 = GATE[(size_t)t * 128 + 64 + lane];
        const float us0 = USG[(size_t)t * 128 + lane], us1 = USG[(size_t)t * 128 + 64 + lane];
        const GAS f32x4* hp = (const GAS f32x4*)(H + (size_t)t * D) + lane * 4;
        f32x4 hv[4]; float mx = 0.f;
#pragma unroll
        for (int i = 0; i < 4; ++i) { hv[i] = hp[i];
#pragma unroll
            for (int c = 0; c < 4; ++c) mx = fmaxf(mx, __builtin_fabsf(hv[i][c])); }
#pragma unroll
        for (int o = 1; o < 64; o <<= 1) mx = fmaxf(mx, __shfl_xor(mx, o));
        const float sh = mx > 0.f ? mx * (1.0f / 127.0f) : 1.0f, ish = 1.0f / sh;
        int hq[4];
#pragma unroll
        for (int i = 0; i < 4; ++i) { unsigned wq = 0u;
#pragma unroll
            for (int c = 0; c < 4; ++c) { const int qi = (int)__builtin_rintf(hv[i][c] * ish); wq |= (unsigned)(qi & 0xFF) << (8 * c); }
            hq[i] = (int)wq; }
        float acc[16]; float csum = 0.f;
#pragma unroll
        for (int i = 0; i < 16; ++i) acc[i] = 0.f;
        GStage st[4];
#define G_LOAD(S_, idv, kk) do { _Pragma("unroll") for (int j_ = 0; j_ < 2; ++j_) { const int e_ = __builtin_amdgcn_readlane(idv, (kk) + j_); \
            st[S_].u[j_] = *((const GAS u32x4*)(UQ + (size_t)e_ * 1024) + lane); st[S_].v[j_] = *((const GAS u32x4*)(VQ + (size_t)e_ * 1024) + lane); } } while (0)
#define G_COMP(S_, gtv, usv, kk) do { float d_[2]; _Pragma("unroll") for (int j_ = 0; j_ < 2; ++j_) { int x_ = 0; \
            _Pragma("unroll") for (int c_ = 0; c_ < 4; ++c_) x_ = __builtin_amdgcn_sdot4((int)st[S_].u[j_][c_], hq[c_], x_, false); d_[j_] = (float)x_; } \
            const auto sw_ = __builtin_amdgcn_permlane32_swap(__builtin_bit_cast(unsigned, d_[0]), __builtin_bit_cast(unsigned, d_[1]), false, false); \
            const unsigned sw0_ = sw_[0], sw1_ = sw_[1]; float x_ = __builtin_bit_cast(float, sw0_) + __builtin_bit_cast(float, sw1_); \
            const auto s16_ = __builtin_amdgcn_permlane16_swap(__builtin_bit_cast(unsigned, x_), __builtin_bit_cast(unsigned, x_), false, false); \
            const unsigned s160_ = s16_[0], s161_ = s16_[1]; x_ = __builtin_bit_cast(float, s160_) + __builtin_bit_cast(float, s161_); \
            x_ += dppf<0x128>(x_); x_ += dppf<0x141>(x_); x_ += dppf<0x4E>(x_); x_ += dppf<0xB1>(x_); \
            const float g0_ = __builtin_bit_cast(float, __builtin_amdgcn_readlane(__builtin_bit_cast(int, gtv), (kk))), g1_ = __builtin_bit_cast(float, __builtin_amdgcn_readlane(__builtin_bit_cast(int, gtv), (kk) + 1)); \
            const float u0_ = __builtin_bit_cast(float, __builtin_amdgcn_readlane(__builtin_bit_cast(int, usv), (kk))), u1_ = __builtin_bit_cast(float, __builtin_amdgcn_readlane(__builtin_bit_cast(int, usv), (kk) + 1)); \
            const float act_ = gelu1(x_ * sh * (lane < 32 ? u0_ : u1_)) * (lane < 32 ? g0_ : g1_); \
            const float a0_ = __builtin_bit_cast(float, __builtin_amdgcn_readlane(__builtin_bit_cast(int, act_), 0)), a1_ = __builtin_bit_cast(float, __builtin_amdgcn_readlane(__builtin_bit_cast(int, act_), 32)); \
            csum += a0_ + a1_; \
            _Pragma("unroll") for (int c_ = 0; c_ < 4; ++c_) { const unsigned w0_ = st[S_].v[0][c_], w1_ = st[S_].v[1][c_]; \
                acc[4 * c_ + 0] += a0_ * (float)(w0_ & 0xFFu); acc[4 * c_ + 1] += a0_ * (float)((w0_ >> 8) & 0xFFu); acc[4 * c_ + 2] += a0_ * (float)((w0_ >> 16) & 0xFFu); acc[4 * c_ + 3] += a0_ * (float)(w0_ >> 24); \
                acc[4 * c_ + 0] += a1_ * (float)(w1_ & 0xFFu); acc[4 * c_ + 1] += a1_ * (float)((w1_ >> 8) & 0xFFu); acc[4 * c_ + 2] += a1_ * (float)((w1_ >> 16) & 0xFFu); acc[4 * c_ + 3] += a1_ * (float)(w1_ >> 24); } } while (0)
#pragma unroll
        for (int hh = 0; hh < 2; ++hh) {
            const int idv = hh ? id1 : id0; const float gtv = hh ? gt1 : gt0, usv = hh ? us1 : us0;
            G_LOAD(0, idv, 0); G_LOAD(1, idv, 2); G_LOAD(2, idv, 4);
            for (int k = 0; k < 64; k += 8) {
                G_LOAD(3, idv, k + 6); G_COMP(0, gtv, usv, k);
                if (k + 8 < 64) G_LOAD(0, idv, k + 8);
                G_COMP(1, gtv, usv, k + 2);
                if (k + 8 < 64) G_LOAD(1, idv, k + 10);
                G_COMP(2, gtv, usv, k + 4);
                if (k + 8 < 64) G_LOAD(2, idv, k + 12);
                G_COMP(3, gtv, usv, k + 6);
            }
        }
#undef G_LOAD
#undef G_COMP
        const GAS u32x4* pp = (const GAS u32x4*)(PLE + (size_t)t * D) + lane * 2;
        const u32x4 pa = pp[0], pb = pp[1];
        f32x4 p[4]; pg8::unpack8(pa, p[0], p[1]); pg8::unpack8(pb, p[2], p[3]);
        const float off = 128.0f * csum;
        f32x4 r[4];
#pragma unroll
        for (int i = 0; i < 4; ++i) r[i] = hv[i] * ALPHA + ((f32x4){acc[4 * i], acc[4 * i + 1], acc[4 * i + 2], acc[4 * i + 3]} - off) + p[i];
        float s = 0.f;
#pragma unroll
        for (int i = 0; i < 4; ++i) s += (r[i][0] + r[i][1]) + (r[i][2] + r[i][3]);
        const float mean = wave_sum(s) * (1.f / D); float s2 = 0.f;
#pragma unroll
        for (int i = 0; i < 4; ++i) { r[i] = r[i] - mean; s2 += (r[i][0] * r[i][0] + r[i][1] * r[i][1]) + (r[i][2] * r[i][2] + r[i][3] * r[i][3]); }
        const float rstd = 1.f / sqrtf(wave_sum(s2) * (1.f / D) + LN_EPS);
        const GAS f32x4* gp = (const GAS f32x4*)g2 + lane * 4; const GAS f32x4* bp = (const GAS f32x4*)b2 + lane * 4;
        GAS f32x4* op = (GAS f32x4*)(OUTP + (size_t)t * D) + lane * 4;
#pragma unroll
        for (int i = 0; i < 4; ++i) op[i] = r[i] * rstd * gp[i] + bp[i];
    }
}

constexpr int NPHASE = 9;
__global__ void __launch_bounds__(NWAVES * 64, 2) mk_fwd(Args args) {
    extern __shared__ __attribute__((aligned(16))) unsigned char lds[];
    Frame F;
    F.lds = (LAS unsigned char*)lds;
    F.MISC = (volatile LAS unsigned*)(F.lds + MISC_OFF);
    F.tid = threadIdx.x; F.lane = F.tid & 63; F.wave = __builtin_amdgcn_readfirstlane(F.tid >> 6);
    F.G = gridDim.x; { const int bx = blockIdx.x; F.vcu = (F.G % 8 == 0) ? (bx % 8) * (F.G / 8) + bx / 8 : bx; }
    unsigned char* ws = args.ws;
    F.ctl = (gu32*)(ws + WS_CTL);
    for (int u = F.tid; u < (LDS_BYTES - LDSCTL_OFF) / 4; u += NWAVES * 64) ((LAS unsigned*)(F.lds + LDSCTL_OFF))[u] = 0u;
    __syncthreads();
    const int lo = args.ph_lo, hi = args.ph_hi;
    const bool one = (hi - lo) > 1;
    XcdBarrier bar; bar.bar = (unsigned*)(F.ctl + CW_BAR); bar.x = 0; bar.st = nullptr;
    if (one) bar = xcd_barrier_post((unsigned*)(F.ctl + CW_BAR), F.MISC + 8);
#ifndef PH_MASK
#define PH_MASK 0xFFFF
#endif
#define IN(k) (((PH_MASK >> (k)) & 1) && lo <= (k) && (k) < hi)
#define SEAM(k) do { if (IN(k) && IN((k) + 1)) xcd_barrier(bar); } while (0)
#ifndef REP_MASK
#define REP_MASK 0
#define REP_N 1
#endif
#define REPS(k) for (int rep_ = (((REP_MASK >> (k)) & 1) ? REP_N : 1); rep_ > 0; --rep_)
    bf16_t* const GA = (bf16_t*)args.out; bf16_t* const GB = (bf16_t*)args.out + (size_t)T * 1024;

    if (IN(0)) REPS(0) { phase_prologue(F, args); SEAM(0); }
    if (IN(1)) REPS(1) {
        pg8::Gemm g{(const bf16_t*)(ws + WS_XN), (const bf16_t*)(ws + WS_WIN), T, NPROJ, 1024, 1024, 1024, 0, 0};
        pg8::StaticOrder S; S.init(T, NPROJ, F.G, (int)blockIdx.x);
        pg8::EpiProj E{(bf16_t*)(ws + WS_QS), (bf16_t*)(ws + WS_KK), (bf16_t*)(ws + WS_VI), (bf16_t*)(ws + WS_SG), (bf16_t*)(ws + WS_VP), GA, GB, (const float*)(ws + WS_OML)};
        pg8::gemm_phase<pg8::EpiProj>(F.lds, g, S, E);
        SEAM(1);
    }
    if (IN(2)) REPS(2) {
        for (int u = blockIdx.x; u < 256; u += F.G) { const int unit = u >> 2, seg = u & 3;
            if (seg < 3) hgrn_unit<false>(F, args, unit, seg); }
        { const int np = F.G >> 2; if ((blockIdx.x & 3) == 3 && np > 0) pool_prep(F, args, (size_t)(blockIdx.x >> 2) * 512 + F.tid, (size_t)np * 512); }
        xcd_barrier(bar);
        for (int u = blockIdx.x; u < 256; u += F.G) hgrn_unit<true>(F, args, u >> 2, u & 3);
        SEAM(2);
    }
    if (IN(3)) REPS(3) {
        { pg8::Gemm g{(const bf16_t*)(ws + WS_PL), (const bf16_t*)(ws + WS_WPOOL), T, 1024, 256, 512, 256, 1, 256};
          pg8::StaticOrder S; S.init(T, 1024, F.G, (int)blockIdx.x);
          pg8::EpiYB E{(bf16_t*)(ws + WS_YB), GB, args.in[9]};
          pg8::gemm_phase<pg8::EpiYB>(F.lds, g, S, E); }
        { pg8::Gemm g{(const bf16_t*)(ws + WS_OG), (const bf16_t*)(ws + WS_WA), T, 1024, 1024, 1024, 1024, 0, 0};
          pg8::StaticOrder S; S.init(T, 1024, F.G, (int)blockIdx.x);
          pg8::EpiMix E{(bf16_t*)(ws + WS_MIX), GA, (const bf16_t*)(ws + WS_YB)};
          pg8::gemm_phase<pg8::EpiMix>(F.lds, g, S, E); }
        { pg8::Gemm g{(const bf16_t*)(ws + WS_PB), (const bf16_t*)(ws + WS_WPP), T, 1024, 256, 256, 256, 0, 0};
          pg8::StaticOrder S; S.init(T, 1024, F.G, (int)blockIdx.x);
          pg8::EpiPlain E{(bf16_t*)(ws + WS_PP), 1024};
          pg8::gemm_phase<pg8::EpiPlain>(F.lds, g, S, E); }
        SEAM(3);
    }
    if (IN(4)) REPS(4) {
        pg8::Gemm g{(const bf16_t*)(ws + WS_MIX), (const bf16_t*)(ws + WS_WOUT), T, 1024, 1024, 1024, 1024, 0, 0};
        pg8::StaticOrder S; S.init(T, 1024, F.G, (int)blockIdx.x);
        pg8::EpiR1 E{args.out, args.in[0], (const float*)(ws + WS_ST0), args.in[2], args.in[3]};
        pg8::gemm_phase<pg8::EpiR1>(F.lds, g, S, E);
        SEAM(4);
    }
    if (IN(5)) { phase_ln1(F, args); SEAM(5); }
    if (IN(6)) {
        pg8::Gemm g{(const bf16_t*)(ws + WS_H1B), (const bf16_t*)(ws + WS_WPGQ), T, 3072, 1024, 1024, 1024, 0, 0};
        pg8::StaticOrder S; S.init(T, 3072, F.G, (int)blockIdx.x);
        pg8::EpiPgq E{(bf16_t*)(ws + WS_PP), (bf16_t*)(ws + WS_QRY)};
        pg8::gemm_phase<pg8::EpiPgq>(F.lds, g, S, E);
        SEAM(6);
    }
    if (IN(7)) REPS(7) { phase_topk(F, args); SEAM(7); }
    if (IN(8)) REPS(8) { phase_gather(F, args, rep_ > 1 ? (float*)(ws + WS_QS) : args.out); if (rep_ > 1) xcd_barrier(bar); }
#undef IN
#undef SEAM
}

extern "C" void kernel_launch(void* const* d_in, const int* in_sizes, int n_in, void* d_out, int out_size, void* d_ws, size_t ws_size, hipStream_t stream) {
    static int grid = 0;
    if (grid == 0) {
        if (n_in != 21 || out_size != T * D || ws_size < WS_END) { fprintf(stderr, "kernel_launch: unexpected shapes (n_in %d, out %d, ws %zu)\n", n_in, out_size, ws_size); grid = -1; return; }
        int dev = 0, cus = 0, per_cu = 0;
        if (hipGetDevice(&dev) != hipSuccess || hipDeviceGetAttribute(&cus, hipDeviceAttributeMultiprocessorCount, dev) != hipSuccess) { grid = -1; return; }
        if (hipFuncSetAttribute((const void*)mk_fwd, hipFuncAttributeMaxDynamicSharedMemorySize, LDS_BYTES) != hipSuccess) { fprintf(stderr, "kernel_launch: hipFuncSetAttribute failed\n"); grid = -1; return; }
        if (hipOccupancyMaxActiveBlocksPerMultiprocessor(&per_cu, (const void*)mk_fwd, NWAVES * 64, LDS_BYTES) != hipSuccess || per_cu < 1)
            fprintf(stderr, "kernel_launch: occupancy query reports %d\n", per_cu);
        (void)hipGetLastError();
        grid = cus;
    }
    if (grid < 0) return;
    (void)hipMemsetAsync((char*)d_ws + WS_CTL, 0, CTL_ZERO_BYTES, stream);
    Args a{};
    for (int i = 0; i < 21; ++i) a.in[i] = (const float*)d_in[i];
    a.out = (float*)d_out; a.ws = (unsigned char*)d_ws;
#if MK_ONE_LAUNCH
    a.ph_lo = 0; a.ph_hi = NPHASE;
    hipLaunchKernelGGL(mk_fwd, dim3(grid), dim3(NWAVES * 64), LDS_BYTES, stream, a);
#else
    for (int p = 0; p < NPHASE; ++p) { a.ph_lo = p; a.ph_hi = p + 1; hipLaunchKernelGGL(mk_fwd, dim3(grid), dim3(NWAVES * 64), LDS_BYTES, stream, a); }
#endif
}
```
